# Optimizing an MI355X kernel written in HIP

```python
import math
import jax
import jax.numpy as jnp
from jax import lax
import numpy as np

D_MODEL = 1024
BATCH = 4
SEQ = 8192
DEPTH = 2

CHUNK = 64
Q_BLOCK = 128
MEM_LEN = 256
MEM_HEADS = 4
MEM_DIM = D_MODEL // MEM_HEADS

FOX_DIM = 64
FOX_W = D_MODEL // 4
FOX_HEADS = FOX_W // FOX_DIM
DIFF_QK_DIM = 32
DIFF_V_DIM = 2 * DIFF_QK_DIM
DIFF_W = D_MODEL // 4
DIFF_HEADS = DIFF_W // DIFF_V_DIM
HGRN_DIM = 128
HGRN_W = D_MODEL - FOX_W - DIFF_W
HGRN_HEADS = HGRN_W // HGRN_DIM

MIX_W = FOX_W + DIFF_W + HGRN_W
IN_SIZES = (FOX_W, FOX_W, FOX_W, FOX_HEADS, DIFF_W, DIFF_W, DIFF_W, HGRN_W, HGRN_W, HGRN_W, HGRN_W)
IN_W = sum(IN_SIZES)

N_EXPERTS = 16
N_GROUPS = 4
EXPERTS_PER_GROUP = N_EXPERTS // N_GROUPS
TOP_K = 2
EXPERT_FF = D_MODEL // 2

ALPHA = (2 * DEPTH) ** 0.25
BETA = (8 * DEPTH) ** -0.25
LN_EPS = 1e-5

kernel_name = 'hybrid_fox_diff_hgrn2_moe_encoder'


def _layer_norm(x, g, b):
    xf = x.astype(jnp.float32)
    mu = jnp.mean(xf, axis=-1, keepdims=True)
    var = jnp.mean(jnp.square(xf - mu), axis=-1, keepdims=True)
    y = (xf - mu) * lax.rsqrt(var + LN_EPS) * g.astype(jnp.float32) + b.astype(jnp.float32)
    return y.astype(x.dtype)


def _rms_norm(x, g):
    xf = x.astype(jnp.float32)
    y = xf * lax.rsqrt(jnp.mean(xf * xf, axis=-1, keepdims=True) + LN_EPS) * g.astype(jnp.float32)
    return y.astype(x.dtype)


def _split_heads(t, n_heads):
    b, s, _ = t.shape
    return t.reshape(b, s, n_heads, -1).transpose(0, 2, 1, 3)


def _merge_heads(t):
    b, h, s, d = t.shape
    return t.transpose(0, 2, 1, 3).reshape(b, s, h * d)


def _to_blocks(t):
    b, h, s = t.shape[:3]
    t = t.reshape((b, h, s // Q_BLOCK, Q_BLOCK) + t.shape[3:])
    return jnp.moveaxis(t, 2, 0)


def _from_blocks(t):
    nb, b, h, q, d = t.shape
    return t.transpose(1, 2, 0, 3, 4).reshape(b, h, nb * q, d)


def _split_columns(proj):
    parts, start = [], 0
    for width in IN_SIZES:
        parts.append(proj[..., start:start + width])
        start += width
    return parts


def _forgetting_attention(q, k, v, log_f):
    s = q.shape[2]
    cum = jnp.cumsum(log_f, axis=-1)
    key_pos = jnp.arange(s)
    query_pos = key_pos.reshape(s // Q_BLOCK, Q_BLOCK)
    scale = FOX_DIM ** -0.5

    def block(args):
        q_blk, c_blk, q_pos = args
        logits = jnp.einsum('bhqd,bhkd->bhqk', q_blk, k).astype(jnp.float32) * scale
        logits = logits + c_blk[..., :, None] - cum[..., None, :]
        logits = jnp.where(key_pos[None, :] <= q_pos[:, None], logits, -jnp.inf)
        p = jax.nn.softmax(logits, axis=-1).astype(v.dtype)
        return jnp.einsum('bhqk,bhkd->bhqd', p, v)

    out = lax.map(block, (_to_blocks(q), _to_blocks(cum), query_pos))
    return _from_blocks(out)


def _differential_attention(q1, q2, k1, k2, v, lam):
    s = q1.shape[2]
    key_chunk = jnp.arange(s) // CHUNK
    query_chunk = key_chunk.reshape(s // Q_BLOCK, Q_BLOCK)
    scale = DIFF_QK_DIM ** -0.5

    def block(args):
        q1b, q2b, qc = args
        visible = key_chunk[None, :] <= qc[:, None]

        def attn_map(qb, kk):
            logits = jnp.einsum('bhqd,bhkd->bhqk', qb, kk).astype(jnp.float32) * scale
            return jax.nn.softmax(jnp.where(visible, logits, -jnp.inf), axis=-1)

        p = attn_map(q1b, k1) - lam * attn_map(q2b, k2)
        return jnp.einsum('bhqk,bhkd->bhqd', p.astype(v.dtype), v)

    out = lax.map(block, (_to_blocks(q1), _to_blocks(q2), query_chunk))
    return _from_blocks(out)


def _hgrn2_recurrence(q, k, log_f, v):
    b, h, s, dk = q.shape
    dv = v.shape[-1]
    n = s // CHUNK

    def chunks(t):
        t = t.astype(jnp.float32)
        return t.reshape(b, h, n, CHUNK, t.shape[-1]).transpose(2, 0, 1, 3, 4)

    pos = jnp.arange(CHUNK)
    causal = (pos[:, None] >= pos[None, :])[None, None, :, :, None]

    def step(state, inp):
        qc, kc, gc, vc = inp
        bc = jnp.cumsum(gc, axis=2)
        rel = jnp.where(causal, bc[:, :, :, None, :] - bc[:, :, None, :, :], -jnp.inf)
        scores = jnp.einsum('bhtd,bhsd,bhtsd->bhts', qc, kc, jnp.exp(rel))
        o = (jnp.einsum('bhts,bhsv->bhtv', scores, vc)
             + jnp.einsum('bhtd,bhdv->bhtv', qc * jnp.exp(bc), state))
        b_last = bc[:, :, -1, :]
        k_dec = kc * jnp.exp(b_last[:, :, None, :] - bc)
        state = jnp.exp(b_last)[..., None] * state + jnp.einsum('bhsd,bhsv->bhdv', k_dec, vc)
        return state, o

    state0 = jnp.zeros((b, h, dk, dv), jnp.float32)
    _, o = lax.scan(step, state0, (chunks(q), chunks(k), chunks(log_f), chunks(v)))
    return o.transpose(1, 2, 0, 3, 4).reshape(b, h, s, dv)


def _hybrid_mixer(x, w_in, fox_fb, lam_q1, lam_k1, lam_q2, lam_k2, lam_init,
                  diff_norm_g, lower_bound, hgrn_norm_g, w_out):
    proj = x @ w_in
    fq, fk, fv, ff, dq, dk, dv, hq, hf, hi, hg = _split_columns(proj)

    log_f = jax.nn.log_sigmoid(ff.astype(jnp.float32) + fox_fb.astype(jnp.float32))
    y_fox = _forgetting_attention(_split_heads(fq, FOX_HEADS), _split_heads(fk, FOX_HEADS),
                                  _split_heads(fv, FOX_HEADS), log_f.transpose(0, 2, 1))

    dq_h = _split_heads(dq, DIFF_HEADS)
    dk_h = _split_heads(dk, DIFF_HEADS)
    lam = (jnp.exp(jnp.sum(lam_q1.astype(jnp.float32) * lam_k1.astype(jnp.float32)))
           - jnp.exp(jnp.sum(lam_q2.astype(jnp.float32) * lam_k2.astype(jnp.float32)))
           + lam_init)
    y_diff = _differential_attention(dq_h[..., :DIFF_QK_DIM], dq_h[..., DIFF_QK_DIM:],
                                     dk_h[..., :DIFF_QK_DIM], dk_h[..., DIFF_QK_DIM:],
                                     _split_heads(dv, DIFF_HEADS), lam)
    y_diff = _rms_norm(y_diff, diff_norm_g) * (1.0 - lam_init)

    f_logit = hf.astype(jnp.float32)
    lb = lower_bound.astype(jnp.float32)
    log_f_h = jnp.logaddexp(jnp.log(lb), jnp.log1p(-lb) + jax.nn.log_sigmoid(f_logit))
    k_h = (1.0 - lb) * jax.nn.sigmoid(-f_logit)
    o = _hgrn2_recurrence(_split_heads(jax.nn.silu(hq), HGRN_HEADS), _split_heads(k_h, HGRN_HEADS),
                          _split_heads(log_f_h, HGRN_HEADS), _split_heads(hi, HGRN_HEADS))
    y_hgrn = _rms_norm(o, hgrn_norm_g) * jax.nn.silu(_split_heads(hg, HGRN_HEADS).astype(jnp.float32))

    y = jnp.concatenate([_merge_heads(y_fox).astype(x.dtype), _merge_heads(y_diff).astype(x.dtype),
                         _merge_heads(y_hgrn).astype(x.dtype)], axis=-1)
    return y @ w_out


def _memory_attention(x, mem, w_q, w_k, w_v, w_o):
    q = _split_heads(x @ w_q, MEM_HEADS)
    k = _split_heads(mem @ w_k, MEM_HEADS)
    v = _split_heads(mem @ w_v, MEM_HEADS)
    logits = jnp.einsum('bhqd,bhkd->bhqk', q, k).astype(jnp.float32) * MEM_DIM ** -0.5
    p = jax.nn.softmax(logits, axis=-1).astype(v.dtype)
    return _merge_heads(jnp.einsum('bhqk,bhkd->bhqd', p, v)) @ w_o


def _grouped_moe(x, router_w, router_b, w1, w3, w2):
    b, s, d = x.shape
    xt = x.reshape(b * s, d)
    n = xt.shape[0]
    scores = jax.nn.sigmoid((xt @ router_w).astype(jnp.float32))
    biased = scores + router_b.astype(jnp.float32)
    grouped = biased.reshape(n, N_GROUPS, EXPERTS_PER_GROUP)
    group_score = jnp.sum(lax.top_k(grouped, TOP_K)[0], axis=-1)
    group_sel = jnp.argmax(group_score, axis=-1)
    in_group = jnp.arange(N_GROUPS)[None, :] == group_sel[:, None]
    masked = jnp.where(in_group[:, :, None], grouped, -jnp.inf).reshape(n, N_EXPERTS)
    _, expert_idx = lax.top_k(masked, TOP_K)
    sel = jnp.take_along_axis(scores, expert_idx, axis=-1)
    gates = sel / jnp.sum(sel, axis=-1, keepdims=True)
    gate_dense = jnp.sum(jax.nn.one_hot(expert_idx, N_EXPERTS, dtype=jnp.float32) * gates[..., None], axis=1)
    out = jnp.zeros_like(xt)
    for e in range(N_EXPERTS):
        hid = jax.nn.silu(xt @ w1[e]) * (xt @ w3[e])
        out = out + gate_dense[:, e, None].astype(xt.dtype) * (hid @ w2[e])
    return out.reshape(b, s, d)


def setup_inputs(seed: int = 0) -> dict:
    key = jax.random.key(seed)
    ks = jax.random.split(key, 26)
    f32 = jnp.float32

    def nrm(k, shape, scale):
        return jax.random.normal(k, shape, f32) * scale

    d = D_MODEL
    return {
        'x': nrm(ks[0], (BATCH, SEQ, d), 1.0),
        'mem': nrm(ks[1], (BATCH, MEM_LEN, d), 1.0),
        'ln_in_g': 1.0 + nrm(ks[2], (d,), 0.02),
        'ln_in_b': nrm(ks[3], (d,), 0.02),
        'w_in': nrm(ks[4], (DEPTH, d, IN_W), d ** -0.5),
        'fox_fb': jax.random.uniform(ks[5], (DEPTH, FOX_HEADS), f32, 1.0, 3.0),
        'lam_q1': nrm(ks[6], (DEPTH, DIFF_QK_DIM), 0.1),
        'lam_k1': nrm(ks[7], (DEPTH, DIFF_QK_DIM), 0.1),
        'lam_q2': nrm(ks[8], (DEPTH, DIFF_QK_DIM), 0.1),
        'lam_k2': nrm(ks[9], (DEPTH, DIFF_QK_DIM), 0.1),
        'diff_norm_g': 1.0 + nrm(ks[10], (DEPTH, DIFF_V_DIM), 0.02),
        'hgrn_lb': nrm(ks[11], (DEPTH, HGRN_W), 0.1),
        'hgrn_norm_g': 1.0 + nrm(ks[12], (DEPTH, HGRN_DIM), 0.02),
        'w_out': nrm(ks[13], (DEPTH, MIX_W, d), BETA * MIX_W ** -0.5),
        'mem_wq': nrm(ks[14], (DEPTH, d, d), d ** -0.5),
        'mem_wk': nrm(ks[15], (DEPTH, d, d), d ** -0.5),
        'mem_wv': nrm(ks[16], (DEPTH, d, d), d ** -0.5),
        'mem_wo': nrm(ks[17], (DEPTH, d, d), BETA * d ** -0.5),
        'router_w': nrm(ks[18], (d, N_EXPERTS), d ** -0.5),
        'router_b': nrm(ks[19], (N_EXPERTS,), 0.01),
        'w1': nrm(ks[20], (DEPTH, N_EXPERTS, d, EXPERT_FF), d ** -0.5),
        'w3': nrm(ks[21], (DEPTH, N_EXPERTS, d, EXPERT_FF), d ** -0.5),
        'w2': nrm(ks[22], (DEPTH, N_EXPERTS, EXPERT_FF, d), BETA * EXPERT_FF ** -0.5),
        'ln_g': 1.0 + nrm(ks[23], (DEPTH, 3, d), 0.02),
        'ln_b': nrm(ks[24], (DEPTH, 3, d), 0.02),
    }


def reference(x, mem, ln_in_g, ln_in_b, w_in, fox_fb, lam_q1, lam_k1, lam_q2, lam_k2,
              diff_norm_g, hgrn_lb, hgrn_norm_g, w_out, mem_wq, mem_wk, mem_wv, mem_wo,
              router_w, router_b, w1, w3, w2, ln_g, ln_b):
    lbs = jax.nn.softmax(hgrn_lb.astype(jnp.float32), axis=0)
    lbs = jnp.cumsum(lbs, axis=0) - lbs[0]
    h = _layer_norm(x, ln_in_g, ln_in_b)
    for i in range(DEPTH):
        lam_init = 0.8 - 0.6 * math.exp(-0.3 * i)
        y = _hybrid_mixer(h, w_in[i], fox_fb[i], lam_q1[i], lam_k1[i], lam_q2[i], lam_k2[i],
                          lam_init, diff_norm_g[i], jnp.maximum(lbs[i], 0.0), hgrn_norm_g[i], w_out[i])
        h = _layer_norm(ALPHA * h + y, ln_g[i, 0], ln_b[i, 0])
        y = _memory_attention(h, mem, mem_wq[i], mem_wk[i], mem_wv[i], mem_wo[i])
        h = _layer_norm(ALPHA * h + y, ln_g[i, 1], ln_b[i, 1])
        y = _grouped_moe(h, router_w, router_b, w1[i], w3[i], w2[i])
        h = _layer_norm(ALPHA * h + y, ln_g[i, 2], ln_b[i, 2])
    return h
```

```cpp
#include <hip/hip_runtime.h>
#include <cstdio>
#include <cstdint>

#define GAS __attribute__((address_space(1)))
#define LAS __attribute__((address_space(3)))
typedef unsigned short bf16;
typedef short bf16x8 __attribute__((ext_vector_type(8)));
typedef short s16x4 __attribute__((ext_vector_type(4)));
typedef float f32x4 __attribute__((ext_vector_type(4)));
typedef float f32x2 __attribute__((ext_vector_type(2)));
typedef float f32x16 __attribute__((ext_vector_type(16)));
typedef unsigned u32x4 __attribute__((ext_vector_type(4)));
typedef unsigned u32x2 __attribute__((ext_vector_type(2)));
typedef GAS unsigned gu32;
#define RLX_AGENT __ATOMIC_RELAXED, __HIP_MEMORY_SCOPE_AGENT
#define LDS_WAIT() asm volatile("s_waitcnt lgkmcnt(0)" ::: "memory")
#define VM_WAIT() asm volatile("s_waitcnt vmcnt(0)" ::: "memory")

constexpr int DM = 1024, NB = 4, SEQ = 8192, MTOK = NB * SEQ;
constexpr int NIN = 3584;
constexpr int INW = 3588;
constexpr int NEXP = 16, EFF = 512;
constexpr float LN_EPS = 1e-5f;
constexpr float ALPHA = 1.4142135623730951f;
constexpr float LOG2E = 1.4426950408889634f;
constexpr int PA_LD = 1536;
constexpr int NWAVES = 8, NTHR = 512;

constexpr size_t MiB = 1u << 20;
constexpr size_t WS_CTL = 0, CTL_ZERO_BYTES = 1 * MiB;
constexpr size_t WS_CUMF = 1 * MiB;
constexpr size_t WS_LF2 = 1 * MiB + 512 * 1024;
constexpr size_t WS_LIST = 2 * MiB;
constexpr size_t WS_GATE = 4 * MiB;
constexpr size_t WS_HDEC = 4 * MiB + 512 * 1024;
constexpr size_t WS_MEMB = 6 * MiB;
constexpr size_t WS_KMEM = 8 * MiB;
constexpr size_t WS_VT = 10 * MiB;
constexpr size_t WS_WIN = 16 * MiB, WS_WOUT = 23 * MiB, WS_WQ = 25 * MiB, WS_WK = 27 * MiB, WS_WV = 29 * MiB, WS_WO = 31 * MiB, WS_W13 = 33 * MiB, WS_W2 = 65 * MiB;
constexpr size_t WS_R1 = 81 * MiB;
constexpr size_t WS_BIG = 145 * MiB;
constexpr size_t WS_PA = WS_BIG, WS_HQ = WS_BIG + 96 * MiB, WS_HI = WS_BIG + 128 * MiB, WS_HG = WS_BIG + 160 * MiB, WS_HF = WS_BIG + 192 * MiB, WS_ST = WS_BIG + 256 * MiB;
constexpr size_t WS_Q = WS_BIG, WS_PATT = WS_BIG + 64 * MiB, WS_OATT = WS_BIG + 128 * MiB;
constexpr size_t WS_HID = WS_BIG, WS_CB = WS_BIG + 68 * MiB;
constexpr size_t WS_END = WS_BIG + 320 * MiB;
static_assert(WS_CB + (size_t)MTOK * 2 * DM * 2 <= WS_END, "ws map");
constexpr int CW_TMO = 0, CW_CODE = 1, CW_BAR = 4096, CW_ECNT = 8192  , CW_DBG = 16384;

__device__ __forceinline__ unsigned cvt_pk_bf16(float lo, float hi) { typedef __bf16 bf2 __attribute__((ext_vector_type(2))); f32x2 v = {lo, hi}; bf2 b = __builtin_convertvector(v, bf2); return __builtin_bit_cast(unsigned, b); }
__device__ __forceinline__ bf16 f2bf(float f) { return (bf16)(cvt_pk_bf16(f, 0.f) & 0xffffu); }
__device__ __forceinline__ float bf2f(bf16 b) { return __uint_as_float(((unsigned)b) << 16); }
__device__ __forceinline__ float wave_sum(float v) {
#pragma unroll
    for (int o = 1; o < 64; o <<= 1) v += __shfl_xor(v, o);
    return v;
}
__device__ __forceinline__ float fast_exp2(float x) { return __builtin_amdgcn_exp2f(x); }
__device__ __forceinline__ float fast_rcp(float x) { return __builtin_amdgcn_rcpf(x); }
__device__ __forceinline__ float sigmoidf_(float x) { return fast_rcp(1.f + fast_exp2(-x * LOG2E)); }
__device__ __forceinline__ float siluf_(float x) { return x * sigmoidf_(x); }
__device__ __forceinline__ float log_sigmoidf_(float x) { return fminf(x, 0.f) - log1pf(__expf(-fabsf(x))); }
constexpr int NPH_L = 14, NPHASE = 1 + 2 * NPH_L;
#define MK_N_LAUNCHES 29
namespace pg8 {
constexpr int BM = 256, BK = 64, HALF = 128, HTB = HALF * BK * 2, STAGE_BYTES = 8 * HTB, NXCD = 8, WGM = 8;
__host__ __device__ __forceinline__ int lds_byte(int r, int c) { const int st = (r >> 4) * 2 + (c >> 5), rr = r & 15, cc = c & 31, ob = rr * 64 + cc * 2; return st * 1024 + (ob ^ (((ob >> 9) & 1) << 5)); }
__host__ __device__ __forceinline__ void stage_rc(int b, int& R, int& C) { const int st = b / 1024, sb = b % 1024, swz = sb ^ (((sb >> 9) & 1) << 5); R = (st >> 1) * 16 + swz / 64; C = (st & 1) * 32 + (swz % 64) / 2; }
__host__ __device__ __forceinline__ int perm32(int rho) { const int n = rho >> 4, i = rho & 15; return 8 * (i >> 2) + 4 * n + (i & 3); }

struct Unit { const char* a; const char* b; const int* rl; int pm, pn, nv, e; };

__device__ __forceinline__ void tile_of(int L, int nM, int nN, int& pm, int& pn) {
    const int nwg = nM * nN; int wgid = L; { const int q = nwg / NXCD, r = nwg % NXCD, xcd = wgid % NXCD, off = wgid / NXCD; wgid = (xcd < r ? xcd * (q + 1) : r * (q + 1) + (xcd - r) * q) + off; }
    const int nig = WGM * nN, gid = wgid / nig, fm = gid * WGM, gsz = (nM - fm) < WGM ? (nM - fm) : WGM;
    pm = fm + ((wgid % nig) % gsz); pn = (wgid % nig) / gsz;
}

template <class Epi, class Sched, bool GATHER, bool ALIGN_EPI>
__device__ __forceinline__ void gemm_phase(LAS unsigned char* lds, const int lda, const int ldb, const int K, const Sched& S, const Epi& E) {
    int tid = threadIdx.x; asm volatile("" : "+v"(tid));
    const int wid = __builtin_amdgcn_readfirstlane(tid >> 6), lane = tid & 63, wr = wid >> 2, wc = wid & 3, fr = lane & 15, fq = lane >> 4;
    const int nt = K / BK;
    unsigned vB[2];
#pragma unroll
    for (int i = 0; i < 2; ++i) { int R, C; stage_rc(tid * 16 + i * 8192, R, C); const int Rb = Epi::PERM ? ((R & ~31) + perm32(R & 31)) : R; vB[i] = (unsigned)(Rb * ldb + C) * 2u; }
    const size_t kstep = (size_t)(BK * 2);
    const size_t hstepB = (size_t)HALF * ldb * 2;
    const unsigned ldsw = (unsigned)wid * 1024u;
    const int aoff = lds_byte(wr * 64 + fr, fq * 8), boff = lds_byte(wc * 32 + fr, fq * 8);
#define PG8_SA(b, h) (((b) * 2 + (h)) * HTB)
#define PG8_SB(b, h) ((4 + (b) * 2 + (h)) * HTB)
#define PG8_STAGE2(bufoff, gbase, v0, v1) do { \
        __builtin_amdgcn_global_load_lds((const unsigned*)((const char*)(gbase) + (v0)), (LAS unsigned*)(lds + (bufoff) + ldsw), 16, 0, 0); \
        __builtin_amdgcn_global_load_lds((const unsigned*)((const char*)(gbase) + (v1)), (LAS unsigned*)(lds + (bufoff) + ldsw + 8192), 16, 0, 0); } while (0)
#define PG8_STAGEB(bufoff, gbase) PG8_STAGE2(bufoff, gbase, vB[0], vB[1])
#define PG8_LDA(dst, b, h) do { _Pragma("unroll") for (int m = 0; m < 4; ++m) _Pragma("unroll") for (int k = 0; k < 2; ++k) dst[m][k] = *(const LAS bf16x8*)(lds + PG8_SA(b, h) + aoff + m * 2048 + k * 1024); } while (0)
#define PG8_LDB(dst, b, h) do { _Pragma("unroll") for (int n = 0; n < 2; ++n) _Pragma("unroll") for (int k = 0; k < 2; ++k) dst[n][k] = *(const LAS bf16x8*)(lds + PG8_SB(b, h) + boff + n * 2048 + k * 1024); } while (0)
#define PG8_MMA(ai, bj, At, Bt) do { __builtin_amdgcn_s_setprio(1); _Pragma("unroll") for (int m = 0; m < 4; ++m) _Pragma("unroll") for (int n = 0; n < 2; ++n) _Pragma("unroll") for (int k = 0; k < 2; ++k) \
        acc[ai][bj][m][n] = __builtin_amdgcn_mfma_f32_16x16x32_bf16(Bt[n][k], At[m][k], acc[ai][bj][m][n], 0, 0, 0); __builtin_amdgcn_s_setprio(0); } while (0)
#define PG8_WAIT_V(n) asm volatile("s_waitcnt vmcnt(" #n ")" ::: "memory")
#define PG8_WAIT_L(n) asm volatile("s_waitcnt lgkmcnt(" #n ")" ::: "memory")
#define PG8_BAR __builtin_amdgcn_s_barrier()
#define PG8_SCHED __builtin_amdgcn_sched_barrier(0)
    Unit cur, nxt; int ui = 0;
    if (!S.next(0, cur)) return;
    unsigned vA[2][2], nvA[2][2];
#define PG8_AOFFS(dst, u) do { int t2_ = tid; if constexpr (GATHER) asm volatile("" : "+v"(t2_)); _Pragma("unroll") for (int i_ = 0; i_ < 2; ++i_) { int R_, C_; stage_rc(t2_ * 16 + i_ * 8192, R_, C_); \
        _Pragma("unroll") for (int h_ = 0; h_ < 2; ++h_) { \
        if constexpr (GATHER) { int rr_ = h_ * HALF + R_; rr_ = rr_ < (u).nv ? rr_ : (u).nv - 1; const int tok_ = (u).rl[rr_] >> 1; dst[h_][i_] = (unsigned)(tok_ * lda + C_) * 2u; } \
        else dst[h_][i_] = (unsigned)((h_ * HALF + R_) * lda + C_) * 2u; } } } while (0)
    PG8_AOFFS(vA, cur);
    f32x4 acc[2][2][4][2];
#pragma unroll
    for (int a = 0; a < 2; ++a)
#pragma unroll
        for (int b = 0; b < 2; ++b)
#pragma unroll
            for (int m = 0; m < 4; ++m)
#pragma unroll
                for (int n = 0; n < 2; ++n) acc[a][b][m][n] = (f32x4){0.f, 0.f, 0.f, 0.f};
    bf16x8 At[4][2], B0[2][2], B1[2][2];
    const char* cA = cur.a; const char* cB = cur.b;
    PG8_STAGEB(PG8_SB(0, 0), cB); PG8_STAGEB(PG8_SB(0, 1), cB + hstepB); PG8_STAGE2(PG8_SA(0, 0), cA, vA[0][0], vA[0][1]); PG8_STAGE2(PG8_SA(0, 1), cA, vA[1][0], vA[1][1]);
    if (wr == 1) PG8_BAR;
    PG8_WAIT_V(2); PG8_BAR;
    PG8_STAGEB(PG8_SB(1, 0), cB + kstep); PG8_STAGE2(PG8_SA(1, 0), cA + kstep, vA[0][0], vA[0][1]); PG8_STAGEB(PG8_SB(1, 1), cB + hstepB + kstep);
    PG8_WAIT_V(6); PG8_BAR;
    for (;;) {
        const bool has_next = S.next(ui + 1, nxt);
        const char* nA = has_next ? nxt.a : cA; const char* nB = has_next ? nxt.b : cB;
        if constexpr (GATHER) { if (has_next) { PG8_AOFFS(nvA, nxt); } else {
#pragma unroll
            for (int h_ = 0; h_ < 2; ++h_)
#pragma unroll
                for (int i_ = 0; i_ < 2; ++i_) nvA[h_][i_] = vA[h_][i_]; } }
#pragma nounroll
        for (int t = 0; t < nt; t += 2) {
            const bool last = (t == nt - 2);
            const char* a1 = cA + (size_t)(t + 1) * kstep;
            const char* a2 = last ? nA : cA + (size_t)(t + 2) * kstep; const char* b2 = last ? nB : cB + (size_t)(t + 2) * kstep;
            const char* a3 = a2 + kstep; const char* b3 = b2 + kstep;
            unsigned x00, x01, x10, x11;
            if constexpr (GATHER) { x00 = last ? nvA[0][0] : vA[0][0]; x01 = last ? nvA[0][1] : vA[0][1]; x10 = last ? nvA[1][0] : vA[1][0]; x11 = last ? nvA[1][1] : vA[1][1]; }
            else { x00 = vA[0][0]; x01 = vA[0][1]; x10 = vA[1][0]; x11 = vA[1][1]; }
            PG8_LDB(B0, 0, 0); PG8_LDB(B1, 0, 1); PG8_SCHED; PG8_LDA(At, 0, 0); PG8_STAGE2(PG8_SA(1, 1), a1, vA[1][0], vA[1][1]);
            PG8_WAIT_V(8); PG8_WAIT_L(0); PG8_BAR; PG8_MMA(0, 0, At, B0); PG8_MMA(0, 1, At, B1); PG8_BAR; PG8_SCHED;
            PG8_LDA(At, 0, 1); PG8_STAGEB(PG8_SB(0, 0), b2); PG8_STAGEB(PG8_SB(0, 1), b2 + hstepB); PG8_STAGE2(PG8_SA(0, 0), a2, x00, x01);
            PG8_WAIT_V(8); PG8_WAIT_L(0); PG8_BAR; PG8_MMA(1, 0, At, B0); PG8_MMA(1, 1, At, B1); PG8_BAR; PG8_SCHED;
            PG8_LDB(B0, 1, 0); PG8_LDB(B1, 1, 1); PG8_SCHED; PG8_LDA(At, 1, 0); PG8_STAGE2(PG8_SA(0, 1), a2, x10, x11);
            PG8_WAIT_V(8); PG8_WAIT_L(0); PG8_BAR; PG8_MMA(0, 0, At, B0); PG8_MMA(0, 1, At, B1); PG8_BAR; PG8_SCHED;
            PG8_LDA(At, 1, 1); PG8_STAGEB(PG8_SB(1, 0), b3); PG8_STAGEB(PG8_SB(1, 1), b3 + hstepB); PG8_STAGE2(PG8_SA(1, 0), a3, x00, x01);
            PG8_WAIT_V(8); PG8_WAIT_L(0); PG8_BAR; PG8_MMA(1, 0, At, B0); PG8_MMA(1, 1, At, B1); PG8_BAR; PG8_SCHED;
        }
        if constexpr (ALIGN_EPI) { if (wr == 0) PG8_BAR; }
        if constexpr (!Epi::AFTER_DRAIN) { int fr_ = fr, fq_ = fq; asm volatile("" : "+v"(fr_), "+v"(fq_)); E(acc, cur, wr, wc, fr_, fq_); }
        if (!has_next) break;
#pragma unroll
        for (int a = 0; a < 2; ++a)
#pragma unroll
            for (int b = 0; b < 2; ++b)
#pragma unroll
                for (int m = 0; m < 4; ++m)
#pragma unroll
                    for (int n = 0; n < 2; ++n) acc[a][b][m][n] = (f32x4){0.f, 0.f, 0.f, 0.f};
        cur = nxt; cA = nA; cB = nB; ++ui;
        if constexpr (GATHER) {
#pragma unroll
            for (int h_ = 0; h_ < 2; ++h_)
#pragma unroll
                for (int i_ = 0; i_ < 2; ++i_) vA[h_][i_] = nvA[h_][i_]; }
        if constexpr (ALIGN_EPI) { if (wr == 1) PG8_BAR; }
    }
    PG8_WAIT_V(0);
    if constexpr (!ALIGN_EPI) { if (wr == 0) PG8_BAR; }
    PG8_BAR;
    if constexpr (Epi::AFTER_DRAIN) { E.fused(acc, cur, wr, wc, fr, fq, lds, wid, lane); }
#undef PG8_AOFFS
#undef PG8_SA
#undef PG8_SB
#undef PG8_STAGE2
#undef PG8_STAGEB
#undef PG8_LDA
#undef PG8_LDB
#undef PG8_MMA
#undef PG8_WAIT_V
#undef PG8_WAIT_L
#undef PG8_BAR
#undef PG8_SCHED
}
}
constexpr int RING_OFF = 0, RING_BYTES = 131072;
constexpr int XCH_OFF = RING_BYTES;
constexpr int TAB_OFF = XCH_OFF + 8192;
constexpr int MISC_OFF = TAB_OFF + 512;
constexpr int LDS_BYTES = 147456;
static_assert(MISC_OFF + 128 <= LDS_BYTES, "LDS map");

namespace pg8 {
template <int ACT>
__device__ __forceinline__ void tile_store_bf16(const f32x4 (&acc)[2][2][4][2], bf16* dst, int ld, float sc, int wr, int wc, int fr, int fq) {
    bf16* p0 = dst + (size_t)(wr * 64 + fr) * ld + wc * 32 + 8 * fq;
#pragma unroll
    for (int ai = 0; ai < 2; ++ai)
#pragma unroll
        for (int m = 0; m < 4; ++m) { bf16* rowp = p0 + (size_t)(ai * HALF + m * 16) * ld;
#pragma unroll
            for (int bj = 0; bj < 2; ++bj) { f32x4 v0 = acc[ai][bj][m][0], v1 = acc[ai][bj][m][1];
                if (ACT == 1) {
#pragma unroll
                    for (int i = 0; i < 4; ++i) { v0[i] = siluf_(v0[i]); v1[i] = siluf_(v1[i]); } }
                v0 = v0 * sc; v1 = v1 * sc; u32x4 w; w.x = cvt_pk_bf16(v0[0], v0[1]); w.y = cvt_pk_bf16(v0[2], v0[3]); w.z = cvt_pk_bf16(v1[0], v1[1]); w.w = cvt_pk_bf16(v1[2], v1[3]);
                *(u32x4*)(rowp + bj * HALF) = w; } }
}
__device__ __forceinline__ void tile_store_f32(const f32x4 (&acc)[2][2][4][2], float* dst, int ld, int wr, int wc, int fr, int fq) {
    float* p0 = dst + (size_t)(wr * 64 + fr) * ld + wc * 32 + 8 * fq;
#pragma unroll
    for (int ai = 0; ai < 2; ++ai)
#pragma unroll
        for (int m = 0; m < 4; ++m) { float* rowp = p0 + (size_t)(ai * HALF + m * 16) * ld;
#pragma unroll
            for (int bj = 0; bj < 2; ++bj) { *(f32x4*)(rowp + bj * HALF) = acc[ai][bj][m][0]; *(f32x4*)(rowp + bj * HALF + 4) = acc[ai][bj][m][1]; } }
}

constexpr float C2_FOX = 0.125f * LOG2E, C2_DIFF = 0.17677669529663687f * LOG2E, C2_MEM = 0.0625f * LOG2E;

struct EpiProj {
    static constexpr bool PERM = true, AFTER_DRAIN = false;
    bf16 *PA, *HQ, *HI, *HG, *KMEM, *VT; float* HF;
    __device__ __forceinline__ void operator()(f32x4 (&acc)[2][2][4][2], const Unit& u, int wr, int wc, int fr, int fq) const {
        const size_t row0 = (size_t)u.pm * BM; const int pn = u.pn;
        if (u.e == 0) {
            if (pn < 6) { const float sc = pn == 0 ? C2_FOX : (pn == 3 ? C2_DIFF : 1.f); tile_store_bf16<0>(acc, PA + row0 * PA_LD + pn * 256, PA_LD, sc, wr, wc, fr, fq); }
            else if (pn < 8) tile_store_bf16<1>(acc, HQ + row0 * 512 + (pn - 6) * 256, 512, 1.f, wr, wc, fr, fq);
            else if (pn < 10) tile_store_f32(acc, HF + row0 * 512 + (pn - 8) * 256, 512, wr, wc, fr, fq);
            else if (pn < 12) tile_store_bf16<0>(acc, HI + row0 * 512 + (pn - 10) * 256, 512, 1.f, wr, wc, fr, fq);
            else tile_store_bf16<1>(acc, HG + row0 * 512 + (pn - 12) * 256, 512, 1.f, wr, wc, fr, fq);
        } else if (u.e == 1) tile_store_bf16<0>(acc, KMEM + row0 * 1024 + pn * 256, 1024, 1.f, wr, wc, fr, fq);
        else tile_store_bf16<0>(acc, VT + row0 * 1024 + pn * 256, 1024, 1.f, wr, wc, fr, fq);
    }
};
struct EpiBf16 {
    static constexpr bool PERM = true, AFTER_DRAIN = false;
    bf16* O; int ld; float sc;
    __device__ __forceinline__ void operator()(f32x4 (&acc)[2][2][4][2], const Unit& u, int wr, int wc, int fr, int fq) const {
        tile_store_bf16<0>(acc, O + (size_t)u.pm * BM * ld + u.pn * BM, ld, sc, wr, wc, fr, fq);
    }
};
struct EpiRes {
    static constexpr bool PERM = true, AFTER_DRAIN = false;
    float* X;
    __device__ __forceinline__ void operator()(f32x4 (&acc)[2][2][4][2], const Unit& u, int wr, int wc, int fr, int fq) const {
        float* p0 = X + ((size_t)u.pm * BM + wr * 64 + fr) * DM + u.pn * BM + wc * 32 + 8 * fq;
#pragma unroll
        for (int ai = 0; ai < 2; ++ai)
#pragma unroll
            for (int m = 0; m < 4; ++m) { float* rowp = p0 + (size_t)(ai * HALF + m * 16) * DM;
#pragma unroll
                for (int bj = 0; bj < 2; ++bj) { const f32x4 a = *(const f32x4*)(rowp + bj * HALF), b = *(const f32x4*)(rowp + bj * HALF + 4);
                    *(f32x4*)(rowp + bj * HALF) = a * ALPHA + acc[ai][bj][m][0]; *(f32x4*)(rowp + bj * HALF + 4) = b * ALPHA + acc[ai][bj][m][1]; } }
    }
};
struct EpiSoftmax {
    static constexpr bool PERM = true, AFTER_DRAIN = false;
    bf16* P; LAS unsigned char* xch;
    __device__ __forceinline__ void operator()(f32x4 (&acc)[2][2][4][2], const Unit& u, int wr, int wc, int fr, int fq) const {
        LAS float* X1 = (LAS float*)xch; LAS float* X2 = X1 + 1024;
        float mx[2][4];
#pragma unroll
        for (int ai = 0; ai < 2; ++ai)
#pragma unroll
            for (int m = 0; m < 4; ++m) { float v = -INFINITY;
#pragma unroll
                for (int bj = 0; bj < 2; ++bj)
#pragma unroll
                    for (int n = 0; n < 2; ++n) { const f32x4 x = acc[ai][bj][m][n]; v = fmaxf(v, fmaxf(fmaxf(x[0], x[1]), fmaxf(x[2], x[3]))); }
                v = fmaxf(v, __shfl_xor(v, 16)); v = fmaxf(v, __shfl_xor(v, 32)); mx[ai][m] = v;
                if (fq == 0) X1[(ai * HALF + wr * 64 + m * 16 + fr) * 4 + wc] = v; }
        asm volatile("s_waitcnt lgkmcnt(0)" ::: "memory"); __builtin_amdgcn_s_barrier(); asm volatile("" ::: "memory");
        float sm[2][4];
#pragma unroll
        for (int ai = 0; ai < 2; ++ai)
#pragma unroll
            for (int m = 0; m < 4; ++m) { const f32x4 q = *(const LAS f32x4*)(X1 + (ai * HALF + wr * 64 + m * 16 + fr) * 4); const float M_ = fmaxf(fmaxf(q[0], q[1]), fmaxf(q[2], q[3])); float s = 0.f;
#pragma unroll
                for (int bj = 0; bj < 2; ++bj)
#pragma unroll
                    for (int n = 0; n < 2; ++n) { f32x4 x = acc[ai][bj][m][n];
#pragma unroll
                        for (int i = 0; i < 4; ++i) { x[i] = fast_exp2(x[i] - M_); s += x[i]; } acc[ai][bj][m][n] = x; }
                s += __shfl_xor(s, 16); s += __shfl_xor(s, 32); sm[ai][m] = s;
                if (fq == 0) X2[(ai * HALF + wr * 64 + m * 16 + fr) * 4 + wc] = s; }
        asm volatile("s_waitcnt lgkmcnt(0)" ::: "memory"); __builtin_amdgcn_s_barrier(); asm volatile("" ::: "memory");
        bf16* p0 = P + ((size_t)u.pm * BM + wr * 64 + fr) * DM + u.pn * BM + wc * 32 + 8 * fq;
#pragma unroll
        for (int ai = 0; ai < 2; ++ai)
#pragma unroll
            for (int m = 0; m < 4; ++m) { const f32x4 q = *(const LAS f32x4*)(X2 + (ai * HALF + wr * 64 + m * 16 + fr) * 4); const float inv = fast_rcp((q[0] + q[1]) + (q[2] + q[3]));
                bf16* rowp = p0 + (size_t)(ai * HALF + m * 16) * DM;
#pragma unroll
                for (int bj = 0; bj < 2; ++bj) { const f32x4 v0 = acc[ai][bj][m][0] * inv, v1 = acc[ai][bj][m][1] * inv; u32x4 w; w.x = cvt_pk_bf16(v0[0], v0[1]); w.y = cvt_pk_bf16(v0[2], v0[3]); w.z = cvt_pk_bf16(v1[0], v1[1]); w.w = cvt_pk_bf16(v1[2], v1[3]);
                    *(u32x4*)(rowp + bj * HALF) = w; } }
        (void)mx; (void)sm;
    }
};
struct EpiSwiGLU {
    static constexpr bool PERM = true, AFTER_DRAIN = false;
    bf16* HID;
    __device__ __forceinline__ void operator()(f32x4 (&acc)[2][2][4][2], const Unit& u, int wr, int wc, int fr, int fq) const {
        bf16* p0 = HID + ((size_t)u.pm * BM + wr * 64 + fr) * EFF + u.pn * 128 + wc * 32 + 8 * fq;
#pragma unroll
        for (int ai = 0; ai < 2; ++ai)
#pragma unroll
            for (int m = 0; m < 4; ++m) { f32x4 v0 = acc[ai][0][m][0], v1 = acc[ai][0][m][1]; const f32x4 g0 = acc[ai][1][m][0], g1 = acc[ai][1][m][1];
#pragma unroll
                for (int i = 0; i < 4; ++i) { v0[i] = siluf_(v0[i]) * g0[i]; v1[i] = siluf_(v1[i]) * g1[i]; }
                u32x4 w; w.x = cvt_pk_bf16(v0[0], v0[1]); w.y = cvt_pk_bf16(v0[2], v0[3]); w.z = cvt_pk_bf16(v1[0], v1[1]); w.w = cvt_pk_bf16(v1[2], v1[3]);
                *(u32x4*)(p0 + (size_t)(ai * HALF + m * 16) * EFF) = w; }
    }
};
struct EpiMoeOut {
    static constexpr bool PERM = true, AFTER_DRAIN = false;
    bf16* CB; const float* GATE;
    __device__ __forceinline__ void operator()(f32x4 (&acc)[2][2][4][2], const Unit& u, int wr, int wc, int fr, int fq) const {
        const int colb = u.pn * BM + wc * 32 + 8 * fq;
#pragma unroll
        for (int ai = 0; ai < 2; ++ai)
#pragma unroll
            for (int m = 0; m < 4; ++m) { const int r = ai * HALF + wr * 64 + m * 16 + fr;
                if (r < u.nv) { const int dest = u.rl[r]; const float g = GATE[dest]; bf16* rowp = CB + (size_t)dest * DM + colb;
#pragma unroll
                    for (int bj = 0; bj < 2; ++bj) { const f32x4 v0 = acc[ai][bj][m][0] * g, v1 = acc[ai][bj][m][1] * g; u32x4 w; w.x = cvt_pk_bf16(v0[0], v0[1]); w.y = cvt_pk_bf16(v0[2], v0[3]); w.z = cvt_pk_bf16(v1[0], v1[1]); w.w = cvt_pk_bf16(v1[2], v1[3]);
                        *(u32x4*)(rowp + bj * HALF) = w; } } }
    }
};

struct DenseOrder {
    const char* A; const char* Bt; int lda, ldb, nM, nN, G, c;
    __device__ __forceinline__ bool next(int i, Unit& u) const {
        const int L = i * G + c; if (L >= nM * nN) return false;
        tile_of(L, nM, nN, u.pm, u.pn); u.a = A + (size_t)u.pm * BM * lda * 2; u.b = Bt + (size_t)u.pn * BM * ldb * 2; u.rl = nullptr; u.nv = 256; u.e = 0; return true;
    }
};
struct ProjOrder {
    const char* HB; const char* WIN; const char* MEMB; const char* WK; const char* WV; int G, c;
    __device__ __forceinline__ bool next(int i, Unit& u) const {
        const int L = i * G + c; constexpr int NP = (MTOK / 256) * (NIN / 256);
        if (L >= NP + 32) return false;
        u.rl = nullptr; u.nv = 256;
        if (L < NP) { tile_of(L, MTOK / 256, NIN / 256, u.pm, u.pn); u.a = HB + (size_t)u.pm * BM * DM * 2; u.b = WIN + (size_t)u.pn * BM * DM * 2; u.e = 0; }
        else { const int j = L - NP; u.pm = (j & 15) >> 2; u.pn = j & 3;
            if (j < 16) { u.a = MEMB + (size_t)u.pm * BM * DM * 2; u.b = WK + (size_t)u.pn * BM * DM * 2; u.e = 1; }
            else { u.a = WV + (size_t)u.pm * BM * DM * 2; u.b = MEMB + (size_t)u.pn * BM * DM * 2; u.e = 2; } }
        return true;
    }
};
struct XattnOrder {
    const char* A; const char* B; int mode, G, c;
    __device__ __forceinline__ bool next(int i, Unit& u) const {
        const int L = i * G + c; if (L >= (MTOK / 256) * 4) return false;
        tile_of(L, MTOK / 256, 4, u.pm, u.pn); const int bt = u.pm / (SEQ / 256);
        u.a = A + ((size_t)u.pm * BM * DM + u.pn * 256) * 2;
        u.b = mode == 0 ? B + ((size_t)bt * 256 * DM + u.pn * 256) * 2 : B + ((size_t)u.pn * 256 * DM + bt * 256) * 2;
        u.rl = nullptr; u.nv = 256; u.e = 0; return true;
    }
};
struct MoeOrder {
    const char* A; const char* W; const int* LIST; const LAS int* T; int mode  , G, c;
    __device__ __forceinline__ bool next(int i, Unit& u) const {
        const int L = i * G + c; const int ntile = T[16]; if (L >= ntile * 4) return false;
        const int mt = L >> 2; u.pn = L & 3; int e = 0;
#pragma unroll
        for (int j = 1; j < 16; ++j) e += (T[j] <= mt) ? 1 : 0;
        const int r0 = (mt - T[e]) * 256, ne = T[32 + e];
        u.e = e; u.pm = mt; u.nv = (ne - r0) < 256 ? (ne - r0) : 256; u.rl = LIST + (size_t)e * MTOK + r0;
        if (mode == 0) { u.a = A; u.b = W + ((size_t)e * 1024 + u.pn * 256) * DM * 2; }
        else { u.a = A + (size_t)mt * BM * EFF * 2; u.b = W + ((size_t)e * 1024 + u.pn * 256) * EFF * 2; }
        return true;
    }
};
}
#define XB_TMO      128
#define XB_XCNT(j)  (256  + 64 * (j))
#define XB_XSUB(j)  (1280 + 64 * (j))
#define XB_XGEN(j)  (2304 + 64 * (j))
#define XB_TOP      3328
#define XB_TOPGEN   3392
#define XCD_BAR_WORDS 3456
#define XB_SPIN_CAP (1u << 18)
__device__ __forceinline__ unsigned xb_ld(unsigned* p)              { return __hip_atomic_load(p, __ATOMIC_RELAXED, __HIP_MEMORY_SCOPE_AGENT); }
__device__ __forceinline__ unsigned xb_add(unsigned* p, unsigned v) { return __hip_atomic_fetch_add(p, v, __ATOMIC_RELAXED, __HIP_MEMORY_SCOPE_AGENT); }
__device__ __forceinline__ unsigned xb_xcc_id() { return (unsigned)__builtin_amdgcn_s_getreg((3 << 11) | 20) & 0xFu; }
#define XB_SPIN(cond, bar) do { unsigned _sp = 0; while (cond) { __builtin_amdgcn_s_sleep(1); \
    if ((++_sp & 255u) == 0u) { if (xb_ld(&(bar)[XB_TMO])) break; if (_sp > XB_SPIN_CAP) { atomicAdd(&(bar)[XB_TMO], 1u); break; } } } } while (0)
struct XcdBarrier { unsigned* bar; unsigned x; volatile LAS unsigned* st; };
__device__ __forceinline__ XcdBarrier xcd_barrier_post(unsigned* bar, volatile LAS unsigned* st) {
    XcdBarrier b; b.bar = bar; b.x = xb_xcc_id(); b.st = st;
    if (threadIdx.x == 0) (void)xb_add(&bar[XB_XCNT(b.x)], 1u);
    return b;
}
__device__ __forceinline__ void xcd_barrier_complete(unsigned* bar, unsigned x, unsigned& nloc, unsigned& nx) {
    const unsigned G = gridDim.x * gridDim.y * gridDim.z;
    unsigned sum, cnt, mine, sp = 0u;
    for (;;) {
        sum = 0u; cnt = 0u; mine = 0u;
#pragma unroll
        for (unsigned j = 0; j < 16; ++j) { const unsigned c = xb_ld(&bar[XB_XCNT(j)]); sum += c; cnt += (c > 0u) ? 1u : 0u; mine = (j == x) ? c : mine; }
        if (sum == G) break;
        __builtin_amdgcn_s_sleep(1);
        if ((++sp & 255u) == 0u) { if (xb_ld(&bar[XB_TMO])) break; if (sp > XB_SPIN_CAP) { atomicAdd(&bar[XB_TMO], 1u); break; } }
    }
    nloc = mine > 0u ? mine : 1u; nx = cnt > 0u ? cnt : 1u;
}
__device__ __forceinline__ void xcd_barrier(const XcdBarrier& b) {
    asm volatile("s_waitcnt vmcnt(0)" ::: "memory");
    __syncthreads();
    if (threadIdx.x == 0) {
        unsigned* bar = b.bar;
        __builtin_amdgcn_s_waitcnt(0);
        unsigned nloc = b.st[0], nx = b.st[1];
        if (nloc == 0u) { xcd_barrier_complete(bar, b.x, nloc, nx); b.st[0] = nloc; b.st[1] = nx; }
        const unsigned old = xb_add(&bar[XB_XSUB(b.x)], 1u);
        const unsigned gen = old / nloc;
        if (old + 1u == (gen + 1u) * nloc) {
            __builtin_amdgcn_fence(__ATOMIC_RELEASE, "agent");
            asm volatile("s_waitcnt vmcnt(0)" ::: "memory");
            const unsigned og = xb_add(&bar[XB_TOP], 1u);
            const unsigned tg = og / nx;
            if (og + 1u == (tg + 1u) * nx) xb_add(&bar[XB_TOPGEN], 1u);
            else XB_SPIN(xb_ld(&bar[XB_TOPGEN]) == tg, bar);
            __builtin_amdgcn_fence(__ATOMIC_ACQUIRE, "agent");
            xb_add(&bar[XB_XGEN(b.x)], 1u);
            asm volatile("s_waitcnt vmcnt(0)" ::: "memory");
        } else {
            XB_SPIN(xb_ld(&bar[XB_XGEN(b.x)]) == gen, bar);
            __builtin_amdgcn_fence(__ATOMIC_ACQUIRE, "agent");
            asm volatile("s_waitcnt vmcnt(0)" ::: "memory");
        }
    }
    __syncthreads();
}

struct Args { const float* in[25]; float* out; unsigned char* ws; int ph_lo, ph_hi; };
enum { I_X = 0, I_MEM, I_LNIG, I_LNIB, I_WIN, I_FB, I_LQ1, I_LK1, I_LQ2, I_LK2, I_DNG, I_HLB, I_HNG, I_WOUT, I_WQ, I_WK, I_WV, I_WO, I_RW, I_RB, I_W1, I_W3, I_W2, I_LNG, I_LNB };

struct Frame {
    LAS unsigned char* lds; unsigned char* ws; gu32* ctl; float* out;
    int tid, lane, wave, G, bid;
};
#define WSP(T, off) ((T*)(F.ws + (off)))

__device__ __forceinline__ void tr_item(const float* W, int ldsrc, int nsrc0, bf16* WT, int ldd, int ndst0, int k0, LAS float* scr, int lane) {
#pragma unroll 8
    for (int i = 0; i < 32; ++i) { const int kk = 2 * i + (lane >> 5); scr[kk * 33 + (lane & 31)] = W[(size_t)(k0 + kk) * ldsrc + nsrc0 + (lane & 31)]; }
    LDS_WAIT(); asm volatile("" ::: "memory");
    const int c = lane & 7;
#pragma unroll
    for (int j = 0; j < 4; ++j) { const int n = (lane >> 3) + 8 * j; const LAS float* s = scr + (8 * c) * 33 + n;
        u32x4 o; o.x = cvt_pk_bf16(s[0 * 33], s[1 * 33]); o.y = cvt_pk_bf16(s[2 * 33], s[3 * 33]); o.z = cvt_pk_bf16(s[4 * 33], s[5 * 33]); o.w = cvt_pk_bf16(s[6 * 33], s[7 * 33]);
        *(u32x4*)(WT + (size_t)(ndst0 + n) * ldd + k0 + 8 * c) = o; }
    LDS_WAIT(); asm volatile("" ::: "memory");
}
__device__ __forceinline__ void convert_weights(const Frame& F, const Args& A, int l) {
    LAS float* scr = (LAS float*)(F.lds + RING_OFF + F.wave * 16384);
    const int gw = F.bid * NWAVES + F.wave, NGW = F.G * NWAVES;
    constexpr int I_IN = 16 * 112, I_SQ = 16 * 32, I_13 = 16 * 2 * 16 * 16, I_2 = 16 * 8 * 32;
    constexpr int NITEMS = I_IN + 5 * I_SQ + I_13 + I_2;
    for (int it = gw; it < NITEMS; it += NGW) {
        int r = it;
        if (r < I_IN) { const int kb = r / 112, nb = r % 112; const int nd = nb * 32, ns = nd < 768 ? nd : nd + 4;
            tr_item(A.in[I_WIN] + (size_t)l * DM * INW, INW, ns, WSP(bf16, WS_WIN), DM, nd, kb * 64, scr, F.lane); continue; }
        r -= I_IN;
        if (r < 5 * I_SQ) { const int w = r / I_SQ, rr = r % I_SQ, kb = rr / 32, nb = rr % 32;
            const float* src = (w == 0 ? A.in[I_WOUT] : w == 1 ? A.in[I_WQ] : w == 2 ? A.in[I_WK] : w == 3 ? A.in[I_WV] : A.in[I_WO]) + (size_t)l * DM * DM;
            bf16* dst = (bf16*)(F.ws + (w == 0 ? WS_WOUT : w == 1 ? WS_WQ : w == 2 ? WS_WK : w == 3 ? WS_WV : WS_WO));
            tr_item(src, DM, nb * 32, dst, DM, nb * 32, kb * 64, scr, F.lane); continue; }
        r -= 5 * I_SQ;
        if (r < I_13) { const int e = r / 512, rr = r % 512, which = rr / 256, r2 = rr % 256, kb = r2 / 16, nb = r2 % 16;
            const float* src = (which == 0 ? A.in[I_W1] : A.in[I_W3]) + ((size_t)l * NEXP + e) * DM * EFF;
            const int j0 = nb * 32, nd = (j0 / 128) * 256 + which * 128 + (j0 % 128);
            tr_item(src, EFF, j0, WSP(bf16, WS_W13) + (size_t)e * 1024 * DM, DM, nd, kb * 64, scr, F.lane); continue; }
        r -= I_13;
        { const int e = r / 256, rr = r % 256, kb = rr / 32, nb = rr % 32;
            const float* src = A.in[I_W2] + ((size_t)l * NEXP + e) * EFF * DM;
            tr_item(src, DM, nb * 32, WSP(bf16, WS_W2) + (size_t)e * 1024 * EFF, EFF, nb * 32, kb * 64, scr, F.lane); }
    }
}

__device__ __forceinline__ void ln_regs(f32x4 (&v)[4], const float* g, const float* b, int lane) {
    float s = 0.f;
#pragma unroll
    for (int j = 0; j < 4; ++j) s += (v[j].x + v[j].y) + (v[j].z + v[j].w);
    const float mean = wave_sum(s) * (1.f / DM); float s2 = 0.f;
#pragma unroll
    for (int j = 0; j < 4; ++j) { v[j] = v[j] - mean; s2 += (v[j].x * v[j].x + v[j].y * v[j].y) + (v[j].z * v[j].z + v[j].w * v[j].w); }
    const float rstd = 1.f / sqrtf(wave_sum(s2) * (1.f / DM) + LN_EPS);
#pragma unroll
    for (int j = 0; j < 4; ++j) { const f32x4 gg = *(const f32x4*)(g + 4 * lane + 256 * j), bb = *(const f32x4*)(b + 4 * lane + 256 * j); v[j] = v[j] * rstd * gg + bb; }
}
__device__ __forceinline__ void store_row(const f32x4 (&v)[4], float* o32, bf16* o16, int lane) {
#pragma unroll
    for (int j = 0; j < 4; ++j) { if (o32) *(f32x4*)(o32 + 4 * lane + 256 * j) = v[j];
        if (o16) { u32x2 w; w.x = cvt_pk_bf16(v[j].x, v[j].y); w.y = cvt_pk_bf16(v[j].z, v[j].w); *(u32x2*)(o16 + 4 * lane + 256 * j) = w; } }
}
__device__ __forceinline__ void fox_forget(const f32x4 (&v)[4], const LAS float* WF, const float* fb, float* lf2row, int lane) {
    f32x4 a = {0.f, 0.f, 0.f, 0.f};
#pragma unroll
    for (int j = 0; j < 4; ++j)
#pragma unroll
        for (int i = 0; i < 4; ++i) { const f32x4 w = *(const LAS f32x4*)(WF + (4 * lane + 256 * j + i) * 4); a = a + w * v[j][i]; }
#pragma unroll
    for (int c = 0; c < 4; ++c) a[c] = wave_sum(a[c]);
    if (lane == 0) { f32x4 o;
#pragma unroll
        for (int c = 0; c < 4; ++c) o[c] = log_sigmoidf_(a[c] + fb[c]) * LOG2E;
        *(f32x4*)lf2row = o; }
}
__device__ __forceinline__ void load_wf(const Frame& F, const Args& A, int l, LAS float* WF) {
    const float* w = A.in[I_WIN] + (size_t)l * DM * INW + 768;
    for (int k = F.tid; k < DM; k += NTHR) *(LAS f32x4*)(WF + 4 * k) = *(const f32x4*)(w + (size_t)k * INW);
    __syncthreads();
}

__device__ __forceinline__ void phase_prologue(const Frame& F, const Args& A) {
    convert_weights(F, A, 0);
    __syncthreads();
    LAS float* WF = (LAS float*)(F.lds + XCH_OFF - 16384);
    load_wf(F, A, 0, WF);
    const int gw = F.bid * NWAVES + F.wave, NGW = F.G * NWAVES;
    for (int m = gw; m < NB * 256; m += NGW) { f32x4 v[4];
#pragma unroll
        for (int j = 0; j < 4; ++j) v[j] = *(const f32x4*)(A.in[I_MEM] + (size_t)m * DM + 4 * F.lane + 256 * j);
        store_row(v, nullptr, WSP(bf16, WS_MEMB) + (size_t)m * DM, F.lane); }
    for (int m = gw; m < MTOK; m += NGW) { f32x4 v[4];
#pragma unroll
        for (int j = 0; j < 4; ++j) v[j] = *(const f32x4*)(A.in[I_X] + (size_t)m * DM + 4 * F.lane + 256 * j);
        ln_regs(v, A.in[I_LNIG], A.in[I_LNIB], F.lane);
        store_row(v, F.out + (size_t)m * DM, WSP(bf16, WS_R1) + (size_t)m * DM, F.lane);
        fox_forget(v, WF, A.in[I_FB], WSP(float, WS_LF2) + (size_t)m * 4, F.lane); }
}
__device__ __forceinline__ void phase_ln1(const Frame& F, const Args& A, int l) {
    const int gw = F.bid * NWAVES + F.wave, NGW = F.G * NWAVES;
    const float* g = A.in[I_LNG] + (size_t)(l * 3 + 0) * DM; const float* b = A.in[I_LNB] + (size_t)(l * 3 + 0) * DM;
    for (int m = gw; m < MTOK; m += NGW) { f32x4 v[4];
#pragma unroll
        for (int j = 0; j < 4; ++j) v[j] = *(const f32x4*)(F.out + (size_t)m * DM + 4 * F.lane + 256 * j);
        ln_regs(v, g, b, F.lane);
        store_row(v, F.out + (size_t)m * DM, WSP(bf16, WS_R1) + (size_t)m * DM, F.lane); }
}
__device__ __forceinline__ void phase_ln3(const Frame& F, const Args& A, int l) {
    LAS float* WF = (LAS float*)(F.lds + XCH_OFF - 16384);
    if (l == 0) { convert_weights(F, A, 1); __syncthreads(); load_wf(F, A, 1, WF); }
    const int gw = F.bid * NWAVES + F.wave, NGW = F.G * NWAVES;
    const float* g = A.in[I_LNG] + (size_t)(l * 3 + 2) * DM; const float* b = A.in[I_LNB] + (size_t)(l * 3 + 2) * DM;
    const bf16* CB = WSP(bf16, WS_CB);
    for (int m = gw; m < MTOK; m += NGW) { f32x4 v[4];
#pragma unroll
        for (int j = 0; j < 4; ++j) { v[j] = *(const f32x4*)(F.out + (size_t)m * DM + 4 * F.lane + 256 * j);
            const u32x2 c0 = *(const u32x2*)(CB + (size_t)(2 * m) * DM + 4 * F.lane + 256 * j), c1 = *(const u32x2*)(CB + (size_t)(2 * m + 1) * DM + 4 * F.lane + 256 * j);
            v[j].x = v[j].x * ALPHA + (__uint_as_float(c0.x << 16) + __uint_as_float(c1.x << 16)); v[j].y = v[j].y * ALPHA + (__uint_as_float(c0.x & 0xffff0000u) + __uint_as_float(c1.x & 0xffff0000u));
            v[j].z = v[j].z * ALPHA + (__uint_as_float(c0.y << 16) + __uint_as_float(c1.y << 16)); v[j].w = v[j].w * ALPHA + (__uint_as_float(c0.y & 0xffff0000u) + __uint_as_float(c1.y & 0xffff0000u)); }
        ln_regs(v, g, b, F.lane);
        store_row(v, F.out + (size_t)m * DM, l == 0 ? WSP(bf16, WS_R1) + (size_t)m * DM : nullptr, F.lane);
        if (l == 0) fox_forget(v, WF, A.in[I_FB] + 4, WSP(float, WS_LF2) + (size_t)m * 4, F.lane); }
}
__device__ __forceinline__ void fox_cumsum(const Frame& F) {
    if (F.bid >= 16) return;
    const int b = F.bid >> 2, h = F.bid & 3; const float* src = WSP(float, WS_LF2) + (size_t)b * SEQ * 4 + h; float* dst = WSP(float, WS_CUMF) + (size_t)F.bid * SEQ;
    LAS float* tot = (LAS float*)(F.lds + XCH_OFF);
    float v[16]; float run = 0.f;
#pragma unroll
    for (int i = 0; i < 16; ++i) { run += src[(size_t)(F.tid * 16 + i) * 4]; v[i] = run; }
    float inc = run;
#pragma unroll
    for (int o = 1; o < 64; o <<= 1) { const float t = __shfl_up(inc, o); if (F.lane >= o) inc += t; }
    if (F.lane == 63) tot[F.wave] = inc;
    __syncthreads();
    float base = inc - run;
    for (int w = 0; w < F.wave; ++w) base += tot[w];
#pragma unroll
    for (int i = 0; i < 16; ++i) dst[F.tid * 16 + i] = v[i] + base;
    __syncthreads();
}
__device__ __forceinline__ void phase_ln2_route(const Frame& F, const Args& A, int l) {
    LAS float* RW = (LAS float*)(F.lds + RING_OFF);
    LAS int* REC = (LAS int*)(F.lds + RING_OFF + 65536);
    LAS int* CNT = (LAS int*)(F.lds + RING_OFF + 65536 + 2048);
    LAS int* BASE = CNT + 16; LAS int* NREC = CNT + 32;
    for (int i = F.tid; i < DM * 16 / 4; i += NTHR) *(LAS f32x4*)(RW + 4 * i) = *(const f32x4*)(A.in[I_RW] + 4 * i);
    if (F.tid < 16) CNT[F.tid] = 0;
    __syncthreads();
    const int gw = F.bid * NWAVES + F.wave, NGW = F.G * NWAVES;
    const float* g = A.in[I_LNG] + (size_t)(l * 3 + 1) * DM; const float* b = A.in[I_LNB] + (size_t)(l * 3 + 1) * DM;
    float* GATE = WSP(float, WS_GATE);
    int nrec = 0;
    for (int m = gw; m < MTOK; m += NGW, ++nrec) { f32x4 v[4];
#pragma unroll
        for (int j = 0; j < 4; ++j) v[j] = *(const f32x4*)(F.out + (size_t)m * DM + 4 * F.lane + 256 * j);
        ln_regs(v, g, b, F.lane);
        store_row(v, F.out + (size_t)m * DM, WSP(bf16, WS_R1) + (size_t)m * DM, F.lane);
        f32x4 a[4];
#pragma unroll
        for (int q = 0; q < 4; ++q) a[q] = (f32x4){0.f, 0.f, 0.f, 0.f};
#pragma unroll
        for (int j = 0; j < 4; ++j)
#pragma unroll
            for (int i = 0; i < 4; ++i) { const LAS float* wr = RW + (4 * F.lane + 256 * j + i) * 16; const float x = v[j][i];
#pragma unroll
                for (int q = 0; q < 4; ++q) a[q] = a[q] + *(const LAS f32x4*)(wr + 4 * q) * x; }
        float sc[16], bi[16];
#pragma unroll
        for (int q = 0; q < 4; ++q)
#pragma unroll
            for (int i = 0; i < 4; ++i) { const float lg = wave_sum(a[q][i]); const float s = 1.f / (1.f + __expf(-lg)); sc[q * 4 + i] = s; bi[q * 4 + i] = s + A.in[I_RB][q * 4 + i]; }
        int gs = 0; float best = -INFINITY;
#pragma unroll
        for (int q = 0; q < 4; ++q) { float m1 = -INFINITY, m2 = -INFINITY;
#pragma unroll
            for (int i = 0; i < 4; ++i) { const float x = bi[q * 4 + i]; if (x > m1) { m2 = m1; m1 = x; } else if (x > m2) m2 = x; }
            const float s = m1 + m2; if (s > best) { best = s; gs = q; } }
        float bq[4], sq[4];
#pragma unroll
        for (int i = 0; i < 4; ++i) { bq[i] = gs == 0 ? bi[i] : gs == 1 ? bi[4 + i] : gs == 2 ? bi[8 + i] : bi[12 + i]; sq[i] = gs == 0 ? sc[i] : gs == 1 ? sc[4 + i] : gs == 2 ? sc[8 + i] : sc[12 + i]; }
        int i0 = 0; float b0 = bq[0];
#pragma unroll
        for (int i = 1; i < 4; ++i) if (bq[i] > b0) { b0 = bq[i]; i0 = i; }
        int i1 = -1; float b1 = -INFINITY;
#pragma unroll
        for (int i = 0; i < 4; ++i) if (i != i0 && bq[i] > b1) { b1 = bq[i]; i1 = i; }
        const float s0 = i0 == 0 ? sq[0] : i0 == 1 ? sq[1] : i0 == 2 ? sq[2] : sq[3];
        const float s1 = i1 == 0 ? sq[0] : i1 == 1 ? sq[1] : i1 == 2 ? sq[2] : sq[3];
        const int e0 = gs * 4 + i0, e1 = gs * 4 + i1;
        if (F.lane == 0) { const float inv = 1.f / (s0 + s1); GATE[2 * m] = s0 * inv; GATE[2 * m + 1] = s1 * inv;
            const int r0 = __hip_atomic_fetch_add(&CNT[e0], 1, __ATOMIC_RELAXED, __HIP_MEMORY_SCOPE_WORKGROUP), r1 = __hip_atomic_fetch_add(&CNT[e1], 1, __ATOMIC_RELAXED, __HIP_MEMORY_SCOPE_WORKGROUP);
            LAS int* rec = REC + (F.wave * 16 + nrec) * 4; rec[0] = m; rec[1] = e0; rec[2] = e1; rec[3] = r0 | (r1 << 16); }
    }
    if (F.lane == 0) NREC[F.wave] = nrec;
    __syncthreads();
    if (F.tid < 16) BASE[F.tid] = (int)__hip_atomic_fetch_add((unsigned*)(F.ctl + CW_ECNT + (l * 16 + F.tid) * 64), (unsigned)CNT[F.tid], RLX_AGENT);
    __syncthreads();
    int* LIST = WSP(int, WS_LIST);
    if (F.tid < 128) { const int w = F.tid >> 4, i = F.tid & 15; const int cnt_w = NREC[w];
        if (i < cnt_w) { const LAS int* rec = REC + F.tid * 4; const int m = rec[0], e0 = rec[1], e1 = rec[2], rr = rec[3];
            LIST[(size_t)e0 * MTOK + BASE[e0] + (rr & 0xffff)] = 2 * m; LIST[(size_t)e1 * MTOK + BASE[e1] + (rr >> 16)] = 2 * m + 1; } }
    __syncthreads();
}
__device__ __forceinline__ void moe_tables(const Frame& F, int l) {
    LAS int* T = (LAS int*)(F.lds + TAB_OFF);
    if (F.tid == 0) { int cum = 0;
        for (int e = 0; e < 16; ++e) { const int n = (int)__hip_atomic_load((unsigned*)(F.ctl + CW_ECNT + (l * 16 + e) * 64), RLX_AGENT); T[e] = cum; T[32 + e] = n; cum += (n + 255) >> 8; }
        T[16] = cum; }
    __syncthreads();
}
namespace att {
constexpr int SLOTB = 8192;
constexpr int L_K = 0, L_V = 2 * SLOTB, L_KX = 4 * SLOTB, L_WS = L_KX + 2 * 2048, L_OST = L_WS + NWAVES * 256, L_END = L_OST + NWAVES * 8192;
static_assert(L_END <= RING_BYTES, "attention LDS");
__device__ __forceinline__ int crow(int r, int hi) { return (r & 3) + 8 * (r >> 2) + 4 * hi; }
__device__ __forceinline__ void glds16(const void* gsrc, unsigned lds_dst) { unsigned keep;
    asm volatile("s_mov_b32 %0, m0\n\ts_mov_b32 m0, %2\n\ts_nop 0\n\tglobal_load_lds_dwordx4 %1, off\n\ts_mov_b32 m0, %0" : "=&s"(keep) : "v"(gsrc), "s"(lds_dst) : "memory"); }
#define ATT_WAIT_BAR() asm volatile("s_waitcnt vmcnt(0) lgkmcnt(0)\n\ts_barrier" ::: "memory")
typedef short v4i16_t __attribute__((ext_vector_type(4)));
__device__ __forceinline__ s16x4 vtr(const LAS unsigned char* p) { return __builtin_bit_cast(s16x4, __builtin_amdgcn_ds_read_tr16_b64_v4i16((LAS v4i16_t*)p)); }
__device__ __forceinline__ float rowmax32(const f32x16& p0, const f32x16& p1) {
    float a = fmaxf(p0[0], p1[0]);
#pragma unroll
    for (int r = 1; r < 16; ++r) a = fmaxf(a, fmaxf(p0[r], p1[r]));
    auto rr = __builtin_amdgcn_permlane32_swap(__float_as_uint(a), __float_as_uint(a), false, false);
    return fmaxf(__uint_as_float(rr[0]), __uint_as_float(rr[1]));
}
__device__ __forceinline__ float half_sum(float a) { auto rr = __builtin_amdgcn_permlane32_swap(__float_as_uint(a), __float_as_uint(a), false, false); return __uint_as_float(rr[0]) + __uint_as_float(rr[1]); }
__device__ __forceinline__ bf16x8 pack8(const f32x16& p, int b) { u32x4 w; w.x = cvt_pk_bf16(p[b], p[b + 1]); w.y = cvt_pk_bf16(p[b + 2], p[b + 3]); w.z = cvt_pk_bf16(p[b + 4], p[b + 5]); w.w = cvt_pk_bf16(p[b + 6], p[b + 7]); return __builtin_bit_cast(bf16x8, w); }

__device__ __forceinline__ void softmax_step(f32x16& p0, f32x16& p1, float& m, float& l, f32x16 (&o)[2], bf16x8 (&pa)[4], LAS float* wsf, int r32, int hi) {
    const float rm = rowmax32(p0, p1); const float mn = fmaxf(m, rm);
    if (__any(mn > m)) {
        const float al = fast_exp2(m - mn); l *= al;
        if (hi == 0) wsf[r32] = al;
        LDS_WAIT();
#pragma unroll
        for (int g = 0; g < 4; ++g) { const f32x4 f = *(const LAS f32x4*)(wsf + 4 * hi + 8 * g);
#pragma unroll
            for (int i = 0; i < 4; ++i) { o[0][4 * g + i] *= f[i]; o[1][4 * g + i] *= f[i]; } }
        m = mn;
    }
    float s = 0.f;
#pragma unroll
    for (int r = 0; r < 16; ++r) { p0[r] = fast_exp2(p0[r] - m); p1[r] = fast_exp2(p1[r] - m); s += p0[r] + p1[r]; }
    l += s;
    pa[0] = pack8(p0, 0); pa[1] = pack8(p0, 8); pa[2] = pack8(p1, 0); pa[3] = pack8(p1, 8);
}

template <int MODE>
__device__ __forceinline__ void attn_unit(const Frame& F, const Args& A, int l, int b, int h, int qb) {
    LAS unsigned char* shm = F.lds + RING_OFF;
    const int lane = F.lane, r32 = lane & 31, hi = lane >> 5, wid = F.wave;
    const bf16* PA = WSP(bf16, WS_PA);
    const size_t rowbase = (size_t)b * SEQ; const int q0 = qb * 256;
    constexpr int QC = MODE == 0 ? 0 : 768, KC = MODE == 0 ? 256 : 1024, VC = MODE == 0 ? 512 : 1280;
    const bf16* Qw = PA + (rowbase + q0 + wid * 32 + r32) * PA_LD + QC + h * 64;
    const bf16* Kh = PA + rowbase * PA_LD + KC + h * 64; const bf16* Vh = PA + rowbase * PA_LD + VC + h * 64;
    const unsigned lds0 = (unsigned)(uintptr_t)shm;
    LAS float* wsf = (LAS float*)(shm + L_WS) + wid * 64;
    const bf16* ksrc = Kh + (size_t)lane * PA_LD + wid * 8;
    const bf16* vsrc = Vh + (size_t)(16 * (wid & 3) + (lane >> 2)) * PA_LD + (wid >> 2) * 32 + (lane & 3) * 8;
    const unsigned kdst = lds0 + L_K + wid * 1024, vdst = lds0 + L_V + wid * 1024;
#define DMA_KV(t, slot) do { glds16(ksrc + (size_t)(t) * 64 * PA_LD, (unsigned)__builtin_amdgcn_readfirstlane(kdst + (slot) * SLOTB)); glds16(vsrc + (size_t)(t) * 64 * PA_LD, (unsigned)__builtin_amdgcn_readfirstlane(vdst + (slot) * SLOTB)); } while (0)
    bf16x8 qr[4];
#pragma unroll
    for (int d0 = 0; d0 < 4; ++d0) qr[d0] = *(const bf16x8*)(Qw + d0 * 16 + hi * 8);
    const int NT = 4 * qb + 4;
    const float* cum = WSP(float, WS_CUMF) + (size_t)(b * 4 + h) * SEQ;
    float cq0 = 0.f; if (MODE == 0) cq0 = cum[q0];
#define TILE_OF(i) (MODE == 0 ? (NT - 1 - (i)) : (i))
#define KX_LOAD(t) (cq0 - cum[(t) * 64 + F.tid])
#define KX_STORE(slot, bv) do { const float b_ = (bv); const unsigned hb_ = cvt_pk_bf16(b_, 0.f) & 0xffffu; const float lo_ = b_ - __uint_as_float(hb_ << 16); u32x4 w_; w_.x = hb_ | (cvt_pk_bf16(lo_, 0.f) << 16); w_.y = 0u; w_.z = 0u; w_.w = 0u; \
        *(LAS u32x4*)(shm + L_KX + (slot) * 2048 + F.tid * 16) = w_; } while (0)
    float kxv = 0.f;
    DMA_KV(TILE_OF(0), 0);
    if (MODE == 0 && F.tid < 64) { kxv = KX_LOAD(TILE_OF(0)); KX_STORE(0, kxv); }
    float m1 = -INFINITY, l1 = 0.f, m2 = -INFINITY, l2 = 0.f;
    f32x16 o1[2], o2[2];
#pragma unroll
    for (int d = 0; d < 2; ++d) { o1[d] = f32x16{}; o2[d] = f32x16{}; }
    u32x4 qxw; qxw.x = hi == 0 ? 0x3F803F80u : 0u; qxw.y = 0u; qxw.z = 0u; qxw.w = 0u; const bf16x8 qx = __builtin_bit_cast(bf16x8, qxw);
    const int qmin = q0 + wid * 32, qrow = qmin + r32;
    ATT_WAIT_BAR();
    for (int i = 0; i < NT; ++i) {
        const int cur = i & 1, t = TILE_OF(i);
        if (i + 1 < NT) { DMA_KV(TILE_OF(i + 1), cur ^ 1); if (MODE == 0 && F.tid < 64) kxv = KX_LOAD(TILE_OF(i + 1)); }
        const bool active = MODE == 0 ? (64 * t <= qmin + 31) : (t <= 4 * qb + (wid >> 1));
        if (active) {
            const LAS unsigned char* kb = shm + L_K + cur * SLOTB + hi * 1024 + r32 * 16;
            const LAS unsigned char* vb = shm + L_V + cur * SLOTB + ((lane >> 4) & 1) * 32 + (lane & 3) * 8 + (4 * hi + ((lane & 15) >> 2)) * 64;
            bf16x8 pa1[4], pa2[4];
            {
                f32x16 p0 = f32x16{}, p1 = f32x16{};
#pragma unroll
                for (int d0 = 0; d0 < (MODE == 0 ? 4 : 2); ++d0) { const bf16x8 k0 = *(const LAS bf16x8*)(kb + d0 * 2048), k1 = *(const LAS bf16x8*)(kb + d0 * 2048 + 512);
                    p0 = __builtin_amdgcn_mfma_f32_32x32x16_bf16(k0, qr[d0], p0, 0, 0, 0); p1 = __builtin_amdgcn_mfma_f32_32x32x16_bf16(k1, qr[d0], p1, 0, 0, 0); }
                if (MODE == 0) {
                    const LAS unsigned char* kx = shm + L_KX + cur * 2048 + r32 * 16; bf16x8 x0 = *(const LAS bf16x8*)kx, x1 = *(const LAS bf16x8*)(kx + 512);
                    if (hi) { x0 = bf16x8{}; x1 = bf16x8{}; }
                    p0 = __builtin_amdgcn_mfma_f32_32x32x16_bf16(x0, qx, p0, 0, 0, 0); p1 = __builtin_amdgcn_mfma_f32_32x32x16_bf16(x1, qx, p1, 0, 0, 0);
                    if (64 * t + 63 > qmin) {
#pragma unroll
                        for (int r = 0; r < 16; ++r) { const int kv = 64 * t + crow(r, hi); if (kv > qrow) p0[r] = -INFINITY; if (kv + 32 > qrow) p1[r] = -INFINITY; } }
                }
                softmax_step(p0, p1, m1, l1, o1, pa1, wsf, r32, hi);
            }
            if (MODE == 1) {
                f32x16 p0 = f32x16{}, p1 = f32x16{};
#pragma unroll
                for (int d0 = 2; d0 < 4; ++d0) { const bf16x8 k0 = *(const LAS bf16x8*)(kb + d0 * 2048), k1 = *(const LAS bf16x8*)(kb + d0 * 2048 + 512);
                    p0 = __builtin_amdgcn_mfma_f32_32x32x16_bf16(k0, qr[d0], p0, 0, 0, 0); p1 = __builtin_amdgcn_mfma_f32_32x32x16_bf16(k1, qr[d0], p1, 0, 0, 0); }
                softmax_step(p0, p1, m2, l2, o2, pa2, wsf, r32, hi);
            }
#pragma unroll
            for (int d0 = 0; d0 < 2; ++d0) {
#pragma unroll
                for (int ks = 0; ks < 4; ++ks) { const s16x4 lo = vtr(vb + d0 * 4096 + ks * 1024), hi4 = vtr(vb + d0 * 4096 + ks * 1024 + 512);
                    const bf16x8 vf = (bf16x8){lo[0], lo[1], lo[2], lo[3], hi4[0], hi4[1], hi4[2], hi4[3]};
                    o1[d0] = __builtin_amdgcn_mfma_f32_32x32x16_bf16(pa1[ks], vf, o1[d0], 0, 0, 0);
                    if (MODE == 1) o2[d0] = __builtin_amdgcn_mfma_f32_32x32x16_bf16(pa2[ks], vf, o2[d0], 0, 0, 0); }
            }
        }
        if (MODE == 0 && i + 1 < NT && F.tid < 64) KX_STORE(cur ^ 1, kxv);
        ATT_WAIT_BAR();
    }
    l1 = half_sum(l1); if (MODE == 1) l2 = half_sum(l2);
    float lam = 0.f, post = 1.f;
    if (MODE == 1) { float d1 = 0.f, d2 = 0.f;
        for (int i = 0; i < 32; ++i) { d1 += A.in[I_LQ1][l * 32 + i] * A.in[I_LK1][l * 32 + i]; d2 += A.in[I_LQ2][l * 32 + i] * A.in[I_LK2][l * 32 + i]; }
        const float lam_init = 0.8f - 0.6f * __expf(-0.3f * (float)l); lam = __expf(d1) - __expf(d2) + lam_init; post = 1.f - lam_init; }
    if (hi == 0) { wsf[r32] = 1.f / l1; if (MODE == 1) wsf[32 + r32] = lam / l2; }
    LDS_WAIT();
    LAS float* stg = (LAS float*)(shm + L_OST) + wid * 2048;
#pragma unroll
    for (int g = 0; g < 4; ++g) { const f32x4 c1 = *(const LAS f32x4*)(wsf + 4 * hi + 8 * g); f32x4 c2 = {0.f, 0.f, 0.f, 0.f}; if (MODE == 1) c2 = *(const LAS f32x4*)(wsf + 32 + 4 * hi + 8 * g);
#pragma unroll
        for (int i = 0; i < 4; ++i) { const int r = 4 * g + i, orow = crow(r, hi);
#pragma unroll
            for (int d0 = 0; d0 < 2; ++d0) { float v = o1[d0][r] * c1[i]; if (MODE == 1) v -= o2[d0][r] * c2[i]; stg[orow * 64 + d0 * 32 + r32] = v; } } }
    LDS_WAIT();
    bf16* Y = WSP(bf16, WS_R1) + (rowbase + q0 + wid * 32) * DM + (MODE == 0 ? 0 : 256) + h * 64;
    const float* gn = A.in[I_DNG] + l * 64;
#pragma unroll
    for (int i = 0; i < 4; ++i) { const int row = i * 8 + (lane >> 3), ch = lane & 7; f32x4 a = *(const LAS f32x4*)(stg + row * 64 + ch * 8), c = *(const LAS f32x4*)(stg + row * 64 + ch * 8 + 4);
        if (MODE == 1) { float ss = (a[0] * a[0] + a[1] * a[1]) + (a[2] * a[2] + a[3] * a[3]) + (c[0] * c[0] + c[1] * c[1]) + (c[2] * c[2] + c[3] * c[3]);
            ss += __shfl_xor(ss, 1); ss += __shfl_xor(ss, 2); ss += __shfl_xor(ss, 4);
            const float rs = post / sqrtf(ss * (1.f / 64.f) + LN_EPS); const f32x4 g0 = *(const f32x4*)(gn + ch * 8), g1 = *(const f32x4*)(gn + ch * 8 + 4);
            a = a * rs * g0; c = c * rs * g1; }
        u32x4 w; w.x = cvt_pk_bf16(a[0], a[1]); w.y = cvt_pk_bf16(a[2], a[3]); w.z = cvt_pk_bf16(c[0], c[1]); w.w = cvt_pk_bf16(c[2], c[3]);
        *(u32x4*)(Y + (size_t)row * DM + ch * 8) = w; }
    ATT_WAIT_BAR();
#undef DMA_KV
#undef TILE_OF
#undef KX_LOAD
#undef KX_STORE
}
template <int MODE>
__device__ __forceinline__ void attn_phase(const Frame& F, const Args& A, int l) {
    for (int c = F.bid; c < 256; c += F.G) { const int bh = c >> 4, s = c & 15;
        attn_unit<MODE>(F, A, l, bh >> 2, bh & 3, 31 - s); attn_unit<MODE>(F, A, l, bh >> 2, bh & 3, s); }
}
}
namespace hg {
constexpr int PQ = 136, PV = 72;
constexpr int L_QD = 0, L_KD = 17408, L_KO = 34816, L_QS = 43520, L_VT = 60928, L_ST = 79360, L_SEG = 114176, L_END = 116224, L_OST = 0;
static_assert(L_END <= RING_BYTES, "hgrn LDS");
struct Prep { float q[16], k[16], bc[16]; float blast, b31; };
__device__ __forceinline__ void prep(const Frame& F, const Args& A, int l, int b, int h, int n, bool need_q, Prep& P) {
    const int c = F.tid & 127, seg = F.tid >> 7; const size_t tok0 = (size_t)b * SEQ + n * 64 + seg * 16; const int ch = h * 128 + c;
    const float* HF = WSP(float, WS_HF) + tok0 * 512 + ch; const bf16* HQ = WSP(bf16, WS_HQ) + tok0 * 512 + ch;
    float lb = 0.f; if (l == 1) { const float b0 = A.in[I_HLB][ch], b1 = A.in[I_HLB][512 + ch]; lb = 1.f / (1.f + __expf(b0 - b1)); }
    LAS float* SEG = (LAS float*)(F.lds + L_SEG);
    float run = 0.f;
#pragma unroll
    for (int i = 0; i < 16; ++i) { const float x = HF[(size_t)i * 512]; const float s = 1.f / (1.f + __expf(-x));
        const float lf = (l == 0) ? log_sigmoidf_(x) : __logf(lb + (1.f - lb) * s);
        run += lf * LOG2E; P.bc[i] = run; P.k[i] = (1.f - lb) * (1.f - s); P.q[i] = need_q ? bf2f(HQ[(size_t)i * 512]) : 0.f; }
    SEG[seg * 128 + c] = run;
    __syncthreads();
    const float s0 = SEG[c], s1 = SEG[128 + c], s2 = SEG[256 + c], s3 = SEG[384 + c];
    const float pre = seg == 0 ? 0.f : seg == 1 ? s0 : seg == 2 ? s0 + s1 : s0 + s1 + s2;
#pragma unroll
    for (int i = 0; i < 16; ++i) P.bc[i] += pre;
    P.b31 = s0 + s1; P.blast = (s0 + s1) + (s2 + s3);
}
__device__ __forceinline__ void store16(LAS unsigned char* dst, const float (&v)[16]) {
    u32x4 a, b; a.x = cvt_pk_bf16(v[0], v[1]); a.y = cvt_pk_bf16(v[2], v[3]); a.z = cvt_pk_bf16(v[4], v[5]); a.w = cvt_pk_bf16(v[6], v[7]);
    b.x = cvt_pk_bf16(v[8], v[9]); b.y = cvt_pk_bf16(v[10], v[11]); b.z = cvt_pk_bf16(v[12], v[13]); b.w = cvt_pk_bf16(v[14], v[15]);
    *(LAS u32x4*)dst = a; *(LAS u32x4*)(dst + 16) = b;
}
__device__ __forceinline__ void load_vt(const Frame& F, int b, int h, int n) {
    const int c = F.tid & 127, seg = F.tid >> 7; const bf16* HI = WSP(bf16, WS_HI) + ((size_t)b * SEQ + n * 64 + seg * 16) * 512 + h * 128 + c;
    float v[16];
#pragma unroll
    for (int i = 0; i < 16; ++i) v[i] = bf2f(HI[(size_t)i * 512]);
    store16(F.lds + L_VT + c * (PV * 2) + seg * 32, v);
}
__device__ __forceinline__ void pass1_unit(const Frame& F, const Args& A, int l, int U) {
    const int bh = U >> 7, n = U & 127, b = bh >> 2, h = bh & 3; const int c = F.tid & 127, seg = F.tid >> 7;
    Prep P; prep(F, A, l, b, h, n, false, P);
    { float kd[16];
#pragma unroll
      for (int i = 0; i < 16; ++i) kd[i] = P.k[i] * fast_exp2(P.blast - P.bc[i]);
      store16(F.lds + L_KD + c * (PV * 2) + seg * 32, kd); }
    load_vt(F, b, h, n);
    if (seg == 0) WSP(float, WS_HDEC)[(size_t)U * 128 + c] = fast_exp2(P.blast);
    __syncthreads();
    const int lane = F.lane, r32 = lane & 31, hi = lane >> 5, vb = F.wave >> 1, db0 = (F.wave & 1) * 2;
    f32x16 acc[2]; acc[0] = f32x16{}; acc[1] = f32x16{};
#pragma unroll
    for (int ks = 0; ks < 4; ++ks) { const bf16x8 a = *(const LAS bf16x8*)(F.lds + L_VT + (vb * 32 + r32) * (PV * 2) + ks * 32 + hi * 16);
#pragma unroll
        for (int j = 0; j < 2; ++j) { const bf16x8 bb = *(const LAS bf16x8*)(F.lds + L_KD + ((db0 + j) * 32 + r32) * (PV * 2) + ks * 32 + hi * 16);
            acc[j] = __builtin_amdgcn_mfma_f32_32x32x16_bf16(a, bb, acc[j], 0, 0, 0); } }
    bf16* ST = WSP(bf16, WS_ST) + (size_t)U * 16384;
#pragma unroll
    for (int j = 0; j < 2; ++j)
#pragma unroll
        for (int r = 0; r < 16; ++r) { const int v = vb * 32 + (r & 3) + 8 * (r >> 2) + 4 * hi; ST[v * 128 + (db0 + j) * 32 + r32] = f2bf(acc[j][r]); }
    __syncthreads();
}
__device__ __forceinline__ void phase_pass1(const Frame& F, const Args& A, int l) { for (int U = F.bid; U < 2048; U += F.G) pass1_unit(F, A, l, U); }

__device__ __forceinline__ void phase_scan(const Frame& F) {
    unsigned* ST = WSP(unsigned, WS_ST); const float* HD = WSP(float, WS_HDEC);
    for (int g = F.bid * NTHR + F.tid; g < 16 * 8192; g += F.G * NTHR) { const int bh = g >> 13, rem = g & 8191, v = rem >> 6, d2 = rem & 63;
        unsigned* p = ST + ((size_t)bh * 128 * 16384 + v * 128) / 2 + d2; const float* dp = HD + (size_t)bh * 128 * 128 + 2 * d2;
        float s0 = 0.f, s1 = 0.f;
        for (int n0 = 0; n0 < 128; n0 += 8) { unsigned x[8]; f32x2 dc[8];
#pragma unroll
            for (int j = 0; j < 8; ++j) { x[j] = p[(size_t)(n0 + j) * 8192]; dc[j] = *(const f32x2*)(dp + (size_t)(n0 + j) * 128); }
#pragma unroll
            for (int j = 0; j < 8; ++j) { s0 = s0 * dc[j].x + __uint_as_float(x[j] << 16); s1 = s1 * dc[j].y + __uint_as_float(x[j] & 0xffff0000u); p[(size_t)(n0 + j) * 8192] = cvt_pk_bf16(s0, s1); } }
    }
}
__device__ __forceinline__ void pass3_unit(const Frame& F, const Args& A, int l, int U) {
    const int bh = U >> 7, n = U & 127, b = bh >> 2, h = bh & 3; const int c = F.tid & 127, seg = F.tid >> 7;
    if (n > 0) { const bf16* ST = WSP(bf16, WS_ST) + (size_t)(U - 1) * 16384;
#pragma unroll
        for (int i = 0; i < 4; ++i) { const int idx = F.tid + i * NTHR, v = idx >> 4, ch = idx & 15; *(LAS u32x4*)(F.lds + L_ST + v * (PQ * 2) + ch * 16) = *(const u32x4*)(ST + v * 128 + ch * 8); } }
    Prep P; prep(F, A, l, b, h, n, true, P);
    { const float ref = seg < 2 ? 0.f : P.b31;
      LAS bf16* QD = (LAS bf16*)(F.lds + L_QD); LAS bf16* KD = (LAS bf16*)(F.lds + L_KD); LAS bf16* KO = (LAS bf16*)(F.lds + L_KO); LAS bf16* QS = (LAS bf16*)(F.lds + L_QS);
#pragma unroll
      for (int i = 0; i < 16; ++i) { const int t = seg * 16 + i;
          QD[t * PQ + c] = f2bf(P.q[i] * fast_exp2(P.bc[i] - ref)); KD[t * PQ + c] = f2bf(P.k[i] * fast_exp2(ref - P.bc[i])); QS[t * PQ + c] = f2bf(P.q[i] * fast_exp2(P.bc[i]));
          if (seg < 2) KO[t * PQ + c] = f2bf(P.k[i] * fast_exp2(P.b31 - P.bc[i])); } }
    load_vt(F, b, h, n);
    __syncthreads();
    const int lane = F.lane, r32 = lane & 31, hi = lane >> 5, tb = F.wave >> 2, vb = F.wave & 3;
    f32x16 o = f32x16{};
    const LAS unsigned char* qd = F.lds + L_QD + (tb * 32 + r32) * (PQ * 2) + hi * 16;
    const LAS unsigned char* vt = F.lds + L_VT + (vb * 32 + r32) * (PV * 2) + hi * 8;
#pragma unroll
    for (int sb = 0; sb < 2; ++sb) {
        if (sb <= tb) {
            const LAS unsigned char* kk = (sb == tb) ? F.lds + L_KD + (sb * 32 + r32) * (PQ * 2) + hi * 16 : F.lds + L_KO + r32 * (PQ * 2) + hi * 16;
            f32x16 x = f32x16{};
#pragma unroll
            for (int ks = 0; ks < 8; ++ks) x = __builtin_amdgcn_mfma_f32_32x32x16_bf16(*(const LAS bf16x8*)(kk + ks * 32), *(const LAS bf16x8*)(qd + ks * 32), x, 0, 0, 0);
            if (sb == tb) {
#pragma unroll
                for (int r = 0; r < 16; ++r) { const int s = (r & 3) + 8 * (r >> 2) + 4 * hi; if (s > r32) x[r] = 0.f; } }
#pragma unroll
            for (int s2 = 0; s2 < 2; ++s2) { const bf16x8 pa = att::pack8(x, 8 * s2);
                const s16x4 lo = *(const LAS s16x4*)(vt + (sb * 32 + s2 * 16) * 2), hh = *(const LAS s16x4*)(vt + (sb * 32 + s2 * 16 + 8) * 2);
                const bf16x8 vf = (bf16x8){lo[0], lo[1], lo[2], lo[3], hh[0], hh[1], hh[2], hh[3]};
                o = __builtin_amdgcn_mfma_f32_32x32x16_bf16(pa, vf, o, 0, 0, 0); }
        }
    }
    if (n > 0) { const LAS unsigned char* qs = F.lds + L_QS + (tb * 32 + r32) * (PQ * 2) + hi * 16; const LAS unsigned char* st = F.lds + L_ST + (vb * 32 + r32) * (PQ * 2) + hi * 16;
#pragma unroll
        for (int ks = 0; ks < 8; ++ks) o = __builtin_amdgcn_mfma_f32_32x32x16_bf16(*(const LAS bf16x8*)(qs + ks * 32), *(const LAS bf16x8*)(st + ks * 32), o, 0, 0, 0); }
    __syncthreads();
    LAS float* OST = (LAS float*)(F.lds + L_OST);
#pragma unroll
    for (int r = 0; r < 16; ++r) { const int t = tb * 32 + (r & 3) + 8 * (r >> 2) + 4 * hi; OST[t * 132 + vb * 32 + r32] = o[r]; }
    __syncthreads();
    { const int t = F.tid >> 3, v0 = (F.tid & 7) * 16; const size_t tok = (size_t)b * SEQ + n * 64 + t;
      f32x4 x[4]; float ss = 0.f;
#pragma unroll
      for (int j = 0; j < 4; ++j) { x[j] = *(const LAS f32x4*)(OST + t * 132 + v0 + 4 * j); ss += (x[j][0] * x[j][0] + x[j][1] * x[j][1]) + (x[j][2] * x[j][2] + x[j][3] * x[j][3]); }
      ss += __shfl_xor(ss, 1); ss += __shfl_xor(ss, 2); ss += __shfl_xor(ss, 4);
      const float rs = 1.f / sqrtf(ss * (1.f / 128.f) + LN_EPS);
      const float* gn = A.in[I_HNG] + l * 128 + v0; const bf16* HG = WSP(bf16, WS_HG) + tok * 512 + h * 128 + v0;
      const u32x4 g0 = *(const u32x4*)HG, g1 = *(const u32x4*)(HG + 8); unsigned gw[8] = {g0.x, g0.y, g0.z, g0.w, g1.x, g1.y, g1.z, g1.w};
      unsigned w[8];
#pragma unroll
      for (int j = 0; j < 4; ++j) { const f32x4 gg = *(const f32x4*)(gn + 4 * j);
          const float y0 = x[j][0] * rs * gg[0] * __uint_as_float(gw[2 * j] << 16), y1 = x[j][1] * rs * gg[1] * __uint_as_float(gw[2 * j] & 0xffff0000u);
          const float y2 = x[j][2] * rs * gg[2] * __uint_as_float(gw[2 * j + 1] << 16), y3 = x[j][3] * rs * gg[3] * __uint_as_float(gw[2 * j + 1] & 0xffff0000u);
          w[2 * j] = cvt_pk_bf16(y0, y1); w[2 * j + 1] = cvt_pk_bf16(y2, y3); }
      bf16* Y = WSP(bf16, WS_R1) + tok * DM + 512 + h * 128 + v0;
      *(u32x4*)Y = (u32x4){w[0], w[1], w[2], w[3]}; *(u32x4*)(Y + 8) = (u32x4){w[4], w[5], w[6], w[7]}; }
    __syncthreads();
}
__device__ __forceinline__ void phase_pass3(const Frame& F, const Args& A, int l) { for (int U = F.bid; U < 2048; U += F.G) pass3_unit(F, A, l, U); }
}
#define DEBUG_AFTER_PHASE(p) do{}while(0)
#define DEBUG_BEFORE_PHASE(p) do{}while(0)
#define DEBUG_FINAL() do{}while(0)
#ifndef MK_N_LAUNCHES
#define MK_N_LAUNCHES 1
#endif

__global__ void __launch_bounds__(NTHR, 2) mk_fwd(Args args) {
    extern __shared__ __attribute__((aligned(16))) unsigned char lds_raw[];
    Frame F;
    F.lds = (LAS unsigned char*)lds_raw; F.ws = args.ws; F.ctl = (gu32*)(args.ws + WS_CTL); F.out = args.out;
    F.tid = threadIdx.x; F.lane = F.tid & 63; F.wave = __builtin_amdgcn_readfirstlane(F.tid >> 6); F.G = gridDim.x; F.bid = blockIdx.x;
    volatile LAS unsigned* MISC = (volatile LAS unsigned*)(F.lds + MISC_OFF);
    if (F.tid < 32) MISC[F.tid] = 0u;
    __syncthreads();
    const int lo = args.ph_lo, hi = args.ph_hi;
    XcdBarrier bar; bar.bar = (unsigned*)(F.ctl + CW_BAR); bar.x = 0; bar.st = nullptr;
    if (hi - lo > 1) bar = xcd_barrier_post((unsigned*)(F.ctl + CW_BAR), MISC + 8);
#ifdef ONLY_PH
#define IN(k) (((k) == 0 ? 0 : ((k) - 1) % NPH_L + 1) == ONLY_PH && lo <= (k) && (k) < hi)
#else
#define IN(k) (lo <= (k) && (k) < hi)
#endif
#define SEAM(k) do { if ((k) + 1 < hi) xcd_barrier(bar); } while (0)
    const Args& A = args;
    const Frame F0 = F;
#define FRESH() do { F = F0; int t_ = threadIdx.x; asm volatile("" : "+v"(t_)); F.tid = t_; F.lane = t_ & 63; } while (0)
    if (IN(0)) { FRESH(); phase_prologue(F, A); SEAM(0); }
    for (int l = 0; l < 2; ++l) {
        const int pb = 1 + NPH_L * l;
        if (IN(pb + 0)) { FRESH();
            fox_cumsum(F);
            pg8::ProjOrder S{(const char*)WSP(bf16, WS_R1), (const char*)WSP(bf16, WS_WIN), (const char*)WSP(bf16, WS_MEMB), (const char*)WSP(bf16, WS_WK), (const char*)WSP(bf16, WS_WV), F.G, F.bid};
            pg8::EpiProj E{WSP(bf16, WS_PA), WSP(bf16, WS_HQ), WSP(bf16, WS_HI), WSP(bf16, WS_HG), WSP(bf16, WS_KMEM), WSP(bf16, WS_VT), WSP(float, WS_HF)};
            pg8::gemm_phase<pg8::EpiProj, pg8::ProjOrder, false, true>(F.lds + RING_OFF, DM, DM, DM, S, E);
            SEAM(pb + 0);
        }
        if (IN(pb + 1)) { FRESH(); hg::phase_pass1(F, A, l); att::attn_phase<0>(F, A, l); SEAM(pb + 1); }
        if (IN(pb + 2)) { FRESH(); hg::phase_scan(F); SEAM(pb + 2); }
        if (IN(pb + 3)) { FRESH(); hg::phase_pass3(F, A, l); att::attn_phase<1>(F, A, l); SEAM(pb + 3); }
        if (IN(pb + 4)) { FRESH();
            pg8::DenseOrder S{(const char*)WSP(bf16, WS_R1), (const char*)WSP(bf16, WS_WOUT), DM, DM, MTOK / 256, 4, F.G, F.bid};
            pg8::EpiRes E{F.out};
            pg8::gemm_phase<pg8::EpiRes, pg8::DenseOrder, false, true>(F.lds + RING_OFF, DM, DM, DM, S, E);
            SEAM(pb + 4);
        }
        if (IN(pb + 5)) { FRESH(); phase_ln1(F, A, l); SEAM(pb + 5); }
        if (IN(pb + 6)) { FRESH();
            pg8::DenseOrder S{(const char*)WSP(bf16, WS_R1), (const char*)WSP(bf16, WS_WQ), DM, DM, MTOK / 256, 4, F.G, F.bid};
            pg8::EpiBf16 E{WSP(bf16, WS_Q), DM, pg8::C2_MEM};
            pg8::gemm_phase<pg8::EpiBf16, pg8::DenseOrder, false, true>(F.lds + RING_OFF, DM, DM, DM, S, E);
            SEAM(pb + 6);
        }
        if (IN(pb + 7)) { FRESH();
            pg8::XattnOrder S{(const char*)WSP(bf16, WS_Q), (const char*)WSP(bf16, WS_KMEM), 0, F.G, F.bid};
            pg8::EpiSoftmax E{WSP(bf16, WS_PATT), F.lds + XCH_OFF};
            pg8::gemm_phase<pg8::EpiSoftmax, pg8::XattnOrder, false, true>(F.lds + RING_OFF, DM, DM, 256, S, E);
            SEAM(pb + 7);
        }
        if (IN(pb + 8)) { FRESH();
            pg8::XattnOrder S{(const char*)WSP(bf16, WS_PATT), (const char*)WSP(bf16, WS_VT), 1, F.G, F.bid};
            pg8::EpiBf16 E{WSP(bf16, WS_OATT), DM, 1.f};
            pg8::gemm_phase<pg8::EpiBf16, pg8::XattnOrder, false, true>(F.lds + RING_OFF, DM, DM, 256, S, E);
            SEAM(pb + 8);
        }
        if (IN(pb + 9)) { FRESH();
            pg8::DenseOrder S{(const char*)WSP(bf16, WS_OATT), (const char*)WSP(bf16, WS_WO), DM, DM, MTOK / 256, 4, F.G, F.bid};
            pg8::EpiRes E{F.out};
            pg8::gemm_phase<pg8::EpiRes, pg8::DenseOrder, false, true>(F.lds + RING_OFF, DM, DM, DM, S, E);
            SEAM(pb + 9);
        }
        if (IN(pb + 10)) { FRESH(); phase_ln2_route(F, A, l); SEAM(pb + 10); }
        if (IN(pb + 11)) { FRESH();
            moe_tables(F, l);
            pg8::MoeOrder S{(const char*)WSP(bf16, WS_R1), (const char*)WSP(bf16, WS_W13), WSP(int, WS_LIST), (const LAS int*)(F.lds + TAB_OFF), 0, F.G, F.bid};
            pg8::EpiSwiGLU E{WSP(bf16, WS_HID)};
            pg8::gemm_phase<pg8::EpiSwiGLU, pg8::MoeOrder, true, true>(F.lds + RING_OFF, DM, DM, DM, S, E);
            SEAM(pb + 11);
        }
        if (IN(pb + 12)) { FRESH();
            moe_tables(F, l);
            pg8::MoeOrder S{(const char*)WSP(bf16, WS_HID), (const char*)WSP(bf16, WS_W2), WSP(int, WS_LIST), (const LAS int*)(F.lds + TAB_OFF), 1, F.G, F.bid};
            pg8::EpiMoeOut E{WSP(bf16, WS_CB), WSP(float, WS_GATE)};
            pg8::gemm_phase<pg8::EpiMoeOut, pg8::MoeOrder, false, true>(F.lds + RING_OFF, EFF, EFF, EFF, S, E);
            SEAM(pb + 12);
        }
        if (IN(pb + 13)) { FRESH(); phase_ln3(F, A, l); SEAM(pb + 13); }
    }
#undef IN
#undef SEAM
}

extern "C" void kernel_launch(void* const* d_in, const int* in_sizes, int n_in, void* d_out, int out_size, void* d_ws, size_t ws_size, hipStream_t stream) {
    static int grid = 0;
    if (grid == 0) {
        if (n_in != 25 || out_size != MTOK * DM || ws_size < WS_END) { fprintf(stderr, "kernel_launch: unexpected problem (n_in %d, out %d, ws %zu)\n", n_in, out_size, ws_size); grid = -1; return; }
        int dev = 0, cus = 0, per_cu = 0;
        if (hipGetDevice(&dev) != hipSuccess || hipDeviceGetAttribute(&cus, hipDeviceAttributeMultiprocessorCount, dev) != hipSuccess) { grid = -1; return; }
        if (hipFuncSetAttribute((const void*)mk_fwd, hipFuncAttributeMaxDynamicSharedMemorySize, LDS_BYTES) != hipSuccess) { fprintf(stderr, "kernel_launch: hipFuncSetAttribute failed\n"); grid = -1; return; }
        if (hipOccupancyMaxActiveBlocksPerMultiprocessor(&per_cu, (const void*)mk_fwd, NTHR, LDS_BYTES) != hipSuccess || per_cu < 1) fprintf(stderr, "kernel_launch: occupancy query says %d\n", per_cu);
        (void)hipGetLastError();
        grid = cus < 256 ? cus : 256;
    }
    if (grid < 0) return;
    (void)hipMemsetAsync((char*)d_ws + WS_CTL, 0, CTL_ZERO_BYTES, stream);
    Args a{};
    for (int i = 0; i < 25; ++i) a.in[i] = (const float*)d_in[i];
    a.out = (float*)d_out; a.ws = (unsigned char*)d_ws;
#if MK_N_LAUNCHES == 1
    a.ph_lo = 0; a.ph_hi = NPHASE;
    hipLaunchKernelGGL(mk_fwd, dim3(grid), dim3(NTHR), LDS_BYTES, stream, a);
#else
    for (int p = 0; p < NPHASE; ++p) { DEBUG_BEFORE_PHASE(p); a.ph_lo = p; a.ph_hi = p + 1; hipLaunchKernelGGL(mk_fwd, dim3(grid), dim3(NTHR), LDS_BYTES, stream, a);
        DEBUG_AFTER_PHASE(p); }
    DEBUG_FINAL();
#endif
}
```

```cpp
#include <hip/hip_runtime.h>
#include <cstdio>
#include <cstdint>

#define GAS __attribute__((address_space(1)))
#define LAS __attribute__((address_space(3)))
typedef unsigned short bf16;
typedef short bf16x8 __attribute__((ext_vector_type(8)));
typedef short s16x4 __attribute__((ext_vector_type(4)));
typedef float f32x4 __attribute__((ext_vector_type(4)));
typedef float f32x2 __attribute__((ext_vector_type(2)));
typedef float f32x16 __attribute__((ext_vector_type(16)));
typedef unsigned u32x4 __attribute__((ext_vector_type(4)));
typedef unsigned u32x2 __attribute__((ext_vector_type(2)));
typedef GAS unsigned gu32;
#define RLX_AGENT __ATOMIC_RELAXED, __HIP_MEMORY_SCOPE_AGENT
#define LDS_WAIT() asm volatile("s_waitcnt lgkmcnt(0)" ::: "memory")
#define VM_WAIT() asm volatile("s_waitcnt vmcnt(0)" ::: "memory")

constexpr int DM = 1024, NB = 4, SEQ = 8192, MTOK = NB * SEQ;
constexpr int NIN = 3584;
constexpr int INW = 3588;
constexpr int NEXP = 16, EFF = 512;
constexpr float LN_EPS = 1e-5f;
constexpr float ALPHA = 1.4142135623730951f;
constexpr float LOG2E = 1.4426950408889634f;
constexpr int PA_LD = 1536;
constexpr int NWAVES = 8, NTHR = 512;

constexpr size_t MiB = 1u << 20;
constexpr size_t WS_CTL = 0, CTL_ZERO_BYTES = 1 * MiB;
constexpr size_t WS_CUMF = 1 * MiB;
constexpr size_t WS_LF2 = 1 * MiB + 512 * 1024;
constexpr size_t WS_LIST = 2 * MiB;
constexpr size_t WS_GATE = 4 * MiB;
constexpr size_t WS_HDEC = 4 * MiB + 512 * 1024;
constexpr size_t WS_MEMB = 6 * MiB;
constexpr size_t WS_KMEM = 8 * MiB;
constexpr size_t WS_VT = 10 * MiB;
constexpr size_t WS_WIN = 16 * MiB, WS_WOUT = 23 * MiB, WS_WQ = 25 * MiB, WS_WK = 27 * MiB, WS_WV = 29 * MiB, WS_WO = 31 * MiB, WS_W13 = 33 * MiB, WS_W2 = 65 * MiB;
constexpr size_t WS_R1 = 81 * MiB;
constexpr size_t WS_BIG = 145 * MiB;
constexpr size_t WS_PA = WS_BIG, WS_HQ = WS_BIG + 96 * MiB, WS_HI = WS_BIG + 128 * MiB, WS_HG = WS_BIG + 160 * MiB, WS_HF = WS_BIG + 192 * MiB, WS_ST = WS_BIG + 256 * MiB;
constexpr size_t WS_Q = WS_BIG, WS_PATT = WS_BIG + 64 * MiB, WS_OATT = WS_BIG + 128 * MiB;
constexpr size_t WS_HID = WS_BIG, WS_CB = WS_BIG + 68 * MiB;
constexpr size_t WS_END = WS_BIG + 320 * MiB;
static_assert(WS_CB + (size_t)MTOK * 2 * DM * 2 <= WS_END, "ws map");
constexpr int CW_TMO = 0, CW_CODE = 1, CW_BAR = 4096, CW_ECNT = 8192  , CW_DBG = 16384;

__device__ __forceinline__ unsigned cvt_pk_bf16(float lo, float hi) { typedef __bf16 bf2 __attribute__((ext_vector_type(2))); f32x2 v = {lo, hi}; bf2 b = __builtin_convertvector(v, bf2); return __builtin_bit_cast(unsigned, b); }
__device__ __forceinline__ bf16 f2bf(float f) { return (bf16)(cvt_pk_bf16(f, 0.f) & 0xffffu); }
__device__ __forceinline__ float bf2f(bf16 b) { return __uint_as_float(((unsigned)b) << 16); }
__device__ __forceinline__ float wave_sum(float v) {
#pragma unroll
    for (int o = 1; o < 64; o <<= 1) v += __shfl_xor(v, o);
    return v;
}
__device__ __forceinline__ float fast_exp2(float x) { return __builtin_amdgcn_exp2f(x); }
__device__ __forceinline__ float fast_rcp(float x) { return __builtin_amdgcn_rcpf(x); }
__device__ __forceinline__ float sigmoidf_(float x) { return fast_rcp(1.f + fast_exp2(-x * LOG2E)); }
__device__ __forceinline__ float siluf_(float x) { return x * sigmoidf_(x); }
__device__ __forceinline__ float log_sigmoidf_(float x) { return fminf(x, 0.f) - log1pf(__expf(-fabsf(x))); }
constexpr int NPH_L = 14, NPHASE = 1 + 2 * NPH_L;
namespace pg8 {
constexpr int BM = 256, BK = 64, HALF = 128, HTB = HALF * BK * 2, STAGE_BYTES = 8 * HTB, NXCD = 8, WGM = 8;
__host__ __device__ __forceinline__ int lds_byte(int r, int c) { const int st = (r >> 4) * 2 + (c >> 5), rr = r & 15, cc = c & 31, ob = rr * 64 + cc * 2; return st * 1024 + (ob ^ (((ob >> 9) & 1) << 5)); }
__host__ __device__ __forceinline__ void stage_rc(int b, int& R, int& C) { const int st = b / 1024, sb = b % 1024, swz = sb ^ (((sb >> 9) & 1) << 5); R = (st >> 1) * 16 + swz / 64; C = (st & 1) * 32 + (swz % 64) / 2; }
__host__ __device__ __forceinline__ int perm32(int rho) { const int n = rho >> 4, i = rho & 15; return 8 * (i >> 2) + 4 * n + (i & 3); }

struct Unit { const char* a; const char* b; const int* rl; int pm, pn, nv, e; };

__device__ __forceinline__ void tile_of(int L, int nM, int nN, int& pm, int& pn) {
    const int nwg = nM * nN; int wgid = L; { const int q = nwg / NXCD, r = nwg % NXCD, xcd = wgid % NXCD, off = wgid / NXCD; wgid = (xcd < r ? xcd * (q + 1) : r * (q + 1) + (xcd - r) * q) + off; }
    const int nig = WGM * nN, gid = wgid / nig, fm = gid * WGM, gsz = (nM - fm) < WGM ? (nM - fm) : WGM;
    pm = fm + ((wgid % nig) % gsz); pn = (wgid % nig) / gsz;
}

template <class Epi, class Sched, bool GATHER, bool ALIGN_EPI>
__device__ __forceinline__ void gemm_phase(LAS unsigned char* lds, const int lda, const int ldb, const int K, const Sched& S, const Epi& E) {
    int tid = threadIdx.x; asm volatile("" : "+v"(tid));
    const int wid = __builtin_amdgcn_readfirstlane(tid >> 6), lane = tid & 63, wr = wid >> 2, wc = wid & 3, fr = lane & 15, fq = lane >> 4;
    const int nt = K / BK;
    unsigned vB[2];
#pragma unroll
    for (int i = 0; i < 2; ++i) { int R, C; stage_rc(tid * 16 + i * 8192, R, C); const int Rb = Epi::PERM ? ((R & ~31) + perm32(R & 31)) : R; vB[i] = (unsigned)(Rb * ldb + C) * 2u; }
    const size_t kstep = (size_t)(BK * 2);
    const size_t hstepB = (size_t)HALF * ldb * 2;
    const unsigned ldsw = (unsigned)wid * 1024u;
    const int aoff = lds_byte(wr * 64 + fr, fq * 8), boff = lds_byte(wc * 32 + fr, fq * 8);
#define PG8_SA(b, h) (((b) * 2 + (h)) * HTB)
#define PG8_SB(b, h) ((4 + (b) * 2 + (h)) * HTB)
#define PG8_STAGE2(bufoff, gbase, v0, v1) do { \
        __builtin_amdgcn_global_load_lds((const unsigned*)((const char*)(gbase) + (v0)), (LAS unsigned*)(lds + (bufoff) + ldsw), 16, 0, 0); \
        __builtin_amdgcn_global_load_lds((const unsigned*)((const char*)(gbase) + (v1)), (LAS unsigned*)(lds + (bufoff) + ldsw + 8192), 16, 0, 0); } while (0)
#define PG8_STAGEB(bufoff, gbase) PG8_STAGE2(bufoff, gbase, vB[0], vB[1])
#define PG8_LDA(dst, b, h) do { _Pragma("unroll") for (int m = 0; m < 4; ++m) _Pragma("unroll") for (int k = 0; k < 2; ++k) dst[m][k] = *(const LAS bf16x8*)(lds + PG8_SA(b, h) + aoff + m * 2048 + k * 1024); } while (0)
#define PG8_LDB(dst, b, h) do { _Pragma("unroll") for (int n = 0; n < 2; ++n) _Pragma("unroll") for (int k = 0; k < 2; ++k) dst[n][k] = *(const LAS bf16x8*)(lds + PG8_SB(b, h) + boff + n * 2048 + k * 1024); } while (0)
#define PG8_MMA(ai, bj, At, Bt) do { __builtin_amdgcn_s_setprio(1); _Pragma("unroll") for (int m = 0; m < 4; ++m) _Pragma("unroll") for (int n = 0; n < 2; ++n) _Pragma("unroll") for (int k = 0; k < 2; ++k) \
        acc[ai][bj][m][n] = __builtin_amdgcn_mfma_f32_16x16x32_bf16(Bt[n][k], At[m][k], acc[ai][bj][m][n], 0, 0, 0); __builtin_amdgcn_s_setprio(0); } while (0)
#define PG8_WAIT_V(n) asm volatile("s_waitcnt vmcnt(" #n ")" ::: "memory")
#define PG8_WAIT_L(n) asm volatile("s_waitcnt lgkmcnt(" #n ")" ::: "memory")
#define PG8_BAR __builtin_amdgcn_s_barrier()
#define PG8_SCHED __builtin_amdgcn_sched_barrier(0)
    Unit cur, nxt; int ui = 0;
    if (!S.next(0, cur)) return;
    unsigned vA[2][2], nvA[2][2];
#define PG8_AOFFS(dst, u) do { int t2_ = tid; if constexpr (GATHER) asm volatile("" : "+v"(t2_)); _Pragma("unroll") for (int i_ = 0; i_ < 2; ++i_) { int R_, C_; stage_rc(t2_ * 16 + i_ * 8192, R_, C_); \
        _Pragma("unroll") for (int h_ = 0; h_ < 2; ++h_) { \
        if constexpr (GATHER) { int rr_ = h_ * HALF + R_; rr_ = rr_ < (u).nv ? rr_ : (u).nv - 1; const int tok_ = (u).rl[rr_] >> 1; dst[h_][i_] = (unsigned)(tok_ * lda + C_) * 2u; } \
        else dst[h_][i_] = (unsigned)((h_ * HALF + R_) * lda + C_) * 2u; } } } while (0)
    PG8_AOFFS(vA, cur);
    f32x4 acc[2][2][4][2];
#pragma unroll
    for (int a = 0; a < 2; ++a)
#pragma unroll
        for (int b = 0; b < 2; ++b)
#pragma unroll
            for (int m = 0; m < 4; ++m)
#pragma unroll
                for (int n = 0; n < 2; ++n) acc[a][b][m][n] = (f32x4){0.f, 0.f, 0.f, 0.f};
    bf16x8 At[4][2], B0[2][2], B1[2][2];
    const char* cA = cur.a; const char* cB = cur.b;
    PG8_STAGEB(PG8_SB(0, 0), cB); PG8_STAGEB(PG8_SB(0, 1), cB + hstepB); PG8_STAGE2(PG8_SA(0, 0), cA, vA[0][0], vA[0][1]); PG8_STAGE2(PG8_SA(0, 1), cA, vA[1][0], vA[1][1]);
    if (wr == 1) PG8_BAR;
    PG8_WAIT_V(2); PG8_BAR;
    PG8_STAGEB(PG8_SB(1, 0), cB + kstep); PG8_STAGE2(PG8_SA(1, 0), cA + kstep, vA[0][0], vA[0][1]); PG8_STAGEB(PG8_SB(1, 1), cB + hstepB + kstep);
    PG8_WAIT_V(6); PG8_BAR;
    for (;;) {
        const bool has_next = S.next(ui + 1, nxt);
        const char* nA = has_next ? nxt.a : cA; const char* nB = has_next ? nxt.b : cB;
        if constexpr (GATHER) { if (has_next) { PG8_AOFFS(nvA, nxt); } else {
#pragma unroll
            for (int h_ = 0; h_ < 2; ++h_)
#pragma unroll
                for (int i_ = 0; i_ < 2; ++i_) nvA[h_][i_] = vA[h_][i_]; } }
#pragma nounroll
        for (int t = 0; t < nt; t += 2) {
            const bool last = (t == nt - 2);
            const char* a1 = cA + (size_t)(t + 1) * kstep;
            const char* a2 = last ? nA : cA + (size_t)(t + 2) * kstep; const char* b2 = last ? nB : cB + (size_t)(t + 2) * kstep;
            const char* a3 = a2 + kstep; const char* b3 = b2 + kstep;
            unsigned x00, x01, x10, x11;
            if constexpr (GATHER) { x00 = last ? nvA[0][0] : vA[0][0]; x01 = last ? nvA[0][1] : vA[0][1]; x10 = last ? nvA[1][0] : vA[1][0]; x11 = last ? nvA[1][1] : vA[1][1]; }
            else { x00 = vA[0][0]; x01 = vA[0][1]; x10 = vA[1][0]; x11 = vA[1][1]; }
            PG8_LDB(B0, 0, 0); PG8_LDB(B1, 0, 1); PG8_SCHED; PG8_LDA(At, 0, 0); PG8_STAGE2(PG8_SA(1, 1), a1, vA[1][0], vA[1][1]);
            PG8_WAIT_V(8); PG8_WAIT_L(0); PG8_BAR; PG8_MMA(0, 0, At, B0); PG8_MMA(0, 1, At, B1); PG8_BAR; PG8_SCHED;
            PG8_LDA(At, 0, 1); PG8_STAGEB(PG8_SB(0, 0), b2); PG8_STAGEB(PG8_SB(0, 1), b2 + hstepB); PG8_STAGE2(PG8_SA(0, 0), a2, x00, x01);
            PG8_WAIT_V(8); PG8_WAIT_L(0); PG8_BAR; PG8_MMA(1, 0, At, B0); PG8_MMA(1, 1, At, B1); PG8_BAR; PG8_SCHED;
            PG8_LDB(B0, 1, 0); PG8_LDB(B1, 1, 1); PG8_SCHED; PG8_LDA(At, 1, 0); PG8_STAGE2(PG8_SA(0, 1), a2, x10, x11);
            PG8_WAIT_V(8); PG8_WAIT_L(0); PG8_BAR; PG8_MMA(0, 0, At, B0); PG8_MMA(0, 1, At, B1); PG8_BAR; PG8_SCHED;
            PG8_LDA(At, 1, 1); PG8_STAGEB(PG8_SB(1, 0), b3); PG8_STAGEB(PG8_SB(1, 1), b3 + hstepB); PG8_STAGE2(PG8_SA(1, 0), a3, x00, x01);
            PG8_WAIT_V(8); PG8_WAIT_L(0); PG8_BAR; PG8_MMA(1, 0, At, B0); PG8_MMA(1, 1, At, B1); PG8_BAR; PG8_SCHED;
        }
        if constexpr (ALIGN_EPI) { if (wr == 0) PG8_BAR; }
        if constexpr (!Epi::AFTER_DRAIN) { int fr_ = fr, fq_ = fq; asm volatile("" : "+v"(fr_), "+v"(fq_)); E(acc, cur, wr, wc, fr_, fq_); }
        if (!has_next) break;
#pragma unroll
        for (int a = 0; a < 2; ++a)
#pragma unroll
            for (int b = 0; b < 2; ++b)
#pragma unroll
                for (int m = 0; m < 4; ++m)
#pragma unroll
                    for (int n = 0; n < 2; ++n) acc[a][b][m][n] = (f32x4){0.f, 0.f, 0.f, 0.f};
        cur = nxt; cA = nA; cB = nB; ++ui;
        if constexpr (GATHER) {
#pragma unroll
            for (int h_ = 0; h_ < 2; ++h_)
#pragma unroll
                for (int i_ = 0; i_ < 2; ++i_) vA[h_][i_] = nvA[h_][i_]; }
        if constexpr (ALIGN_EPI) { if (wr == 1) PG8_BAR; }
    }
    PG8_WAIT_V(0);
    if constexpr (!ALIGN_EPI) { if (wr == 0) PG8_BAR; }
    PG8_BAR;
    if constexpr (Epi::AFTER_DRAIN) { E.fused(acc, cur, wr, wc, fr, fq, lds, wid, lane); }
#undef PG8_AOFFS
#undef PG8_SA
#undef PG8_SB
#undef PG8_STAGE2
#undef PG8_STAGEB
#undef PG8_LDA
#undef PG8_LDB
#undef PG8_MMA
#undef PG8_WAIT_V
#undef PG8_WAIT_L
#undef PG8_BAR
#undef PG8_SCHED
}
}
constexpr int RING_OFF = 0, RING_BYTES = 131072;
constexpr int XCH_OFF = RING_BYTES;
constexpr int TAB_OFF = XCH_OFF + 8192;
constexpr int MISC_OFF = TAB_OFF + 512;
constexpr int LDS_BYTES = 147456;
static_assert(MISC_OFF + 128 <= LDS_BYTES, "LDS map");

namespace pg8 {
template <int ACT>
__device__ __forceinline__ void tile_store_bf16(const f32x4 (&acc)[2][2][4][2], bf16* dst, int ld, float sc, int wr, int wc, int fr, int fq) {
    bf16* p0 = dst + (size_t)(wr * 64 + fr) * ld + wc * 32 + 8 * fq;
#pragma unroll
    for (int ai = 0; ai < 2; ++ai)
#pragma unroll
        for (int m = 0; m < 4; ++m) { bf16* rowp = p0 + (size_t)(ai * HALF + m * 16) * ld;
#pragma unroll
            for (int bj = 0; bj < 2; ++bj) { f32x4 v0 = acc[ai][bj][m][0], v1 = acc[ai][bj][m][1];
                if (ACT == 1) {
#pragma unroll
                    for (int i = 0; i < 4; ++i) { v0[i] = siluf_(v0[i]); v1[i] = siluf_(v1[i]); } }
                v0 = v0 * sc; v1 = v1 * sc; u32x4 w; w.x = cvt_pk_bf16(v0[0], v0[1]); w.y = cvt_pk_bf16(v0[2], v0[3]); w.z = cvt_pk_bf16(v1[0], v1[1]); w.w = cvt_pk_bf16(v1[2], v1[3]);
                *(u32x4*)(rowp + bj * HALF) = w; } }
}
__device__ __forceinline__ void tile_store_f32(const f32x4 (&acc)[2][2][4][2], float* dst, int ld, int wr, int wc, int fr, int fq) {
    float* p0 = dst + (size_t)(wr * 64 + fr) * ld + wc * 32 + 8 * fq;
#pragma unroll
    for (int ai = 0; ai < 2; ++ai)
#pragma unroll
        for (int m = 0; m < 4; ++m) { float* rowp = p0 + (size_t)(ai * HALF + m * 16) * ld;
#pragma unroll
            for (int bj = 0; bj < 2; ++bj) { *(f32x4*)(rowp + bj * HALF) = acc[ai][bj][m][0]; *(f32x4*)(rowp + bj * HALF + 4) = acc[ai][bj][m][1]; } }
}

constexpr float C2_FOX = 0.125f * LOG2E, C2_DIFF = 0.17677669529663687f * LOG2E, C2_MEM = 0.0625f * LOG2E;

struct EpiProj {
    static constexpr bool PERM = true, AFTER_DRAIN = false;
    bf16 *PA, *HQ, *HI, *HG, *KMEM, *VT; float* HF;
    __device__ __forceinline__ void operator()(f32x4 (&acc)[2][2][4][2], const Unit& u, int wr, int wc, int fr, int fq) const {
        const size_t row0 = (size_t)u.pm * BM; const int pn = u.pn;
        if (u.e == 0) {
            if (pn < 6) { const float sc = pn == 0 ? C2_FOX : (pn == 3 ? C2_DIFF : 1.f); tile_store_bf16<0>(acc, PA + row0 * PA_LD + pn * 256, PA_LD, sc, wr, wc, fr, fq); }
            else if (pn < 8) tile_store_bf16<1>(acc, HQ + row0 * 512 + (pn - 6) * 256, 512, 1.f, wr, wc, fr, fq);
            else if (pn < 10) tile_store_f32(acc, HF + row0 * 512 + (pn - 8) * 256, 512, wr, wc, fr, fq);
            else if (pn < 12) tile_store_bf16<0>(acc, HI + row0 * 512 + (pn - 10) * 256, 512, 1.f, wr, wc, fr, fq);
            else tile_store_bf16<1>(acc, HG + row0 * 512 + (pn - 12) * 256, 512, 1.f, wr, wc, fr, fq);
        } else if (u.e == 1) tile_store_bf16<0>(acc, KMEM + row0 * 1024 + pn * 256, 1024, 1.f, wr, wc, fr, fq);
        else tile_store_bf16<0>(acc, VT + row0 * 1024 + pn * 256, 1024, 1.f, wr, wc, fr, fq);
    }
};
struct EpiBf16 {
    static constexpr bool PERM = true, AFTER_DRAIN = false;
    bf16* O; int ld; float sc;
    __device__ __forceinline__ void operator()(f32x4 (&acc)[2][2][4][2], const Unit& u, int wr, int wc, int fr, int fq) const {
        tile_store_bf16<0>(acc, O + (size_t)u.pm * BM * ld + u.pn * BM, ld, sc, wr, wc, fr, fq);
    }
};
struct EpiRes {
    static constexpr bool PERM = true, AFTER_DRAIN = false;
    float* X;
    __device__ __forceinline__ void operator()(f32x4 (&acc)[2][2][4][2], const Unit& u, int wr, int wc, int fr, int fq) const {
        float* p0 = X + ((size_t)u.pm * BM + wr * 64 + fr) * DM + u.pn * BM + wc * 32 + 8 * fq;
#pragma unroll
        for (int ai = 0; ai < 2; ++ai)
#pragma unroll
            for (int m = 0; m < 4; ++m) { float* rowp = p0 + (size_t)(ai * HALF + m * 16) * DM;
#pragma unroll
                for (int bj = 0; bj < 2; ++bj) { const f32x4 a = *(const f32x4*)(rowp + bj * HALF), b = *(const f32x4*)(rowp + bj * HALF + 4);
                    *(f32x4*)(rowp + bj * HALF) = a * ALPHA + acc[ai][bj][m][0]; *(f32x4*)(rowp + bj * HALF + 4) = b * ALPHA + acc[ai][bj][m][1]; } }
    }
};
struct EpiSoftmax {
    static constexpr bool PERM = true, AFTER_DRAIN = false;
    bf16* P; LAS unsigned char* xch;
    __device__ __forceinline__ void operator()(f32x4 (&acc)[2][2][4][2], const Unit& u, int wr, int wc, int fr, int fq) const {
        LAS float* X1 = (LAS float*)xch; LAS float* X2 = X1 + 1024;
        float mx[2][4];
#pragma unroll
        for (int ai = 0; ai < 2; ++ai)
#pragma unroll
            for (int m = 0; m < 4; ++m) { float v = -INFINITY;
#pragma unroll
                for (int bj = 0; bj < 2; ++bj)
#pragma unroll
                    for (int n = 0; n < 2; ++n) { const f32x4 x = acc[ai][bj][m][n]; v = fmaxf(v, fmaxf(fmaxf(x[0], x[1]), fmaxf(x[2], x[3]))); }
                v = fmaxf(v, __shfl_xor(v, 16)); v = fmaxf(v, __shfl_xor(v, 32)); mx[ai][m] = v;
                if (fq == 0) X1[(ai * HALF + wr * 64 + m * 16 + fr) * 4 + wc] = v; }
        asm volatile("s_waitcnt lgkmcnt(0)" ::: "memory"); __builtin_amdgcn_s_barrier(); asm volatile("" ::: "memory");
        float sm[2][4];
#pragma unroll
        for (int ai = 0; ai < 2; ++ai)
#pragma unroll
            for (int m = 0; m < 4; ++m) { const f32x4 q = *(const LAS f32x4*)(X1 + (ai * HALF + wr * 64 + m * 16 + fr) * 4); const float M_ = fmaxf(fmaxf(q[0], q[1]), fmaxf(q[2], q[3])); float s = 0.f;
#pragma unroll
                for (int bj = 0; bj < 2; ++bj)
#pragma unroll
                    for (int n = 0; n < 2; ++n) { f32x4 x = acc[ai][bj][m][n];
#pragma unroll
                        for (int i = 0; i < 4; ++i) { x[i] = fast_exp2(x[i] - M_); s += x[i]; } acc[ai][bj][m][n] = x; }
                s += __shfl_xor(s, 16); s += __shfl_xor(s, 32); sm[ai][m] = s;
                if (fq == 0) X2[(ai * HALF + wr * 64 + m * 16 + fr) * 4 + wc] = s; }
        asm volatile("s_waitcnt lgkmcnt(0)" ::: "memory"); __builtin_amdgcn_s_barrier(); asm volatile("" ::: "memory");
        bf16* p0 = P + ((size_t)u.pm * BM + wr * 64 + fr) * DM + u.pn * BM + wc * 32 + 8 * fq;
#pragma unroll
        for (int ai = 0; ai < 2; ++ai)
#pragma unroll
            for (int m = 0; m < 4; ++m) { const f32x4 q = *(const LAS f32x4*)(X2 + (ai * HALF + wr * 64 + m * 16 + fr) * 4); const float inv = fast_rcp((q[0] + q[1]) + (q[2] + q[3]));
                bf16* rowp = p0 + (size_t)(ai * HALF + m * 16) * DM;
#pragma unroll
                for (int bj = 0; bj < 2; ++bj) { const f32x4 v0 = acc[ai][bj][m][0] * inv, v1 = acc[ai][bj][m][1] * inv; u32x4 w; w.x = cvt_pk_bf16(v0[0], v0[1]); w.y = cvt_pk_bf16(v0[2], v0[3]); w.z = cvt_pk_bf16(v1[0], v1[1]); w.w = cvt_pk_bf16(v1[2], v1[3]);
                    *(u32x4*)(rowp + bj * HALF) = w; } }
        (void)mx; (void)sm;
    }
};
struct EpiSwiGLU {
    static constexpr bool PERM = true, AFTER_DRAIN = false;
    bf16* HID;
    __device__ __forceinline__ void operator()(f32x4 (&acc)[2][2][4][2], const Unit& u, int wr, int wc, int fr, int fq) const {
        bf16* p0 = HID + ((size_t)u.pm * BM + wr * 64 + fr) * EFF + u.pn * 128 + wc * 32 + 8 * fq;
#pragma unroll
        for (int ai = 0; ai < 2; ++ai)
#pragma unroll
            for (int m = 0; m < 4; ++m) { f32x4 v0 = acc[ai][0][m][0], v1 = acc[ai][0][m][1]; const f32x4 g0 = acc[ai][1][m][0], g1 = acc[ai][1][m][1];
#pragma unroll
                for (int i = 0; i < 4; ++i) { v0[i] = siluf_(v0[i]) * g0[i]; v1[i] = siluf_(v1[i]) * g1[i]; }
                u32x4 w; w.x = cvt_pk_bf16(v0[0], v0[1]); w.y = cvt_pk_bf16(v0[2], v0[3]); w.z = cvt_pk_bf16(v1[0], v1[1]); w.w = cvt_pk_bf16(v1[2], v1[3]);
                *(u32x4*)(p0 + (size_t)(ai * HALF + m * 16) * EFF) = w; }
    }
};
struct EpiMoeOut {
    static constexpr bool PERM = true, AFTER_DRAIN = false;
    bf16* CB; const float* GATE;
    __device__ __forceinline__ void operator()(f32x4 (&acc)[2][2][4][2], const Unit& u, int wr, int wc, int fr, int fq) const {
        const int colb = u.pn * BM + wc * 32 + 8 * fq;
#pragma unroll
        for (int ai = 0; ai < 2; ++ai)
#pragma unroll
            for (int m = 0; m < 4; ++m) { const int r = ai * HALF + wr * 64 + m * 16 + fr;
                if (r < u.nv) { const int dest = u.rl[r]; const float g = GATE[dest]; bf16* rowp = CB + (size_t)dest * DM + colb;
#pragma unroll
                    for (int bj = 0; bj < 2; ++bj) { const f32x4 v0 = acc[ai][bj][m][0] * g, v1 = acc[ai][bj][m][1] * g; u32x4 w; w.x = cvt_pk_bf16(v0[0], v0[1]); w.y = cvt_pk_bf16(v0[2], v0[3]); w.z = cvt_pk_bf16(v1[0], v1[1]); w.w = cvt_pk_bf16(v1[2], v1[3]);
                        *(u32x4*)(rowp + bj * HALF) = w; } } }
    }
};

struct DenseOrder {
    const char* A; const char* Bt; int lda, ldb, nM, nN, G, c;
    __device__ __forceinline__ bool next(int i, Unit& u) const {
        const int L = i * G + c; if (L >= nM * nN) return false;
        tile_of(L, nM, nN, u.pm, u.pn); u.a = A + (size_t)u.pm * BM * lda * 2; u.b = Bt + (size_t)u.pn * BM * ldb * 2; u.rl = nullptr; u.nv = 256; u.e = 0; return true;
    }
};
struct ProjOrder {
    const char* HB; const char* WIN; const char* MEMB; const char* WK; const char* WV; int G, c;
    __device__ __forceinline__ bool next(int i, Unit& u) const {
        const int L = i * G + c; constexpr int NP = (MTOK / 256) * (NIN / 256);
        if (L >= NP + 32) return false;
        u.rl = nullptr; u.nv = 256;
        if (L < NP) { tile_of(L, MTOK / 256, NIN / 256, u.pm, u.pn); u.a = HB + (size_t)u.pm * BM * DM * 2; u.b = WIN + (size_t)u.pn * BM * DM * 2; u.e = 0; }
        else { const int j = L - NP; u.pm = (j & 15) >> 2; u.pn = j & 3;
            if (j < 16) { u.a = MEMB + (size_t)u.pm * BM * DM * 2; u.b = WK + (size_t)u.pn * BM * DM * 2; u.e = 1; }
            else { u.a = WV + (size_t)u.pm * BM * DM * 2; u.b = MEMB + (size_t)u.pn * BM * DM * 2; u.e = 2; } }
        return true;
    }
};
struct XattnOrder {
    const char* A; const char* B; int mode, G, c;
    __device__ __forceinline__ bool next(int i, Unit& u) const {
        const int L = i * G + c; if (L >= (MTOK / 256) * 4) return false;
        tile_of(L, MTOK / 256, 4, u.pm, u.pn); const int bt = u.pm / (SEQ / 256);
        u.a = A + ((size_t)u.pm * BM * DM + u.pn * 256) * 2;
        u.b = mode == 0 ? B + ((size_t)bt * 256 * DM + u.pn * 256) * 2 : B + ((size_t)u.pn * 256 * DM + bt * 256) * 2;
        u.rl = nullptr; u.nv = 256; u.e = 0; return true;
    }
};
struct MoeOrder {
    const char* A; const char* W; const int* LIST; const LAS int* T; int mode  , G, c;
    __device__ __forceinline__ bool next(int i, Unit& u) const {
        const int L = i * G + c; const int ntile = T[16]; if (L >= ntile * 4) return false;
        const int mt = L >> 2; u.pn = L & 3; int e = 0;
#pragma unroll
        for (int j = 1; j < 16; ++j) e += (T[j] <= mt) ? 1 : 0;
        const int r0 = (mt - T[e]) * 256, ne = T[32 + e];
        u.e = e; u.pm = mt; u.nv = (ne - r0) < 256 ? (ne - r0) : 256; u.rl = LIST + (size_t)e * MTOK + r0;
        if (mode == 0) { u.a = A; u.b = W + ((size_t)e * 1024 + u.pn * 256) * DM * 2; }
        else { u.a = A + (size_t)mt * BM * EFF * 2; u.b = W + ((size_t)e * 1024 + u.pn * 256) * EFF * 2; }
        return true;
    }
};
}
#define XB_TMO      128
#define XB_XCNT(j)  (256  + 64 * (j))
#define XB_XSUB(j)  (1280 + 64 * (j))
#define XB_XGEN(j)  (2304 + 64 * (j))
#define XB_TOP      3328
#define XB_TOPGEN   3392
#define XCD_BAR_WORDS 3456
#define XB_SPIN_CAP (1u << 18)
__device__ __forceinline__ unsigned xb_ld(unsigned* p)              { return __hip_atomic_load(p, __ATOMIC_RELAXED, __HIP_MEMORY_SCOPE_AGENT); }
__device__ __forceinline__ unsigned xb_add(unsigned* p, unsigned v) { return __hip_atomic_fetch_add(p, v, __ATOMIC_RELAXED, __HIP_MEMORY_SCOPE_AGENT); }
__device__ __forceinline__ unsigned xb_xcc_id() { return (unsigned)__builtin_amdgcn_s_getreg((3 << 11) | 20) & 0xFu; }
#define XB_SPIN(cond, bar) do { unsigned _sp = 0; while (cond) { __builtin_amdgcn_s_sleep(1); \
    if ((++_sp & 255u) == 0u) { if (xb_ld(&(bar)[XB_TMO])) break; if (_sp > XB_SPIN_CAP) { atomicAdd(&(bar)[XB_TMO], 1u); break; } } } } while (0)
struct XcdBarrier { unsigned* bar; unsigned x; volatile LAS unsigned* st; };
__device__ __forceinline__ XcdBarrier xcd_barrier_post(unsigned* bar, volatile LAS unsigned* st) {
    XcdBarrier b; b.bar = bar; b.x = xb_xcc_id(); b.st = st;
    if (threadIdx.x == 0) (void)xb_add(&bar[XB_XCNT(b.x)], 1u);
    return b;
}
__device__ __forceinline__ void xcd_barrier_complete(unsigned* bar, unsigned x, unsigned& nloc, unsigned& nx) {
    const unsigned G = gridDim.x * gridDim.y * gridDim.z;
    unsigned sum, cnt, mine, sp = 0u;
    for (;;) {
        sum = 0u; cnt = 0u; mine = 0u;
#pragma unroll
        for (unsigned j = 0; j < 16; ++j) { const unsigned c = xb_ld(&bar[XB_XCNT(j)]); sum += c; cnt += (c > 0u) ? 1u : 0u; mine = (j == x) ? c : mine; }
        if (sum == G) break;
        __builtin_amdgcn_s_sleep(1);
        if ((++sp & 255u) == 0u) { if (xb_ld(&bar[XB_TMO])) break; if (sp > XB_SPIN_CAP) { atomicAdd(&bar[XB_TMO], 1u); break; } }
    }
    nloc = mine > 0u ? mine : 1u; nx = cnt > 0u ? cnt : 1u;
}
__device__ __forceinline__ void xcd_barrier(const XcdBarrier& b) {
    asm volatile("s_waitcnt vmcnt(0)" ::: "memory");
    __syncthreads();
    if (threadIdx.x == 0) {
        unsigned* bar = b.bar;
        __builtin_amdgcn_s_waitcnt(0);
        unsigned nloc = b.st[0], nx = b.st[1];
        if (nloc == 0u) { xcd_barrier_complete(bar, b.x, nloc, nx); b.st[0] = nloc; b.st[1] = nx; }
        const unsigned old = xb_add(&bar[XB_XSUB(b.x)], 1u);
        const unsigned gen = old / nloc;
        if (old + 1u == (gen + 1u) * nloc) {
            __builtin_amdgcn_fence(__ATOMIC_RELEASE, "agent");
            asm volatile("s_waitcnt vmcnt(0)" ::: "memory");
            const unsigned og = xb_add(&bar[XB_TOP], 1u);
            const unsigned tg = og / nx;
            if (og + 1u == (tg + 1u) * nx) xb_add(&bar[XB_TOPGEN], 1u);
            else XB_SPIN(xb_ld(&bar[XB_TOPGEN]) == tg, bar);
            __builtin_amdgcn_fence(__ATOMIC_ACQUIRE, "agent");
            xb_add(&bar[XB_XGEN(b.x)], 1u);
            asm volatile("s_waitcnt vmcnt(0)" ::: "memory");
        } else {
            XB_SPIN(xb_ld(&bar[XB_XGEN(b.x)]) == gen, bar);
            __builtin_amdgcn_fence(__ATOMIC_ACQUIRE, "agent");
            asm volatile("s_waitcnt vmcnt(0)" ::: "memory");
        }
    }
    __syncthreads();
}

struct Args { const float* in[25]; float* out; unsigned char* ws; int ph_lo, ph_hi; };
enum { I_X = 0, I_MEM, I_LNIG, I_LNIB, I_WIN, I_FB, I_LQ1, I_LK1, I_LQ2, I_LK2, I_DNG, I_HLB, I_HNG, I_WOUT, I_WQ, I_WK, I_WV, I_WO, I_RW, I_RB, I_W1, I_W3, I_W2, I_LNG, I_LNB };

struct Frame {
    LAS unsigned char* lds; unsigned char* ws; gu32* ctl; float* out;
    int tid, lane, wave, G, bid;
};
#define WSP(T, off) ((T*)(F.ws + (off)))

__device__ __forceinline__ void tr_item(const float* W, int ldsrc, int nsrc0, bf16* WT, int ldd, int ndst0, int k0, LAS float* scr, int lane) {
#pragma unroll 8
    for (int i = 0; i < 32; ++i) { const int kk = 2 * i + (lane >> 5); scr[kk * 33 + (lane & 31)] = W[(size_t)(k0 + kk) * ldsrc + nsrc0 + (lane & 31)]; }
    LDS_WAIT(); asm volatile("" ::: "memory");
    const int c = lane & 7;
#pragma unroll
    for (int j = 0; j < 4; ++j) { const int n = (lane >> 3) + 8 * j; const LAS float* s = scr + (8 * c) * 33 + n;
        u32x4 o; o.x = cvt_pk_bf16(s[0 * 33], s[1 * 33]); o.y = cvt_pk_bf16(s[2 * 33], s[3 * 33]); o.z = cvt_pk_bf16(s[4 * 33], s[5 * 33]); o.w = cvt_pk_bf16(s[6 * 33], s[7 * 33]);
        *(u32x4*)(WT + (size_t)(ndst0 + n) * ldd + k0 + 8 * c) = o; }
    LDS_WAIT(); asm volatile("" ::: "memory");
}
__device__ __forceinline__ void convert_weights(const Frame& F, const Args& A, int l) {
    LAS float* scr = (LAS float*)(F.lds + RING_OFF + F.wave * 16384);
    const int gw = F.bid * NWAVES + F.wave, NGW = F.G * NWAVES;
    constexpr int I_IN = 16 * 112, I_SQ = 16 * 32, I_13 = 16 * 2 * 16 * 16, I_2 = 16 * 8 * 32;
    constexpr int NITEMS = I_IN + 5 * I_SQ + I_13 + I_2;
    for (int it = gw; it < NITEMS; it += NGW) {
        int r = it;
        if (r < I_IN) { const int kb = r / 112, nb = r % 112; const int nd = nb * 32, ns = nd < 768 ? nd : nd + 4;
            tr_item(A.in[I_WIN] + (size_t)l * DM * INW, INW, ns, WSP(bf16, WS_WIN), DM, nd, kb * 64, scr, F.lane); continue; }
        r -= I_IN;
        if (r < 5 * I_SQ) { const int w = r / I_SQ, rr = r % I_SQ, kb = rr / 32, nb = rr % 32;
            const float* src = (w == 0 ? A.in[I_WOUT] : w == 1 ? A.in[I_WQ] : w == 2 ? A.in[I_WK] : w == 3 ? A.in[I_WV] : A.in[I_WO]) + (size_t)l * DM * DM;
            bf16* dst = (bf16*)(F.ws + (w == 0 ? WS_WOUT : w == 1 ? WS_WQ : w == 2 ? WS_WK : w == 3 ? WS_WV : WS_WO));
            tr_item(src, DM, nb * 32, dst, DM, nb * 32, kb * 64, scr, F.lane); continue; }
        r -= 5 * I_SQ;
        if (r < I_13) { const int e = r / 512, rr = r % 512, which = rr / 256, r2 = rr % 256, kb = r2 / 16, nb = r2 % 16;
            const float* src = (which == 0 ? A.in[I_W1] : A.in[I_W3]) + ((size_t)l * NEXP + e) * DM * EFF;
            const int j0 = nb * 32, nd = (j0 / 128) * 256 + which * 128 + (j0 % 128);
            tr_item(src, EFF, j0, WSP(bf16, WS_W13) + (size_t)e * 1024 * DM, DM, nd, kb * 64, scr, F.lane); continue; }
        r -= I_13;
        { const int e = r / 256, rr = r % 256, kb = rr / 32, nb = rr % 32;
            const float* src = A.in[I_W2] + ((size_t)l * NEXP + e) * EFF * DM;
            tr_item(src, DM, nb * 32, WSP(bf16, WS_W2) + (size_t)e * 1024 * EFF, EFF, nb * 32, kb * 64, scr, F.lane); }
    }
}

__device__ __forceinline__ void ln_regs(f32x4 (&v)[4], const float* g, const float* b, int lane) {
    float s = 0.f;
#pragma unroll
    for (int j = 0; j < 4; ++j) s += (v[j].x + v[j].y) + (v[j].z + v[j].w);
    const float mean = wave_sum(s) * (1.f / DM); float s2 = 0.f;
#pragma unroll
    for (int j = 0; j < 4; ++j) { v[j] = v[j] - mean; s2 += (v[j].x * v[j].x + v[j].y * v[j].y) + (v[j].z * v[j].z + v[j].w * v[j].w); }
    const float rstd = 1.f / sqrtf(wave_sum(s2) * (1.f / DM) + LN_EPS);
#pragma unroll
    for (int j = 0; j < 4; ++j) { const f32x4 gg = *(const f32x4*)(g + 4 * lane + 256 * j), bb = *(const f32x4*)(b + 4 * lane + 256 * j); v[j] = v[j] * rstd * gg + bb; }
}
__device__ __forceinline__ void store_row(const f32x4 (&v)[4], float* o32, bf16* o16, int lane) {
#pragma unroll
    for (int j = 0; j < 4; ++j) { if (o32) *(f32x4*)(o32 + 4 * lane + 256 * j) = v[j];
        if (o16) { u32x2 w; w.x = cvt_pk_bf16(v[j].x, v[j].y); w.y = cvt_pk_bf16(v[j].z, v[j].w); *(u32x2*)(o16 + 4 * lane + 256 * j) = w; } }
}
__device__ __forceinline__ void fox_forget(const f32x4 (&v)[4], const LAS float* WF, const float* fb, float* lf2row, int lane) {
    f32x4 a = {0.f, 0.f, 0.f, 0.f};
#pragma unroll
    for (int j = 0; j < 4; ++j)
#pragma unroll
        for (int i = 0; i < 4; ++i) { const f32x4 w = *(const LAS f32x4*)(WF + (4 * lane + 256 * j + i) * 4); a = a + w * v[j][i]; }
#pragma unroll
    for (int c = 0; c < 4; ++c) a[c] = wave_sum(a[c]);
    if (lane == 0) { f32x4 o;
#pragma unroll
        for (int c = 0; c < 4; ++c) o[c] = log_sigmoidf_(a[c] + fb[c]) * LOG2E;
        *(f32x4*)lf2row = o; }
}
__device__ __forceinline__ void load_wf(const Frame& F, const Args& A, int l, LAS float* WF) {
    const float* w = A.in[I_WIN] + (size_t)l * DM * INW + 768;
    for (int k = F.tid; k < DM; k += NTHR) *(LAS f32x4*)(WF + 4 * k) = *(const f32x4*)(w + (size_t)k * INW);
    __syncthreads();
}

__device__ __forceinline__ void phase_prologue(const Frame& F, const Args& A) {
    convert_weights(F, A, 0);
    __syncthreads();
    LAS float* WF = (LAS float*)(F.lds + XCH_OFF - 16384);
    load_wf(F, A, 0, WF);
    const int gw = F.bid * NWAVES + F.wave, NGW = F.G * NWAVES;
    for (int m = gw; m < NB * 256; m += NGW) { f32x4 v[4];
#pragma unroll
        for (int j = 0; j < 4; ++j) v[j] = *(const f32x4*)(A.in[I_MEM] + (size_t)m * DM + 4 * F.lane + 256 * j);
        store_row(v, nullptr, WSP(bf16, WS_MEMB) + (size_t)m * DM, F.lane); }
    for (int m = gw; m < MTOK; m += NGW) { f32x4 v[4];
#pragma unroll
        for (int j = 0; j < 4; ++j) v[j] = *(const f32x4*)(A.in[I_X] + (size_t)m * DM + 4 * F.lane + 256 * j);
        ln_regs(v, A.in[I_LNIG], A.in[I_LNIB], F.lane);
        store_row(v, F.out + (size_t)m * DM, WSP(bf16, WS_R1) + (size_t)m * DM, F.lane);
        fox_forget(v, WF, A.in[I_FB], WSP(float, WS_LF2) + (size_t)m * 4, F.lane); }
}
__device__ __forceinline__ void phase_ln1(const Frame& F, const Args& A, int l) {
    const int gw = F.bid * NWAVES + F.wave, NGW = F.G * NWAVES;
    const float* g = A.in[I_LNG] + (size_t)(l * 3 + 0) * DM; const float* b = A.in[I_LNB] + (size_t)(l * 3 + 0) * DM;
    for (int m = gw; m < MTOK; m += NGW) { f32x4 v[4];
#pragma unroll
        for (int j = 0; j < 4; ++j) v[j] = *(const f32x4*)(F.out + (size_t)m * DM + 4 * F.lane + 256 * j);
        ln_regs(v, g, b, F.lane);
        store_row(v, F.out + (size_t)m * DM, WSP(bf16, WS_R1) + (size_t)m * DM, F.lane); }
}
__device__ __forceinline__ void phase_ln3(const Frame& F, const Args& A, int l) {
    LAS float* WF = (LAS float*)(F.lds + XCH_OFF - 16384);
    if (l == 0) { convert_weights(F, A, 1); __syncthreads(); load_wf(F, A, 1, WF); }
    const int gw = F.bid * NWAVES + F.wave, NGW = F.G * NWAVES;
    const float* g = A.in[I_LNG] + (size_t)(l * 3 + 2) * DM; const float* b = A.in[I_LNB] + (size_t)(l * 3 + 2) * DM;
    const bf16* CB = WSP(bf16, WS_CB);
    for (int m = gw; m < MTOK; m += NGW) { f32x4 v[4];
#pragma unroll
        for (int j = 0; j < 4; ++j) { v[j] = *(const f32x4*)(F.out + (size_t)m * DM + 4 * F.lane + 256 * j);
            const u32x2 c0 = *(const u32x2*)(CB + (size_t)(2 * m) * DM + 4 * F.lane + 256 * j), c1 = *(const u32x2*)(CB + (size_t)(2 * m + 1) * DM + 4 * F.lane + 256 * j);
            v[j].x = v[j].x * ALPHA + (__uint_as_float(c0.x << 16) + __uint_as_float(c1.x << 16)); v[j].y = v[j].y * ALPHA + (__uint_as_float(c0.x & 0xffff0000u) + __uint_as_float(c1.x & 0xffff0000u));
            v[j].z = v[j].z * ALPHA + (__uint_as_float(c0.y << 16) + __uint_as_float(c1.y << 16)); v[j].w = v[j].w * ALPHA + (__uint_as_float(c0.y & 0xffff0000u) + __uint_as_float(c1.y & 0xffff0000u)); }
        ln_regs(v, g, b, F.lane);
        store_row(v, F.out + (size_t)m * DM, l == 0 ? WSP(bf16, WS_R1) + (size_t)m * DM : nullptr, F.lane);
        if (l == 0) fox_forget(v, WF, A.in[I_FB] + 4, WSP(float, WS_LF2) + (size_t)m * 4, F.lane); }
}
__device__ __forceinline__ void fox_cumsum(const Frame& F) {
    if (F.bid >= 16) return;
    const int b = F.bid >> 2, h = F.bid & 3; const float* src = WSP(float, WS_LF2) + (size_t)b * SEQ * 4 + h; float* dst = WSP(float, WS_CUMF) + (size_t)F.bid * SEQ;
    LAS float* tot = (LAS float*)(F.lds + XCH_OFF);
    float v[16]; float run = 0.f;
#pragma unroll
    for (int i = 0; i < 16; ++i) { run += src[(size_t)(F.tid * 16 + i) * 4]; v[i] = run; }
    float inc = run;
#pragma unroll
    for (int o = 1; o < 64; o <<= 1) { const float t = __shfl_up(inc, o); if (F.lane >= o) inc += t; }
    if (F.lane == 63) tot[F.wave] = inc;
    __syncthreads();
    float base = inc - run;
    for (int w = 0; w < F.wave; ++w) base += tot[w];
#pragma unroll
    for (int i = 0; i < 16; ++i) dst[F.tid * 16 + i] = v[i] + base;
    __syncthreads();
}
__device__ __forceinline__ void phase_ln2_route(const Frame& F, const Args& A, int l) {
    LAS float* RW = (LAS float*)(F.lds + RING_OFF);
    LAS int* REC = (LAS int*)(F.lds + RING_OFF + 65536);
    LAS int* CNT = (LAS int*)(F.lds + RING_OFF + 65536 + 2048);
    LAS int* BASE = CNT + 16; LAS int* NREC = CNT + 32;
    for (int i = F.tid; i < DM * 16 / 4; i += NTHR) *(LAS f32x4*)(RW + 4 * i) = *(const f32x4*)(A.in[I_RW] + 4 * i);
    if (F.tid < 16) CNT[F.tid] = 0;
    __syncthreads();
    const int gw = F.bid * NWAVES + F.wave, NGW = F.G * NWAVES;
    const float* g = A.in[I_LNG] + (size_t)(l * 3 + 1) * DM; const float* b = A.in[I_LNB] + (size_t)(l * 3 + 1) * DM;
    float* GATE = WSP(float, WS_GATE);
    int nrec = 0;
    for (int m = gw; m < MTOK; m += NGW, ++nrec) { f32x4 v[4];
#pragma unroll
        for (int j = 0; j < 4; ++j) v[j] = *(const f32x4*)(F.out + (size_t)m * DM + 4 * F.lane + 256 * j);
        ln_regs(v, g, b, F.lane);
        store_row(v, F.out + (size_t)m * DM, WSP(bf16, WS_R1) + (size_t)m * DM, F.lane);
        f32x4 a[4];
#pragma unroll
        for (int q = 0; q < 4; ++q) a[q] = (f32x4){0.f, 0.f, 0.f, 0.f};
#pragma unroll
        for (int j = 0; j < 4; ++j)
#pragma unroll
            for (int i = 0; i < 4; ++i) { const LAS float* wr = RW + (4 * F.lane + 256 * j + i) * 16; const float x = v[j][i];
#pragma unroll
                for (int q = 0; q < 4; ++q) a[q] = a[q] + *(const LAS f32x4*)(wr + 4 * q) * x; }
        float sc[16], bi[16];
#pragma unroll
        for (int q = 0; q < 4; ++q)
#pragma unroll
            for (int i = 0; i < 4; ++i) { const float lg = wave_sum(a[q][i]); const float s = 1.f / (1.f + __expf(-lg)); sc[q * 4 + i] = s; bi[q * 4 + i] = s + A.in[I_RB][q * 4 + i]; }
        int gs = 0; float best = -INFINITY;
#pragma unroll
        for (int q = 0; q < 4; ++q) { float m1 = -INFINITY, m2 = -INFINITY;
#pragma unroll
            for (int i = 0; i < 4; ++i) { const float x = bi[q * 4 + i]; if (x > m1) { m2 = m1; m1 = x; } else if (x > m2) m2 = x; }
            const float s = m1 + m2; if (s > best) { best = s; gs = q; } }
        float bq[4], sq[4];
#pragma unroll
        for (int i = 0; i < 4; ++i) { bq[i] = gs == 0 ? bi[i] : gs == 1 ? bi[4 + i] : gs == 2 ? bi[8 + i] : bi[12 + i]; sq[i] = gs == 0 ? sc[i] : gs == 1 ? sc[4 + i] : gs == 2 ? sc[8 + i] : sc[12 + i]; }
        int i0 = 0; float b0 = bq[0];
#pragma unroll
        for (int i = 1; i < 4; ++i) if (bq[i] > b0) { b0 = bq[i]; i0 = i; }
        int i1 = -1; float b1 = -INFINITY;
#pragma unroll
        for (int i = 0; i < 4; ++i) if (i != i0 && bq[i] > b1) { b1 = bq[i]; i1 = i; }
        const float s0 = i0 == 0 ? sq[0] : i0 == 1 ? sq[1] : i0 == 2 ? sq[2] : sq[3];
        const float s1 = i1 == 0 ? sq[0] : i1 == 1 ? sq[1] : i1 == 2 ? sq[2] : sq[3];
        const int e0 = gs * 4 + i0, e1 = gs * 4 + i1;
        if (F.lane == 0) { const float inv = 1.f / (s0 + s1); GATE[2 * m] = s0 * inv; GATE[2 * m + 1] = s1 * inv;
            const int r0 = __hip_atomic_fetch_add(&CNT[e0], 1, __ATOMIC_RELAXED, __HIP_MEMORY_SCOPE_WORKGROUP), r1 = __hip_atomic_fetch_add(&CNT[e1], 1, __ATOMIC_RELAXED, __HIP_MEMORY_SCOPE_WORKGROUP);
            LAS int* rec = REC + (F.wave * 16 + nrec) * 4; rec[0] = m; rec[1] = e0; rec[2] = e1; rec[3] = r0 | (r1 << 16); }
    }
    if (F.lane == 0) NREC[F.wave] = nrec;
    __syncthreads();
    if (F.tid < 16) BASE[F.tid] = (int)__hip_atomic_fetch_add((unsigned*)(F.ctl + CW_ECNT + (l * 16 + F.tid) * 64), (unsigned)CNT[F.tid], RLX_AGENT);
    __syncthreads();
    int* LIST = WSP(int, WS_LIST);
    if (F.tid < 128) { const int w = F.tid >> 4, i = F.tid & 15; const int cnt_w = NREC[w];
        if (i < cnt_w) { const LAS int* rec = REC + F.tid * 4; const int m = rec[0], e0 = rec[1], e1 = rec[2], rr = rec[3];
            LIST[(size_t)e0 * MTOK + BASE[e0] + (rr & 0xffff)] = 2 * m; LIST[(size_t)e1 * MTOK + BASE[e1] + (rr >> 16)] = 2 * m + 1; } }
    __syncthreads();
}
__device__ __forceinline__ void moe_tables(const Frame& F, int l) {
    LAS int* T = (LAS int*)(F.lds + TAB_OFF);
    if (F.tid == 0) { int cum = 0;
        for (int e = 0; e < 16; ++e) { const int n = (int)__hip_atomic_load((unsigned*)(F.ctl + CW_ECNT + (l * 16 + e) * 64), RLX_AGENT); T[e] = cum; T[32 + e] = n; cum += (n + 255) >> 8; }
        T[16] = cum; }
    __syncthreads();
}
namespace att {
constexpr int SLOTB = 8192;
constexpr int L_K = 0, L_V = 2 * SLOTB, L_KX = 4 * SLOTB, L_WS = L_KX + 2 * 2048, L_OST = L_WS + NWAVES * 256, L_END = L_OST + NWAVES * 8192;
static_assert(L_END <= RING_BYTES, "attention LDS");
__device__ __forceinline__ int crow(int r, int hi) { return (r & 3) + 8 * (r >> 2) + 4 * hi; }
__device__ __forceinline__ void glds16(const void* gsrc, unsigned lds_dst) { unsigned keep;
    asm volatile("s_mov_b32 %0, m0\n\ts_mov_b32 m0, %2\n\ts_nop 0\n\tglobal_load_lds_dwordx4 %1, off\n\ts_mov_b32 m0, %0" : "=&s"(keep) : "v"(gsrc), "s"(lds_dst) : "memory"); }
#define ATT_WAIT_BAR() asm volatile("s_waitcnt vmcnt(0) lgkmcnt(0)\n\ts_barrier" ::: "memory")
typedef short v4i16_t __attribute__((ext_vector_type(4)));
__device__ __forceinline__ s16x4 vtr(const LAS unsigned char* p) { return __builtin_bit_cast(s16x4, __builtin_amdgcn_ds_read_tr16_b64_v4i16((LAS v4i16_t*)p)); }
__device__ __forceinline__ float rowmax32(const f32x16& p0, const f32x16& p1) {
    float a = fmaxf(p0[0], p1[0]);
#pragma unroll
    for (int r = 1; r < 16; ++r) a = fmaxf(a, fmaxf(p0[r], p1[r]));
    auto rr = __builtin_amdgcn_permlane32_swap(__float_as_uint(a), __float_as_uint(a), false, false);
    return fmaxf(__uint_as_float(rr[0]), __uint_as_float(rr[1]));
}
__device__ __forceinline__ float half_sum(float a) { auto rr = __builtin_amdgcn_permlane32_swap(__float_as_uint(a), __float_as_uint(a), false, false); return __uint_as_float(rr[0]) + __uint_as_float(rr[1]); }
__device__ __forceinline__ bf16x8 pack8(const f32x16& p, int b) { u32x4 w; w.x = cvt_pk_bf16(p[b], p[b + 1]); w.y = cvt_pk_bf16(p[b + 2], p[b + 3]); w.z = cvt_pk_bf16(p[b + 4], p[b + 5]); w.w = cvt_pk_bf16(p[b + 6], p[b + 7]); return __builtin_bit_cast(bf16x8, w); }

__device__ __forceinline__ void softmax_step(f32x16& p0, f32x16& p1, float& m, float& l, f32x16 (&o)[2], bf16x8 (&pa)[4], LAS float* wsf, int r32, int hi) {
    const float rm = rowmax32(p0, p1); const float mn = fmaxf(m, rm);
    if (__any(mn > m)) {
        const float al = fast_exp2(m - mn); l *= al;
        if (hi == 0) wsf[r32] = al;
        LDS_WAIT();
#pragma unroll
        for (int g = 0; g < 4; ++g) { const f32x4 f = *(const LAS f32x4*)(wsf + 4 * hi + 8 * g);
#pragma unroll
            for (int i = 0; i < 4; ++i) { o[0][4 * g + i] *= f[i]; o[1][4 * g + i] *= f[i]; } }
        m = mn;
    }
    float s = 0.f;
#pragma unroll
    for (int r = 0; r < 16; ++r) { p0[r] = fast_exp2(p0[r] - m); p1[r] = fast_exp2(p1[r] - m); s += p0[r] + p1[r]; }
    l += s;
    pa[0] = pack8(p0, 0); pa[1] = pack8(p0, 8); pa[2] = pack8(p1, 0); pa[3] = pack8(p1, 8);
}

template <int MODE>
__device__ __forceinline__ void attn_unit(const Frame& F, const Args& A, int l, int b, int h, int qb) {
    LAS unsigned char* shm = F.lds + RING_OFF;
    const int lane = F.lane, r32 = lane & 31, hi = lane >> 5, wid = F.wave;
    const bf16* PA = WSP(bf16, WS_PA);
    const size_t rowbase = (size_t)b * SEQ; const int q0 = qb * 256;
    constexpr int QC = MODE == 0 ? 0 : 768, KC = MODE == 0 ? 256 : 1024, VC = MODE == 0 ? 512 : 1280;
    const bf16* Qw = PA + (rowbase + q0 + wid * 32 + r32) * PA_LD + QC + h * 64;
    const bf16* Kh = PA + rowbase * PA_LD + KC + h * 64; const bf16* Vh = PA + rowbase * PA_LD + VC + h * 64;
    const unsigned lds0 = (unsigned)(uintptr_t)shm;
    LAS float* wsf = (LAS float*)(shm + L_WS) + wid * 64;
    const bf16* ksrc = Kh + (size_t)lane * PA_LD + wid * 8;
    const bf16* vsrc = Vh + (size_t)(16 * (wid & 3) + (lane >> 2)) * PA_LD + (wid >> 2) * 32 + (lane & 3) * 8;
    const unsigned kdst = lds0 + L_K + wid * 1024, vdst = lds0 + L_V + wid * 1024;
#define DMA_KV(t, slot) do { glds16(ksrc + (size_t)(t) * 64 * PA_LD, (unsigned)__builtin_amdgcn_readfirstlane(kdst + (slot) * SLOTB)); glds16(vsrc + (size_t)(t) * 64 * PA_LD, (unsigned)__builtin_amdgcn_readfirstlane(vdst + (slot) * SLOTB)); } while (0)
    bf16x8 qr[4];
#pragma unroll
    for (int d0 = 0; d0 < 4; ++d0) qr[d0] = *(const bf16x8*)(Qw + d0 * 16 + hi * 8);
    const int NT = 4 * qb + 4;
    const float* cum = WSP(float, WS_CUMF) + (size_t)(b * 4 + h) * SEQ;
    float cq0 = 0.f; if (MODE == 0) cq0 = cum[q0];
#define TILE_OF(i) (MODE == 0 ? (NT - 1 - (i)) : (i))
#define KX_LOAD(t) (cq0 - cum[(t) * 64 + F.tid])
#define KX_STORE(slot, bv) do { const float b_ = (bv); const unsigned hb_ = cvt_pk_bf16(b_, 0.f) & 0xffffu; const float lo_ = b_ - __uint_as_float(hb_ << 16); u32x4 w_; w_.x = hb_ | (cvt_pk_bf16(lo_, 0.f) << 16); w_.y = 0u; w_.z = 0u; w_.w = 0u; \
        *(LAS u32x4*)(shm + L_KX + (slot) * 2048 + F.tid * 16) = w_; } while (0)
    float kxv = 0.f;
    DMA_KV(TILE_OF(0), 0);
    if (MODE == 0 && F.tid < 64) { kxv = KX_LOAD(TILE_OF(0)); KX_STORE(0, kxv); }
    float m1 = -INFINITY, l1 = 0.f, m2 = -INFINITY, l2 = 0.f;
    f32x16 o1[2], o2[2];
#pragma unroll
    for (int d = 0; d < 2; ++d) { o1[d] = f32x16{}; o2[d] = f32x16{}; }
    u32x4 qxw; qxw.x = hi == 0 ? 0x3F803F80u : 0u; qxw.y = 0u; qxw.z = 0u; qxw.w = 0u; const bf16x8 qx = __builtin_bit_cast(bf16x8, qxw);
    const int qmin = q0 + wid * 32, qrow = qmin + r32;
    ATT_WAIT_BAR();
    for (int i = 0; i < NT; ++i) {
        const int cur = i & 1, t = TILE_OF(i);
        if (i + 1 < NT) { DMA_KV(TILE_OF(i + 1), cur ^ 1); if (MODE == 0 && F.tid < 64) kxv = KX_LOAD(TILE_OF(i + 1)); }
        const bool active = MODE == 0 ? (64 * t <= qmin + 31) : (t <= 4 * qb + (wid >> 1));
        if (active) {
            const LAS unsigned char* kb = shm + L_K + cur * SLOTB + hi * 1024 + r32 * 16;
            const LAS unsigned char* vb = shm + L_V + cur * SLOTB + ((lane >> 4) & 1) * 32 + (lane & 3) * 8 + (4 * hi + ((lane & 15) >> 2)) * 64;
            bf16x8 pa1[4], pa2[4];
            {
                f32x16 p0 = f32x16{}, p1 = f32x16{};
#pragma unroll
                for (int d0 = 0; d0 < (MODE == 0 ? 4 : 2); ++d0) { const bf16x8 k0 = *(const LAS bf16x8*)(kb + d0 * 2048), k1 = *(const LAS bf16x8*)(kb + d0 * 2048 + 512);
                    p0 = __builtin_amdgcn_mfma_f32_32x32x16_bf16(k0, qr[d0], p0, 0, 0, 0); p1 = __builtin_amdgcn_mfma_f32_32x32x16_bf16(k1, qr[d0], p1, 0, 0, 0); }
                if (MODE == 0) {
                    const LAS unsigned char* kx = shm + L_KX + cur * 2048 + r32 * 16; bf16x8 x0 = *(const LAS bf16x8*)kx, x1 = *(const LAS bf16x8*)(kx + 512);
                    if (hi) { x0 = bf16x8{}; x1 = bf16x8{}; }
                    p0 = __builtin_amdgcn_mfma_f32_32x32x16_bf16(x0, qx, p0, 0, 0, 0); p1 = __builtin_amdgcn_mfma_f32_32x32x16_bf16(x1, qx, p1, 0, 0, 0);
                    if (64 * t + 63 > qmin) {
#pragma unroll
                        for (int r = 0; r < 16; ++r) { const int kv = 64 * t + crow(r, hi); if (kv > qrow) p0[r] = -INFINITY; if (kv + 32 > qrow) p1[r] = -INFINITY; } }
                }
                softmax_step(p0, p1, m1, l1, o1, pa1, wsf, r32, hi);
            }
            if (MODE == 1) {
                f32x16 p0 = f32x16{}, p1 = f32x16{};
#pragma unroll
                for (int d0 = 2; d0 < 4; ++d0) { const bf16x8 k0 = *(const LAS bf16x8*)(kb + d0 * 2048), k1 = *(const LAS bf16x8*)(kb + d0 * 2048 + 512);
                    p0 = __builtin_amdgcn_mfma_f32_32x32x16_bf16(k0, qr[d0], p0, 0, 0, 0); p1 = __builtin_amdgcn_mfma_f32_32x32x16_bf16(k1, qr[d0], p1, 0, 0, 0); }
                softmax_step(p0, p1, m2, l2, o2, pa2, wsf, r32, hi);
            }
#pragma unroll
            for (int d0 = 0; d0 < 2; ++d0) {
#pragma unroll
                for (int ks = 0; ks < 4; ++ks) { const s16x4 lo = vtr(vb + d0 * 4096 + ks * 1024), hi4 = vtr(vb + d0 * 4096 + ks * 1024 + 512);
                    const bf16x8 vf = (bf16x8){lo[0], lo[1], lo[2], lo[3], hi4[0], hi4[1], hi4[2], hi4[3]};
                    o1[d0] = __builtin_amdgcn_mfma_f32_32x32x16_bf16(pa1[ks], vf, o1[d0], 0, 0, 0);
                    if (MODE == 1) o2[d0] = __builtin_amdgcn_mfma_f32_32x32x16_bf16(pa2[ks], vf, o2[d0], 0, 0, 0); }
            }
        }
        if (MODE == 0 && i + 1 < NT && F.tid < 64) KX_STORE(cur ^ 1, kxv);
        ATT_WAIT_BAR();
    }
    l1 = half_sum(l1); if (MODE == 1) l2 = half_sum(l2);
    float lam = 0.f, post = 1.f;
    if (MODE == 1) { float d1 = 0.f, d2 = 0.f;
        for (int i = 0; i < 32; ++i) { d1 += A.in[I_LQ1][l * 32 + i] * A.in[I_LK1][l * 32 + i]; d2 += A.in[I_LQ2][l * 32 + i] * A.in[I_LK2][l * 32 + i]; }
        const float lam_init = 0.8f - 0.6f * __expf(-0.3f * (float)l); lam = __expf(d1) - __expf(d2) + lam_init; post = 1.f - lam_init; }
    if (hi == 0) { wsf[r32] = 1.f / l1; if (MODE == 1) wsf[32 + r32] = lam / l2; }
    LDS_WAIT();
    LAS float* stg = (LAS float*)(shm + L_OST) + wid * 2048;
#pragma unroll
    for (int g = 0; g < 4; ++g) { const f32x4 c1 = *(const LAS f32x4*)(wsf + 4 * hi + 8 * g); f32x4 c2 = {0.f, 0.f, 0.f, 0.f}; if (MODE == 1) c2 = *(const LAS f32x4*)(wsf + 32 + 4 * hi + 8 * g);
#pragma unroll
        for (int i = 0; i < 4; ++i) { const int r = 4 * g + i, orow = crow(r, hi);
#pragma unroll
            for (int d0 = 0; d0 < 2; ++d0) { float v = o1[d0][r] * c1[i]; if (MODE == 1) v -= o2[d0][r] * c2[i]; stg[orow * 64 + d0 * 32 + r32] = v; } } }
    LDS_WAIT();
    bf16* Y = WSP(bf16, WS_R1) + (rowbase + q0 + wid * 32) * DM + (MODE == 0 ? 0 : 256) + h * 64;
    const float* gn = A.in[I_DNG] + l * 64;
#pragma unroll
    for (int i = 0; i < 4; ++i) { const int row = i * 8 + (lane >> 3), ch = lane & 7; f32x4 a = *(const LAS f32x4*)(stg + row * 64 + ch * 8), c = *(const LAS f32x4*)(stg + row * 64 + ch * 8 + 4);
        if (MODE == 1) { float ss = (a[0] * a[0] + a[1] * a[1]) + (a[2] * a[2] + a[3] * a[3]) + (c[0] * c[0] + c[1] * c[1]) + (c[2] * c[2] + c[3] * c[3]);
            ss += __shfl_xor(ss, 1); ss += __shfl_xor(ss, 2); ss += __shfl_xor(ss, 4);
            const float rs = post / sqrtf(ss * (1.f / 64.f) + LN_EPS); const f32x4 g0 = *(const f32x4*)(gn + ch * 8), g1 = *(const f32x4*)(gn + ch * 8 + 4);
            a = a * rs * g0; c = c * rs * g1; }
        u32x4 w; w.x = cvt_pk_bf16(a[0], a[1]); w.y = cvt_pk_bf16(a[2], a[3]); w.z = cvt_pk_bf16(c[0], c[1]); w.w = cvt_pk_bf16(c[2], c[3]);
        *(u32x4*)(Y + (size_t)row * DM + ch * 8) = w; }
    ATT_WAIT_BAR();
#undef DMA_KV
#undef TILE_OF
#undef KX_LOAD
#undef KX_STORE
}
template <int MODE>
__device__ __forceinline__ void attn_phase(const Frame& F, const Args& A, int l) {
    for (int c = F.bid; c < 256; c += F.G) { const int bh = c >> 4, s = c & 15;
        attn_unit<MODE>(F, A, l, bh >> 2, bh & 3, 31 - s); attn_unit<MODE>(F, A, l, bh >> 2, bh & 3, s); }
}
}
namespace hg {
constexpr int PQ = 136, PV = 72;
constexpr int L_QD = 0, L_KD = 17408, L_KO = 34816, L_QS = 43520, L_VT = 60928, L_ST = 79360, L_SEG = 114176, L_END = 116224, L_OST = 0;
static_assert(L_END <= RING_BYTES, "hgrn LDS");
struct Prep { float q[16], k[16], bc[16]; float blast, b31; };
__device__ __forceinline__ void prep(const Frame& F, const Args& A, int l, int b, int h, int n, bool need_q, Prep& P) {
    const int c = F.tid & 127, seg = F.tid >> 7; const size_t tok0 = (size_t)b * SEQ + n * 64 + seg * 16; const int ch = h * 128 + c;
    const float* HF = WSP(float, WS_HF) + tok0 * 512 + ch; const bf16* HQ = WSP(bf16, WS_HQ) + tok0 * 512 + ch;
    float lb = 0.f; if (l == 1) { const float b0 = A.in[I_HLB][ch], b1 = A.in[I_HLB][512 + ch]; lb = 1.f / (1.f + __expf(b0 - b1)); }
    LAS float* SEG = (LAS float*)(F.lds + L_SEG);
    float run = 0.f;
#pragma unroll
    for (int i = 0; i < 16; ++i) { const float x = HF[(size_t)i * 512]; const float s = 1.f / (1.f + __expf(-x));
        const float lf = (l == 0) ? log_sigmoidf_(x) : __logf(lb + (1.f - lb) * s);
        run += lf * LOG2E; P.bc[i] = run; P.k[i] = (1.f - lb) * (1.f - s); P.q[i] = need_q ? bf2f(HQ[(size_t)i * 512]) : 0.f; }
    SEG[seg * 128 + c] = run;
    __syncthreads();
    const float s0 = SEG[c], s1 = SEG[128 + c], s2 = SEG[256 + c], s3 = SEG[384 + c];
    const float pre = seg == 0 ? 0.f : seg == 1 ? s0 : seg == 2 ? s0 + s1 : s0 + s1 + s2;
#pragma unroll
    for (int i = 0; i < 16; ++i) P.bc[i] += pre;
    P.b31 = s0 + s1; P.blast = (s0 + s1) + (s2 + s3);
}
__device__ __forceinline__ void store16(LAS unsigned char* dst, const float (&v)[16]) {
    u32x4 a, b; a.x = cvt_pk_bf16(v[0], v[1]); a.y = cvt_pk_bf16(v[2], v[3]); a.z = cvt_pk_bf16(v[4], v[5]); a.w = cvt_pk_bf16(v[6], v[7]);
    b.x = cvt_pk_bf16(v[8], v[9]); b.y = cvt_pk_bf16(v[10], v[11]); b.z = cvt_pk_bf16(v[12], v[13]); b.w = cvt_pk_bf16(v[14], v[15]);
    *(LAS u32x4*)dst = a; *(LAS u32x4*)(dst + 16) = b;
}
__device__ __forceinline__ void load_vt(const Frame& F, int b, int h, int n) {
    const int c = F.tid & 127, seg = F.tid >> 7; const bf16* HI = WSP(bf16, WS_HI) + ((size_t)b * SEQ + n * 64 + seg * 16) * 512 + h * 128 + c;
    float v[16];
#pragma unroll
    for (int i = 0; i < 16; ++i) v[i] = bf2f(HI[(size_t)i * 512]);
    store16(F.lds + L_VT + c * (PV * 2) + seg * 32, v);
}
__device__ __forceinline__ void pass1_unit(const Frame& F, const Args& A, int l, int U) {
    const int bh = U >> 7, n = U & 127, b = bh >> 2, h = bh & 3; const int c = F.tid & 127, seg = F.tid >> 7;
    Prep P; prep(F, A, l, b, h, n, false, P);
    { float kd[16];
#pragma unroll
      for (int i = 0; i < 16; ++i) kd[i] = P.k[i] * fast_exp2(P.blast - P.bc[i]);
      store16(F.lds + L_KD + c * (PV * 2) + seg * 32, kd); }
    load_vt(F, b, h, n);
    if (seg == 0) WSP(float, WS_HDEC)[(size_t)U * 128 + c] = fast_exp2(P.blast);
    __syncthreads();
    const int lane = F.lane, r32 = lane & 31, hi = lane >> 5, vb = F.wave >> 1, db0 = (F.wave & 1) * 2;
    f32x16 acc[2]; acc[0] = f32x16{}; acc[1] = f32x16{};
#pragma unroll
    for (int ks = 0; ks < 4; ++ks) { const bf16x8 a = *(const LAS bf16x8*)(F.lds + L_VT + (vb * 32 + r32) * (PV * 2) + ks * 32 + hi * 16);
#pragma unroll
        for (int j = 0; j < 2; ++j) { const bf16x8 bb = *(const LAS bf16x8*)(F.lds + L_KD + ((db0 + j) * 32 + r32) * (PV * 2) + ks * 32 + hi * 16);
            acc[j] = __builtin_amdgcn_mfma_f32_32x32x16_bf16(a, bb, acc[j], 0, 0, 0); } }
    bf16* ST = WSP(bf16, WS_ST) + (size_t)U * 16384;
#pragma unroll
    for (int j = 0; j < 2; ++j)
#pragma unroll
        for (int r = 0; r < 16; ++r) { const int v = vb * 32 + (r & 3) + 8 * (r >> 2) + 4 * hi; ST[v * 128 + (db0 + j) * 32 + r32] = f2bf(acc[j][r]); }
    __syncthreads();
}
__device__ __forceinline__ void phase_pass1(const Frame& F, const Args& A, int l) { for (int U = F.bid; U < 2048; U += F.G) pass1_unit(F, A, l, U); }

__device__ __forceinline__ void phase_scan(const Frame& F) {
    unsigned* ST = WSP(unsigned, WS_ST); const float* HD = WSP(float, WS_HDEC);
    for (int g = F.bid * NTHR + F.tid; g < 16 * 8192; g += F.G * NTHR) { const int bh = g >> 13, rem = g & 8191, v = rem >> 6, d2 = rem & 63;
        unsigned* p = ST + ((size_t)bh * 128 * 16384 + v * 128) / 2 + d2; const float* dp = HD + (size_t)bh * 128 * 128 + 2 * d2;
        float s0 = 0.f, s1 = 0.f;
        for (int n0 = 0; n0 < 128; n0 += 8) { unsigned x[8]; f32x2 dc[8];
#pragma unroll
            for (int j = 0; j < 8; ++j) { x[j] = p[(size_t)(n0 + j) * 8192]; dc[j] = *(const f32x2*)(dp + (size_t)(n0 + j) * 128); }
#pragma unroll
            for (int j = 0; j < 8; ++j) { s0 = s0 * dc[j].x + __uint_as_float(x[j] << 16); s1 = s1 * dc[j].y + __uint_as_float(x[j] & 0xffff0000u); p[(size_t)(n0 + j) * 8192] = cvt_pk_bf16(s0, s1); } }
    }
}
__device__ __forceinline__ void pass3_unit(const Frame& F, const Args& A, int l, int U) {
    const int bh = U >> 7, n = U & 127, b = bh >> 2, h = bh & 3; const int c = F.tid & 127, seg = F.tid >> 7;
    if (n > 0) { const bf16* ST = WSP(bf16, WS_ST) + (size_t)(U - 1) * 16384;
#pragma unroll
        for (int i = 0; i < 4; ++i) { const int idx = F.tid + i * NTHR, v = idx >> 4, ch = idx & 15; *(LAS u32x4*)(F.lds + L_ST + v * (PQ * 2) + ch * 16) = *(const u32x4*)(ST + v * 128 + ch * 8); } }
    Prep P; prep(F, A, l, b, h, n, true, P);
    { const float ref = seg < 2 ? 0.f : P.b31;
      LAS bf16* QD = (LAS bf16*)(F.lds + L_QD); LAS bf16* KD = (LAS bf16*)(F.lds + L_KD); LAS bf16* KO = (LAS bf16*)(F.lds + L_KO); LAS bf16* QS = (LAS bf16*)(F.lds + L_QS);
#pragma unroll
      for (int i = 0; i < 16; ++i) { const int t = seg * 16 + i;
          QD[t * PQ + c] = f2bf(P.q[i] * fast_exp2(P.bc[i] - ref)); KD[t * PQ + c] = f2bf(P.k[i] * fast_exp2(ref - P.bc[i])); QS[t * PQ + c] = f2bf(P.q[i] * fast_exp2(P.bc[i]));
          if (seg < 2) KO[t * PQ + c] = f2bf(P.k[i] * fast_exp2(P.b31 - P.bc[i])); } }
    load_vt(F, b, h, n);
    __syncthreads();
    const int lane = F.lane, r32 = lane & 31, hi = lane >> 5, tb = F.wave >> 2, vb = F.wave & 3;
    f32x16 o = f32x16{};
    const LAS unsigned char* qd = F.lds + L_QD + (tb * 32 + r32) * (PQ * 2) + hi * 16;
    const LAS unsigned char* vt = F.lds + L_VT + (vb * 32 + r32) * (PV * 2) + hi * 8;
#pragma unroll
    for (int sb = 0; sb < 2; ++sb) {
        if (sb <= tb) {
            const LAS unsigned char* kk = (sb == tb) ? F.lds + L_KD + (sb * 32 + r32) * (PQ * 2) + hi * 16 : F.lds + L_KO + r32 * (PQ * 2) + hi * 16;
            f32x16 x = f32x16{};
#pragma unroll
            for (int ks = 0; ks < 8; ++ks) x = __builtin_amdgcn_mfma_f32_32x32x16_bf16(*(const LAS bf16x8*)(kk + ks * 32), *(const LAS bf16x8*)(qd + ks * 32), x, 0, 0, 0);
            if (sb == tb) {
#pragma unroll
                for (int r = 0; r < 16; ++r) { const int s = (r & 3) + 8 * (r >> 2) + 4 * hi; if (s > r32) x[r] = 0.f; } }
#pragma unroll
            for (int s2 = 0; s2 < 2; ++s2) { const bf16x8 pa = att::pack8(x, 8 * s2);
                const s16x4 lo = *(const LAS s16x4*)(vt + (sb * 32 + s2 * 16) * 2), hh = *(const LAS s16x4*)(vt + (sb * 32 + s2 * 16 + 8) * 2);
                const bf16x8 vf = (bf16x8){lo[0], lo[1], lo[2], lo[3], hh[0], hh[1], hh[2], hh[3]};
                o = __builtin_amdgcn_mfma_f32_32x32x16_bf16(pa, vf, o, 0, 0, 0); }
        }
    }
    if (n > 0) { const LAS unsigned char* qs = F.lds + L_QS + (tb * 32 + r32) * (PQ * 2) + hi * 16; const LAS unsigned char* st = F.lds + L_ST + (vb * 32 + r32) * (PQ * 2) + hi * 16;
#pragma unroll
        for (int ks = 0; ks < 8; ++ks) o = __builtin_amdgcn_mfma_f32_32x32x16_bf16(*(const LAS bf16x8*)(qs + ks * 32), *(const LAS bf16x8*)(st + ks * 32), o, 0, 0, 0); }
    __syncthreads();
    LAS float* OST = (LAS float*)(F.lds + L_OST);
#pragma unroll
    for (int r = 0; r < 16; ++r) { const int t = tb * 32 + (r & 3) + 8 * (r >> 2) + 4 * hi; OST[t * 132 + vb * 32 + r32] = o[r]; }
    __syncthreads();
    { const int t = F.tid >> 3, v0 = (F.tid & 7) * 16; const size_t tok = (size_t)b * SEQ + n * 64 + t;
      f32x4 x[4]; float ss = 0.f;
#pragma unroll
      for (int j = 0; j < 4; ++j) { x[j] = *(const LAS f32x4*)(OST + t * 132 + v0 + 4 * j); ss += (x[j][0] * x[j][0] + x[j][1] * x[j][1]) + (x[j][2] * x[j][2] + x[j][3] * x[j][3]); }
      ss += __shfl_xor(ss, 1); ss += __shfl_xor(ss, 2); ss += __shfl_xor(ss, 4);
      const float rs = 1.f / sqrtf(ss * (1.f / 128.f) + LN_EPS);
      const float* gn = A.in[I_HNG] + l * 128 + v0; const bf16* HG = WSP(bf16, WS_HG) + tok * 512 + h * 128 + v0;
      const u32x4 g0 = *(const u32x4*)HG, g1 = *(const u32x4*)(HG + 8); unsigned gw[8] = {g0.x, g0.y, g0.z, g0.w, g1.x, g1.y, g1.z, g1.w};
      unsigned w[8];
#pragma unroll
      for (int j = 0; j < 4; ++j) { const f32x4 gg = *(const f32x4*)(gn + 4 * j);
          const float y0 = x[j][0] * rs * gg[0] * __uint_as_float(gw[2 * j] << 16), y1 = x[j][1] * rs * gg[1] * __uint_as_float(gw[2 * j] & 0xffff0000u);
          const float y2 = x[j][2] * rs * gg[2] * __uint_as_float(gw[2 * j + 1] << 16), y3 = x[j][3] * rs * gg[3] * __uint_as_float(gw[2 * j + 1] & 0xffff0000u);
          w[2 * j] = cvt_pk_bf16(y0, y1); w[2 * j + 1] = cvt_pk_bf16(y2, y3); }
      bf16* Y = WSP(bf16, WS_R1) + tok * DM + 512 + h * 128 + v0;
      *(u32x4*)Y = (u32x4){w[0], w[1], w[2], w[3]}; *(u32x4*)(Y + 8) = (u32x4){w[4], w[5], w[6], w[7]}; }
    __syncthreads();
}
__device__ __forceinline__ void phase_pass3(const Frame& F, const Args& A, int l) { for (int U = F.bid; U < 2048; U += F.G) pass3_unit(F, A, l, U); }
}
#define DEBUG_AFTER_PHASE(p) do{}while(0)
#define DEBUG_BEFORE_PHASE(p) do{}while(0)
#define DEBUG_FINAL() do{}while(0)
#ifndef MK_N_LAUNCHES
#define MK_N_LAUNCHES 1
#endif

__global__ void __launch_bounds__(NTHR, 2) mk_fwd(Args args) {
    extern __shared__ __attribute__((aligned(16))) unsigned char lds_raw[];
    Frame F;
    F.lds = (LAS unsigned char*)lds_raw; F.ws = args.ws; F.ctl = (gu32*)(args.ws + WS_CTL); F.out = args.out;
    F.tid = threadIdx.x; F.lane = F.tid & 63; F.wave = __builtin_amdgcn_readfirstlane(F.tid >> 6); F.G = gridDim.x; F.bid = blockIdx.x;
    volatile LAS unsigned* MISC = (volatile LAS unsigned*)(F.lds + MISC_OFF);
    if (F.tid < 32) MISC[F.tid] = 0u;
    __syncthreads();
    const int lo = args.ph_lo, hi = args.ph_hi;
    XcdBarrier bar; bar.bar = (unsigned*)(F.ctl + CW_BAR); bar.x = 0; bar.st = nullptr;
    if (hi - lo > 1) bar = xcd_barrier_post((unsigned*)(F.ctl + CW_BAR), MISC + 8);
#ifdef ONLY_PH
#define IN(k) (((k) == 0 ? 0 : ((k) - 1) % NPH_L + 1) == ONLY_PH && lo <= (k) && (k) < hi)
#else
#define IN(k) (lo <= (k) && (k) < hi)
#endif
#define SEAM(k) do { if ((k) + 1 < hi) xcd_barrier(bar); } while (0)
    const Args& A = args;
    const Frame F0 = F;
#define FRESH() do { F = F0; int t_ = threadIdx.x; asm volatile("" : "+v"(t_)); F.tid = t_; F.lane = t_ & 63; } while (0)
    if (IN(0)) { FRESH(); phase_prologue(F, A); SEAM(0); }
    for (int l = 0; l < 2; ++l) {
        const int pb = 1 + NPH_L * l;
        if (IN(pb + 0)) { FRESH();
            fox_cumsum(F);
            pg8::ProjOrder S{(const char*)WSP(bf16, WS_R1), (const char*)WSP(bf16, WS_WIN), (const char*)WSP(bf16, WS_MEMB), (const char*)WSP(bf16, WS_WK), (const char*)WSP(bf16, WS_WV), F.G, F.bid};
            pg8::EpiProj E{WSP(bf16, WS_PA), WSP(bf16, WS_HQ), WSP(bf16, WS_HI), WSP(bf16, WS_HG), WSP(bf16, WS_KMEM), WSP(bf16, WS_VT), WSP(float, WS_HF)};
            pg8::gemm_phase<pg8::EpiProj, pg8::ProjOrder, false, true>(F.lds + RING_OFF, DM, DM, DM, S, E);
            SEAM(pb + 0);
        }
        if (IN(pb + 1)) { FRESH(); hg::phase_pass1(F, A, l); att::attn_phase<0>(F, A, l); SEAM(pb + 1); }
        if (IN(pb + 2)) { FRESH(); hg::phase_scan(F); SEAM(pb + 2); }
        if (IN(pb + 3)) { FRESH(); hg::phase_pass3(F, A, l); att::attn_phase<1>(F, A, l); SEAM(pb + 3); }
        if (IN(pb + 4)) { FRESH();
            pg8::DenseOrder S{(const char*)WSP(bf16, WS_R1), (const char*)WSP(bf16, WS_WOUT), DM, DM, MTOK / 256, 4, F.G, F.bid};
            pg8::EpiRes E{F.out};
            pg8::gemm_phase<pg8::EpiRes, pg8::DenseOrder, false, true>(F.lds + RING_OFF, DM, DM, DM, S, E);
            SEAM(pb + 4);
        }
        if (IN(pb + 5)) { FRESH(); phase_ln1(F, A, l); SEAM(pb + 5); }
        if (IN(pb + 6)) { FRESH();
            pg8::DenseOrder S{(const char*)WSP(bf16, WS_R1), (const char*)WSP(bf16, WS_WQ), DM, DM, MTOK / 256, 4, F.G, F.bid};
            pg8::EpiBf16 E{WSP(bf16, WS_Q), DM, pg8::C2_MEM};
            pg8::gemm_phase<pg8::EpiBf16, pg8::DenseOrder, false, true>(F.lds + RING_OFF, DM, DM, DM, S, E);
            SEAM(pb + 6);
        }
        if (IN(pb + 7)) { FRESH();
            pg8::XattnOrder S{(const char*)WSP(bf16, WS_Q), (const char*)WSP(bf16, WS_KMEM), 0, F.G, F.bid};
            pg8::EpiSoftmax E{WSP(bf16, WS_PATT), F.lds + XCH_OFF};
            pg8::gemm_phase<pg8::EpiSoftmax, pg8::XattnOrder, false, true>(F.lds + RING_OFF, DM, DM, 256, S, E);
            SEAM(pb + 7);
        }
        if (IN(pb + 8)) { FRESH();
            pg8::XattnOrder S{(const char*)WSP(bf16, WS_PATT), (const char*)WSP(bf16, WS_VT), 1, F.G, F.bid};
            pg8::EpiBf16 E{WSP(bf16, WS_OATT), DM, 1.f};
            pg8::gemm_phase<pg8::EpiBf16, pg8::XattnOrder, false, true>(F.lds + RING_OFF, DM, DM, 256, S, E);
            SEAM(pb + 8);
        }
        if (IN(pb + 9)) { FRESH();
            pg8::DenseOrder S{(const char*)WSP(bf16, WS_OATT), (const char*)WSP(bf16, WS_WO), DM, DM, MTOK / 256, 4, F.G, F.bid};
            pg8::EpiRes E{F.out};
            pg8::gemm_phase<pg8::EpiRes, pg8::DenseOrder, false, true>(F.lds + RING_OFF, DM, DM, DM, S, E);
            SEAM(pb + 9);
        }
        if (IN(pb + 10)) { FRESH(); phase_ln2_route(F, A, l); SEAM(pb + 10); }
        if (IN(pb + 11)) { FRESH();
            moe_tables(F, l);
            pg8::MoeOrder S{(const char*)WSP(bf16, WS_R1), (const char*)WSP(bf16, WS_W13), WSP(int, WS_LIST), (const LAS int*)(F.lds + TAB_OFF), 0, F.G, F.bid};
            pg8::EpiSwiGLU E{WSP(bf16, WS_HID)};
            pg8::gemm_phase<pg8::EpiSwiGLU, pg8::MoeOrder, true, true>(F.lds + RING_OFF, DM, DM, DM, S, E);
            SEAM(pb + 11);
        }
        if (IN(pb + 12)) { FRESH();
            moe_tables(F, l);
            pg8::MoeOrder S{(const char*)WSP(bf16, WS_HID), (const char*)WSP(bf16, WS_W2), WSP(int, WS_LIST), (const LAS int*)(F.lds + TAB_OFF), 1, F.G, F.bid};
            pg8::EpiMoeOut E{WSP(bf16, WS_CB), WSP(float, WS_GATE)};
            pg8::gemm_phase<pg8::EpiMoeOut, pg8::MoeOrder, false, true>(F.lds + RING_OFF, EFF, EFF, EFF, S, E);
            SEAM(pb + 12);
        }
        if (IN(pb + 13)) { FRESH(); phase_ln3(F, A, l); SEAM(pb + 13); }
    }
#undef IN
#undef SEAM
}

extern "C" void kernel_launch(void* const* d_in, const int* in_sizes, int n_in, void* d_out, int out_size, void* d_ws, size_t ws_size, hipStream_t stream) {
    static int grid = 0;
    if (grid == 0) {
        if (n_in != 25 || out_size != MTOK * DM || ws_size < WS_END) { fprintf(stderr, "kernel_launch: unexpected problem (n_in %d, out %d, ws %zu)\n", n_in, out_size, ws_size); grid = -1; return; }
        int dev = 0, cus = 0, per_cu = 0;
        if (hipGetDevice(&dev) != hipSuccess || hipDeviceGetAttribute(&cus, hipDeviceAttributeMultiprocessorCount, dev) != hipSuccess) { grid = -1; return; }
        if (hipFuncSetAttribute((const void*)mk_fwd, hipFuncAttributeMaxDynamicSharedMemorySize, LDS_BYTES) != hipSuccess) { fprintf(stderr, "kernel_launch: hipFuncSetAttribute failed\n"); grid = -1; return; }
        if (hipOccupancyMaxActiveBlocksPerMultiprocessor(&per_cu, (const void*)mk_fwd, NTHR, LDS_BYTES) != hipSuccess || per_cu < 1) fprintf(stderr, "kernel_launch: occupancy query says %d\n", per_cu);
        (void)hipGetLastError();
        grid = cus < 256 ? cus : 256;
    }
    if (grid < 0) return;
    (void)hipMemsetAsync((char*)d_ws + WS_CTL, 0, CTL_ZERO_BYTES, stream);
    Args a{};
    for (int i = 0; i < 25; ++i) a.in[i] = (const float*)d_in[i];
    a.out = (float*)d_out; a.ws = (unsigned char*)d_ws;
#if MK_N_LAUNCHES == 1
    a.ph_lo = 0; a.ph_hi = NPHASE;
    hipLaunchKernelGGL(mk_fwd, dim3(grid), dim3(NTHR), LDS_BYTES, stream, a);
#else
    for (int p = 0; p < NPHASE; ++p) { DEBUG_BEFORE_PHASE(p); a.ph_lo = p; a.ph_hi = p + 1; hipLaunchKernelGGL(mk_fwd, dim3(grid), dim3(NTHR), LDS_BYTES, stream, a);
        DEBUG_AFTER_PHASE(p); }
    DEBUG_FINAL();
#endif
}
```

```cpp
#include <hip/hip_runtime.h>
#include <cstdio>
#include <cstdint>

#define GAS __attribute__((address_space(1)))
#define LAS __attribute__((address_space(3)))
typedef unsigned short bf16;
typedef short bf16x8 __attribute__((ext_vector_type(8)));
typedef short s16x4 __attribute__((ext_vector_type(4)));
typedef float f32x4 __attribute__((ext_vector_type(4)));
typedef float f32x2 __attribute__((ext_vector_type(2)));
typedef float f32x16 __attribute__((ext_vector_type(16)));
typedef unsigned u32x4 __attribute__((ext_vector_type(4)));
typedef unsigned u32x2 __attribute__((ext_vector_type(2)));
typedef GAS unsigned gu32;
#define RLX_AGENT __ATOMIC_RELAXED, __HIP_MEMORY_SCOPE_AGENT
#define LDS_WAIT() asm volatile("s_waitcnt lgkmcnt(0)" ::: "memory")
#define VM_WAIT() asm volatile("s_waitcnt vmcnt(0)" ::: "memory")

constexpr int DM = 1024, NB = 4, SEQ = 8192, MTOK = NB * SEQ;
constexpr int NIN = 3584;
constexpr int INW = 3588;
constexpr int NEXP = 16, EFF = 512;
constexpr float LN_EPS = 1e-5f;
constexpr float ALPHA = 1.4142135623730951f;
constexpr float LOG2E = 1.4426950408889634f;
constexpr int PA_LD = 1536;
constexpr int NWAVES = 8, NTHR = 512;

constexpr size_t MiB = 1u << 20;
constexpr size_t WS_CTL = 0, CTL_ZERO_BYTES = 1 * MiB;
constexpr size_t WS_CUMF = 1 * MiB;
constexpr size_t WS_LF2 = 1 * MiB + 512 * 1024;
constexpr size_t WS_LIST = 2 * MiB;
constexpr size_t WS_GATE = 4 * MiB;
constexpr size_t WS_HDEC = 4 * MiB + 512 * 1024;
constexpr size_t WS_MEMB = 6 * MiB;
constexpr size_t WS_KMEM = 8 * MiB;
constexpr size_t WS_VT = 10 * MiB;
constexpr size_t WS_WIN = 16 * MiB, WS_WOUT = 23 * MiB, WS_WQ = 25 * MiB, WS_WK = 27 * MiB, WS_WV = 29 * MiB, WS_WO = 31 * MiB, WS_W13 = 33 * MiB, WS_W2 = 65 * MiB;
constexpr size_t WS_R1 = 81 * MiB;
constexpr size_t WS_BIG = 145 * MiB;
constexpr size_t WS_PA = WS_BIG, WS_HQ = WS_BIG + 96 * MiB, WS_HI = WS_BIG + 128 * MiB, WS_HG = WS_BIG + 160 * MiB, WS_HF = WS_BIG + 192 * MiB, WS_ST = WS_BIG + 256 * MiB;
constexpr size_t WS_Q = WS_BIG, WS_PATT = WS_BIG + 64 * MiB, WS_OATT = WS_BIG + 128 * MiB;
constexpr size_t WS_HID = WS_BIG, WS_CB = WS_BIG + 68 * MiB;
constexpr size_t WS_END = WS_BIG + 320 * MiB;
static_assert(WS_CB + (size_t)MTOK * 2 * DM * 2 <= WS_END, "ws map");
constexpr int CW_TMO = 0, CW_CODE = 1, CW_BAR = 4096, CW_ECNT = 8192  , CW_DBG = 16384, CW_NRM = 12288  ;

__device__ __forceinline__ unsigned cvt_pk_bf16(float lo, float hi) { typedef __bf16 bf2 __attribute__((ext_vector_type(2))); f32x2 v = {lo, hi}; bf2 b = __builtin_convertvector(v, bf2); return __builtin_bit_cast(unsigned, b); }
__device__ __forceinline__ bf16 f2bf(float f) { return (bf16)(cvt_pk_bf16(f, 0.f) & 0xffffu); }
__device__ __forceinline__ float bf2f(bf16 b) { return __uint_as_float(((unsigned)b) << 16); }
__device__ __forceinline__ float wave_sum(float v) {
#pragma unroll
    for (int o = 1; o < 64; o <<= 1) v += __shfl_xor(v, o);
    return v;
}
__device__ __forceinline__ float fast_exp2(float x) { return __builtin_amdgcn_exp2f(x); }
__device__ __forceinline__ float fast_rcp(float x) { return __builtin_amdgcn_rcpf(x); }
__device__ __forceinline__ float sigmoidf_(float x) { return fast_rcp(1.f + fast_exp2(-x * LOG2E)); }
__device__ __forceinline__ float siluf_(float x) { return x * sigmoidf_(x); }
__device__ __forceinline__ float log_sigmoidf_(float x) { return fminf(x, 0.f) - log1pf(__expf(-fabsf(x))); }
constexpr int NPH_L = 14, NPHASE = 1 + 2 * NPH_L;
namespace pg8 {
constexpr int BM = 256, BK = 64, HALF = 128, HTB = HALF * BK * 2, STAGE_BYTES = 8 * HTB, NXCD = 8, WGM = 8;
__host__ __device__ __forceinline__ int lds_byte(int r, int c) { const int st = (r >> 4) * 2 + (c >> 5), rr = r & 15, cc = c & 31, ob = rr * 64 + cc * 2; return st * 1024 + (ob ^ (((ob >> 9) & 1) << 5)); }
__host__ __device__ __forceinline__ void stage_rc(int b, int& R, int& C) { const int st = b / 1024, sb = b % 1024, swz = sb ^ (((sb >> 9) & 1) << 5); R = (st >> 1) * 16 + swz / 64; C = (st & 1) * 32 + (swz % 64) / 2; }
__host__ __device__ __forceinline__ int perm32(int rho) { const int n = rho >> 4, i = rho & 15; return 8 * (i >> 2) + 4 * n + (i & 3); }

struct Unit { const char* a; const char* b; const int* rl; int pm, pn, nv, e; };

__device__ __forceinline__ void tile_of(int L, int nM, int nN, int& pm, int& pn) {
    const int nwg = nM * nN; int wgid = L; { const int q = nwg / NXCD, r = nwg % NXCD, xcd = wgid % NXCD, off = wgid / NXCD; wgid = (xcd < r ? xcd * (q + 1) : r * (q + 1) + (xcd - r) * q) + off; }
    const int nig = WGM * nN, gid = wgid / nig, fm = gid * WGM, gsz = (nM - fm) < WGM ? (nM - fm) : WGM;
    pm = fm + ((wgid % nig) % gsz); pn = (wgid % nig) / gsz;
}

template <class Epi, class Sched, bool GATHER, bool ALIGN_EPI>
__device__ __forceinline__ void gemm_phase(LAS unsigned char* lds, const int lda, const int ldb, const int K, const Sched& S, const Epi& E, unsigned long long* PT = nullptr) {
#ifdef PROBE_GT
#define PG8_RT(x) do { x = __builtin_amdgcn_s_memrealtime(); asm volatile("s_waitcnt lgkmcnt(0)" ::: "memory"); } while (0)
    unsigned long long ps0_ = 0, ps1_ = 0, ps2_ = 0, ps3_ = 0, pe_ = 0; bool pfirst_ = true;
    PG8_RT(pe_);
#endif
    int tid = threadIdx.x; asm volatile("" : "+v"(tid));
    const int wid = __builtin_amdgcn_readfirstlane(tid >> 6), lane = tid & 63, wr = wid >> 2, wc = wid & 3, fr = lane & 15, fq = lane >> 4;
    const int nt = K / BK;
    unsigned vB[2];
#pragma unroll
    for (int i = 0; i < 2; ++i) { int R, C; stage_rc(tid * 16 + i * 8192, R, C); const int Rb = Epi::PERM ? ((R & ~31) + perm32(R & 31)) : R; vB[i] = (unsigned)(Rb * ldb + C) * 2u; }
    const size_t kstep = (size_t)(BK * 2);
    const size_t hstepB = (size_t)HALF * ldb * 2;
    const unsigned ldsw = (unsigned)wid * 1024u;
    const int aoff = lds_byte(wr * 64 + fr, fq * 8), boff = lds_byte(wc * 32 + fr, fq * 8);
#define PG8_SA(b, h) (((b) * 2 + (h)) * HTB)
#define PG8_SB(b, h) ((4 + (b) * 2 + (h)) * HTB)
#define PG8_STAGE2(bufoff, gbase, v0, v1) do { \
        __builtin_amdgcn_global_load_lds((const unsigned*)((const char*)(gbase) + (v0)), (LAS unsigned*)(lds + (bufoff) + ldsw), 16, 0, 0); \
        __builtin_amdgcn_global_load_lds((const unsigned*)((const char*)(gbase) + (v1)), (LAS unsigned*)(lds + (bufoff) + ldsw + 8192), 16, 0, 0); } while (0)
#define PG8_STAGEB(bufoff, gbase) PG8_STAGE2(bufoff, gbase, vB[0], vB[1])
#define PG8_LDA(dst, b, h) do { _Pragma("unroll") for (int m = 0; m < 4; ++m) _Pragma("unroll") for (int k = 0; k < 2; ++k) dst[m][k] = *(const LAS bf16x8*)(lds + PG8_SA(b, h) + aoff + m * 2048 + k * 1024); } while (0)
#define PG8_LDB(dst, b, h) do { _Pragma("unroll") for (int n = 0; n < 2; ++n) _Pragma("unroll") for (int k = 0; k < 2; ++k) dst[n][k] = *(const LAS bf16x8*)(lds + PG8_SB(b, h) + boff + n * 2048 + k * 1024); } while (0)
#define PG8_MMA(ai, bj, At, Bt) do { __builtin_amdgcn_s_setprio(1); _Pragma("unroll") for (int m = 0; m < 4; ++m) _Pragma("unroll") for (int n = 0; n < 2; ++n) _Pragma("unroll") for (int k = 0; k < 2; ++k) \
        acc[ai][bj][m][n] = __builtin_amdgcn_mfma_f32_16x16x32_bf16(Bt[n][k], At[m][k], acc[ai][bj][m][n], 0, 0, 0); __builtin_amdgcn_s_setprio(0); } while (0)
#define PG8_WAIT_V(n) asm volatile("s_waitcnt vmcnt(" #n ")" ::: "memory")
#define PG8_WAIT_L(n) asm volatile("s_waitcnt lgkmcnt(" #n ")" ::: "memory")
#define PG8_BAR __builtin_amdgcn_s_barrier()
#define PG8_SCHED __builtin_amdgcn_sched_barrier(0)
    Unit cur, nxt; int ui = 0;
    if (!S.next(0, cur)) return;
    unsigned vA[2][2], nvA[2][2];
#define PG8_AOFFS(dst, u) do { int t2_ = tid; if constexpr (GATHER) asm volatile("" : "+v"(t2_)); _Pragma("unroll") for (int i_ = 0; i_ < 2; ++i_) { int R_, C_; stage_rc(t2_ * 16 + i_ * 8192, R_, C_); \
        _Pragma("unroll") for (int h_ = 0; h_ < 2; ++h_) { \
        if constexpr (GATHER) { int rr_ = h_ * HALF + R_; rr_ = rr_ < (u).nv ? rr_ : (u).nv - 1; const int tok_ = (u).rl[rr_] >> 1; dst[h_][i_] = (unsigned)(tok_ * lda + C_) * 2u; } \
        else dst[h_][i_] = (unsigned)((h_ * HALF + R_) * lda + C_) * 2u; } } } while (0)
    PG8_AOFFS(vA, cur);
    f32x4 acc[2][2][4][2];
#pragma unroll
    for (int a = 0; a < 2; ++a)
#pragma unroll
        for (int b = 0; b < 2; ++b)
#pragma unroll
            for (int m = 0; m < 4; ++m)
#pragma unroll
                for (int n = 0; n < 2; ++n) acc[a][b][m][n] = (f32x4){0.f, 0.f, 0.f, 0.f};
    bf16x8 At[4][2], B0[2][2], B1[2][2];
    const char* cA = cur.a; const char* cB = cur.b;
    PG8_STAGEB(PG8_SB(0, 0), cB); PG8_STAGEB(PG8_SB(0, 1), cB + hstepB); PG8_STAGE2(PG8_SA(0, 0), cA, vA[0][0], vA[0][1]); PG8_STAGE2(PG8_SA(0, 1), cA, vA[1][0], vA[1][1]);
    if (wr == 1) PG8_BAR;
    PG8_WAIT_V(2); PG8_BAR;
    PG8_STAGEB(PG8_SB(1, 0), cB + kstep); PG8_STAGE2(PG8_SA(1, 0), cA + kstep, vA[0][0], vA[0][1]); PG8_STAGEB(PG8_SB(1, 1), cB + hstepB + kstep);
    PG8_WAIT_V(6); PG8_BAR;
    for (;;) {
        const bool has_next = S.next(ui + 1, nxt);
        const char* nA = has_next ? nxt.a : cA; const char* nB = has_next ? nxt.b : cB;
        if constexpr (GATHER) { if (has_next) { PG8_AOFFS(nvA, nxt); } else {
#pragma unroll
            for (int h_ = 0; h_ < 2; ++h_)
#pragma unroll
                for (int i_ = 0; i_ < 2; ++i_) nvA[h_][i_] = vA[h_][i_]; } }
#ifdef PROBE_GT
        PG8_RT(ps0_);
        if (pfirst_ && PT) { PT[3] += ps0_ - pe_; pfirst_ = false; }
#endif
#pragma nounroll
        for (int t = 0; t < nt; t += 2) {
            const bool last = (t == nt - 2);
            const char* a1 = cA + (size_t)(t + 1) * kstep;
            const char* a2 = last ? nA : cA + (size_t)(t + 2) * kstep; const char* b2 = last ? nB : cB + (size_t)(t + 2) * kstep;
            const char* a3 = a2 + kstep; const char* b3 = b2 + kstep;
            unsigned x00, x01, x10, x11;
            if constexpr (GATHER) { x00 = last ? nvA[0][0] : vA[0][0]; x01 = last ? nvA[0][1] : vA[0][1]; x10 = last ? nvA[1][0] : vA[1][0]; x11 = last ? nvA[1][1] : vA[1][1]; }
            else { x00 = vA[0][0]; x01 = vA[0][1]; x10 = vA[1][0]; x11 = vA[1][1]; }
            PG8_LDB(B0, 0, 0); PG8_LDB(B1, 0, 1); PG8_SCHED; PG8_LDA(At, 0, 0); PG8_STAGE2(PG8_SA(1, 1), a1, vA[1][0], vA[1][1]);
            PG8_WAIT_V(8); PG8_WAIT_L(0); PG8_BAR; PG8_MMA(0, 0, At, B0); PG8_MMA(0, 1, At, B1); PG8_BAR; PG8_SCHED;
            PG8_LDA(At, 0, 1); PG8_STAGEB(PG8_SB(0, 0), b2); PG8_STAGEB(PG8_SB(0, 1), b2 + hstepB); PG8_STAGE2(PG8_SA(0, 0), a2, x00, x01);
            PG8_WAIT_V(8); PG8_WAIT_L(0); PG8_BAR; PG8_MMA(1, 0, At, B0); PG8_MMA(1, 1, At, B1); PG8_BAR; PG8_SCHED;
            PG8_LDB(B0, 1, 0); PG8_LDB(B1, 1, 1); PG8_SCHED; PG8_LDA(At, 1, 0); PG8_STAGE2(PG8_SA(0, 1), a2, x10, x11);
            PG8_WAIT_V(8); PG8_WAIT_L(0); PG8_BAR; PG8_MMA(0, 0, At, B0); PG8_MMA(0, 1, At, B1); PG8_BAR; PG8_SCHED;
            PG8_LDA(At, 1, 1); PG8_STAGEB(PG8_SB(1, 0), b3); PG8_STAGEB(PG8_SB(1, 1), b3 + hstepB); PG8_STAGE2(PG8_SA(1, 0), a3, x00, x01);
            PG8_WAIT_V(8); PG8_WAIT_L(0); PG8_BAR; PG8_MMA(1, 0, At, B0); PG8_MMA(1, 1, At, B1); PG8_BAR; PG8_SCHED;
        }
#ifdef PROBE_GT
        PG8_RT(ps1_);
#endif
        if constexpr (ALIGN_EPI) { if (wr == 0) PG8_BAR; }
        if constexpr (!Epi::AFTER_DRAIN) { int fr_ = fr, fq_ = fq; asm volatile("" : "+v"(fr_), "+v"(fq_)); E(acc, cur, wr, wc, fr_, fq_); }
#ifdef PROBE_GT
        PG8_RT(ps2_);
        if (PROBE_GT == 3 && PT) { asm volatile("s_waitcnt vmcnt(0)" ::: "memory"); PG8_RT(ps3_); }
        if (PT) { PT[0] += ps1_ - ps0_; PT[1] += ps2_ - ps1_; if (PROBE_GT == 3) PT[2] += ps3_ - ps2_; }
#endif
        if (!has_next) break;
#pragma unroll
        for (int a = 0; a < 2; ++a)
#pragma unroll
            for (int b = 0; b < 2; ++b)
#pragma unroll
                for (int m = 0; m < 4; ++m)
#pragma unroll
                    for (int n = 0; n < 2; ++n) acc[a][b][m][n] = (f32x4){0.f, 0.f, 0.f, 0.f};
        cur = nxt; cA = nA; cB = nB; ++ui;
        if constexpr (GATHER) {
#pragma unroll
            for (int h_ = 0; h_ < 2; ++h_)
#pragma unroll
                for (int i_ = 0; i_ < 2; ++i_) vA[h_][i_] = nvA[h_][i_]; }
        if constexpr (ALIGN_EPI) { if (wr == 1) PG8_BAR; }
    }
    PG8_WAIT_V(0);
    if constexpr (!ALIGN_EPI) { if (wr == 0) PG8_BAR; }
    PG8_BAR;
    if constexpr (Epi::AFTER_DRAIN) { E.fused(acc, cur, wr, wc, fr, fq, lds, wid, lane); }
#ifdef PROBE_GT
    PG8_RT(ps3_); if (PT) PT[4] += ps3_ - ps2_;
#endif
#undef PG8_AOFFS
#undef PG8_SA
#undef PG8_SB
#undef PG8_STAGE2
#undef PG8_STAGEB
#undef PG8_LDA
#undef PG8_LDB
#undef PG8_MMA
#undef PG8_WAIT_V
#undef PG8_WAIT_L
#undef PG8_BAR
#undef PG8_SCHED
}
}
constexpr int RING_OFF = 0, RING_BYTES = 131072;
constexpr int XCH_OFF = RING_BYTES;
constexpr int TAB_OFF = XCH_OFF + 8192;
constexpr int MISC_OFF = TAB_OFF + 512;
constexpr int LDS_BYTES = 147456;
static_assert(MISC_OFF + 128 <= LDS_BYTES, "LDS map");

#ifdef NT_STORES
#define ST_U4(p, v) __builtin_nontemporal_store((v), (u32x4*)(p))
#define ST_F4(p, v) __builtin_nontemporal_store((v), (f32x4*)(p))
#else
#define ST_U4(p, v) (*(u32x4*)(p) = (v))
#define ST_F4(p, v) (*(f32x4*)(p) = (v))
#endif
namespace pg8 {
template <int ACT>
__device__ __forceinline__ void tile_store_bf16(const f32x4 (&acc)[2][2][4][2], bf16* dst, int ld, float sc, int wr, int wc, int fr, int fq) {
    bf16* p0 = dst + (size_t)(wr * 64 + fr) * ld + wc * 32 + 8 * fq;
#pragma unroll
    for (int ai = 0; ai < 2; ++ai)
#pragma unroll
        for (int m = 0; m < 4; ++m) { bf16* rowp = p0 + (size_t)(ai * HALF + m * 16) * ld;
#pragma unroll
            for (int bj = 0; bj < 2; ++bj) { f32x4 v0 = acc[ai][bj][m][0], v1 = acc[ai][bj][m][1];
                if (ACT == 1) {
#pragma unroll
                    for (int i = 0; i < 4; ++i) { v0[i] = siluf_(v0[i]); v1[i] = siluf_(v1[i]); } }
                v0 = v0 * sc; v1 = v1 * sc; u32x4 w; w.x = cvt_pk_bf16(v0[0], v0[1]); w.y = cvt_pk_bf16(v0[2], v0[3]); w.z = cvt_pk_bf16(v1[0], v1[1]); w.w = cvt_pk_bf16(v1[2], v1[3]);
                ST_U4(rowp + bj * HALF, w); } }
}
__device__ __forceinline__ void tile_store_f32(const f32x4 (&acc)[2][2][4][2], float* dst, int ld, int wr, int wc, int fr, int fq) {
    float* p0 = dst + (size_t)(wr * 64 + fr) * ld + wc * 32 + 8 * fq;
#pragma unroll
    for (int ai = 0; ai < 2; ++ai)
#pragma unroll
        for (int m = 0; m < 4; ++m) { float* rowp = p0 + (size_t)(ai * HALF + m * 16) * ld;
#pragma unroll
            for (int bj = 0; bj < 2; ++bj) { ST_F4(rowp + bj * HALF, acc[ai][bj][m][0]); ST_F4(rowp + bj * HALF + 4, acc[ai][bj][m][1]); } }
}

constexpr float C2_FOX = 0.125f * LOG2E, C2_DIFF = 0.17677669529663687f * LOG2E, C2_MEM = 0.0625f * LOG2E;

struct EpiProj {
    static constexpr bool PERM = true, AFTER_DRAIN = false;
    bf16 *PA, *HQ, *HI, *HG, *KMEM, *VT; float* HF; unsigned* NRM;
    __device__ __forceinline__ void operator()(f32x4 (&acc)[2][2][4][2], const Unit& u, int wr, int wc, int fr, int fq) const {
        const size_t row0 = (size_t)u.pm * BM; const int pn = u.pn;
        if (u.e == 0) {
            if (pn < 6) { const float sc = pn == 0 ? C2_FOX : (pn == 3 ? C2_DIFF : 1.f); tile_store_bf16<0>(acc, PA + row0 * PA_LD + pn * 256, PA_LD, sc, wr, wc, fr, fq);
                if (pn != 2 && pn != 5) {
#pragma unroll
                    for (int bj = 0; bj < 2; ++bj) { float mx = 0.f;
#pragma unroll
                        for (int ai = 0; ai < 2; ++ai)
#pragma unroll
                            for (int m = 0; m < 4; ++m) { const f32x4 a = acc[ai][bj][m][0] * sc, b = acc[ai][bj][m][1] * sc; float ss = (a[0] * a[0] + a[1] * a[1]) + (a[2] * a[2] + a[3] * a[3]) + (b[0] * b[0] + b[1] * b[1]) + (b[2] * b[2] + b[3] * b[3]);
                                ss += __shfl_xor(ss, 16); ss += __shfl_xor(ss, 32); mx = fmaxf(mx, ss); }
#pragma unroll
                        for (int o = 1; o < 16; o <<= 1) mx = fmaxf(mx, __shfl_xor(mx, o));
                        if (fr == 0 && fq == 0) { const int bh = (u.pm / (SEQ / 256)) * 4 + 2 * bj + (wc >> 1); atomicMax(NRM + (((pn < 2 ? pn : pn - 1) * 16 + bh) * 2 + (wc & 1)), __float_as_uint(mx)); } } } }
            else if (pn < 8) tile_store_bf16<1>(acc, HQ + row0 * 512 + (pn - 6) * 256, 512, 1.f, wr, wc, fr, fq);
            else if (pn < 10) tile_store_f32(acc, HF + row0 * 512 + (pn - 8) * 256, 512, wr, wc, fr, fq);
            else if (pn < 12) tile_store_bf16<0>(acc, HI + row0 * 512 + (pn - 10) * 256, 512, 1.f, wr, wc, fr, fq);
            else tile_store_bf16<1>(acc, HG + row0 * 512 + (pn - 12) * 256, 512, 1.f, wr, wc, fr, fq);
        } else if (u.e == 1) tile_store_bf16<0>(acc, KMEM + row0 * 1024 + pn * 256, 1024, 1.f, wr, wc, fr, fq);
        else tile_store_bf16<0>(acc, VT + row0 * 1024 + pn * 256, 1024, 1.f, wr, wc, fr, fq);
    }
};
struct EpiNull {
    static constexpr bool PERM = true, AFTER_DRAIN = false;
    float* sink;
    __device__ __forceinline__ void operator()(f32x4 (&acc)[2][2][4][2], const Unit& u, int wr, int wc, int fr, int fq) const {
        f32x4 s = {0.f, 0.f, 0.f, 0.f};
#pragma unroll
        for (int ai = 0; ai < 2; ++ai)
#pragma unroll
            for (int bj = 0; bj < 2; ++bj)
#pragma unroll
                for (int m = 0; m < 4; ++m) { s += acc[ai][bj][m][0]; s += acc[ai][bj][m][1]; }
        if ((s[0] + s[1]) + (s[2] + s[3]) == 1234567.125f) sink[fr] = s[0];
    }
};
template <int AIS> struct EpiPart {
    static constexpr bool PERM = true, AFTER_DRAIN = false;
    bf16* O;
    __device__ __forceinline__ void operator()(f32x4 (&acc)[2][2][4][2], const Unit& u, int wr, int wc, int fr, int fq) const {
        bf16* p0 = O + ((size_t)u.pm * BM + wr * 64 + fr) * NIN + u.pn * BM + wc * 32 + 8 * fq;
#pragma unroll
        for (int ai = 0; ai < AIS; ++ai)
#pragma unroll
            for (int m = 0; m < 4; ++m) { bf16* rowp = p0 + (size_t)(ai * HALF + m * 16) * NIN;
#pragma unroll
                for (int bj = 0; bj < 2; ++bj) { const f32x4 v0 = acc[ai][bj][m][0], v1 = acc[ai][bj][m][1]; u32x4 w; w.x = cvt_pk_bf16(v0[0], v0[1]); w.y = cvt_pk_bf16(v0[2], v0[3]); w.z = cvt_pk_bf16(v1[0], v1[1]); w.w = cvt_pk_bf16(v1[2], v1[3]);
                    ST_U4(rowp + bj * HALF, w); } }
        if (AIS < 2) { f32x4 s = {0.f, 0.f, 0.f, 0.f};
#pragma unroll
            for (int bj = 0; bj < 2; ++bj)
#pragma unroll
                for (int m = 0; m < 4; ++m) { s += acc[1][bj][m][0]; s += acc[1][bj][m][1]; }
            if ((s[0] + s[1]) + (s[2] + s[3]) == 1234567.125f) O[fr] = 0; }
    }
};
struct EpiBf16 {
    static constexpr bool PERM = true, AFTER_DRAIN = false;
    bf16* O; int ld; float sc;
    __device__ __forceinline__ void operator()(f32x4 (&acc)[2][2][4][2], const Unit& u, int wr, int wc, int fr, int fq) const {
        tile_store_bf16<0>(acc, O + (size_t)u.pm * BM * ld + u.pn * BM, ld, sc, wr, wc, fr, fq);
    }
};
struct EpiRes {
    static constexpr bool PERM = true, AFTER_DRAIN = false;
    const bf16* H; bf16* PRE;
    __device__ __forceinline__ void operator()(f32x4 (&acc)[2][2][4][2], const Unit& u, int wr, int wc, int fr, int fq) const {
        const size_t o0 = ((size_t)u.pm * BM + wr * 64 + fr) * DM + u.pn * BM + wc * 32 + 8 * fq;
        u32x4 hv[2][4][2];
#pragma unroll
        for (int ai = 0; ai < 2; ++ai)
#pragma unroll
            for (int m = 0; m < 4; ++m)
#pragma unroll
                for (int bj = 0; bj < 2; ++bj) hv[ai][m][bj] = *(const u32x4*)(H + o0 + (size_t)(ai * HALF + m * 16) * DM + bj * HALF);
        __builtin_amdgcn_sched_barrier(0);
#pragma unroll
        for (int ai = 0; ai < 2; ++ai)
#pragma unroll
            for (int m = 0; m < 4; ++m) { const size_t o1 = o0 + (size_t)(ai * HALF + m * 16) * DM;
#pragma unroll
                for (int bj = 0; bj < 2; ++bj) { const u32x4 h4 = hv[ai][m][bj]; const f32x4 a = acc[ai][bj][m][0], b = acc[ai][bj][m][1]; u32x4 w;
                    w.x = cvt_pk_bf16(__uint_as_float(h4.x << 16) * ALPHA + a[0], __uint_as_float(h4.x & 0xffff0000u) * ALPHA + a[1]); w.y = cvt_pk_bf16(__uint_as_float(h4.y << 16) * ALPHA + a[2], __uint_as_float(h4.y & 0xffff0000u) * ALPHA + a[3]);
                    w.z = cvt_pk_bf16(__uint_as_float(h4.z << 16) * ALPHA + b[0], __uint_as_float(h4.z & 0xffff0000u) * ALPHA + b[1]); w.w = cvt_pk_bf16(__uint_as_float(h4.w << 16) * ALPHA + b[2], __uint_as_float(h4.w & 0xffff0000u) * ALPHA + b[3]);
                    ST_U4(PRE + o1 + bj * HALF, w); } }
    }
};
struct EpiSoftmax {
    static constexpr bool PERM = true, AFTER_DRAIN = false;
    bf16* P; LAS unsigned char* xch;
    __device__ __forceinline__ void operator()(f32x4 (&acc)[2][2][4][2], const Unit& u, int wr, int wc, int fr, int fq) const {
        LAS float* X1 = (LAS float*)xch; LAS float* X2 = X1 + 1024;
        float mx[2][4];
#pragma unroll
        for (int ai = 0; ai < 2; ++ai)
#pragma unroll
            for (int m = 0; m < 4; ++m) { float v = -INFINITY;
#pragma unroll
                for (int bj = 0; bj < 2; ++bj)
#pragma unroll
                    for (int n = 0; n < 2; ++n) { const f32x4 x = acc[ai][bj][m][n]; v = fmaxf(v, fmaxf(fmaxf(x[0], x[1]), fmaxf(x[2], x[3]))); }
                v = fmaxf(v, __shfl_xor(v, 16)); v = fmaxf(v, __shfl_xor(v, 32)); mx[ai][m] = v;
                if (fq == 0) X1[(ai * HALF + wr * 64 + m * 16 + fr) * 4 + wc] = v; }
        asm volatile("s_waitcnt lgkmcnt(0)" ::: "memory"); __builtin_amdgcn_s_barrier(); asm volatile("" ::: "memory");
        float sm[2][4];
#pragma unroll
        for (int ai = 0; ai < 2; ++ai)
#pragma unroll
            for (int m = 0; m < 4; ++m) { const f32x4 q = *(const LAS f32x4*)(X1 + (ai * HALF + wr * 64 + m * 16 + fr) * 4); const float M_ = fmaxf(fmaxf(q[0], q[1]), fmaxf(q[2], q[3])); float s = 0.f;
#pragma unroll
                for (int bj = 0; bj < 2; ++bj)
#pragma unroll
                    for (int n = 0; n < 2; ++n) { f32x4 x = acc[ai][bj][m][n];
#pragma unroll
                        for (int i = 0; i < 4; ++i) { x[i] = fast_exp2(x[i] - M_); s += x[i]; } acc[ai][bj][m][n] = x; }
                s += __shfl_xor(s, 16); s += __shfl_xor(s, 32); sm[ai][m] = s;
                if (fq == 0) X2[(ai * HALF + wr * 64 + m * 16 + fr) * 4 + wc] = s; }
        asm volatile("s_waitcnt lgkmcnt(0)" ::: "memory"); __builtin_amdgcn_s_barrier(); asm volatile("" ::: "memory");
        bf16* p0 = P + ((size_t)u.pm * BM + wr * 64 + fr) * DM + u.pn * BM + wc * 32 + 8 * fq;
#pragma unroll
        for (int ai = 0; ai < 2; ++ai)
#pragma unroll
            for (int m = 0; m < 4; ++m) { const f32x4 q = *(const LAS f32x4*)(X2 + (ai * HALF + wr * 64 + m * 16 + fr) * 4); const float inv = fast_rcp((q[0] + q[1]) + (q[2] + q[3]));
                bf16* rowp = p0 + (size_t)(ai * HALF + m * 16) * DM;
#pragma unroll
                for (int bj = 0; bj < 2; ++bj) { const f32x4 v0 = acc[ai][bj][m][0] * inv, v1 = acc[ai][bj][m][1] * inv; u32x4 w; w.x = cvt_pk_bf16(v0[0], v0[1]); w.y = cvt_pk_bf16(v0[2], v0[3]); w.z = cvt_pk_bf16(v1[0], v1[1]); w.w = cvt_pk_bf16(v1[2], v1[3]);
                    ST_U4(rowp + bj * HALF, w); } }
        (void)mx; (void)sm;
    }
};
struct EpiSwiGLU {
    static constexpr bool PERM = true, AFTER_DRAIN = false;
    bf16* HID;
    __device__ __forceinline__ void operator()(f32x4 (&acc)[2][2][4][2], const Unit& u, int wr, int wc, int fr, int fq) const {
        bf16* p0 = HID + ((size_t)u.pm * BM + wr * 64 + fr) * EFF + u.pn * 128 + wc * 32 + 8 * fq;
#pragma unroll
        for (int ai = 0; ai < 2; ++ai)
#pragma unroll
            for (int m = 0; m < 4; ++m) { f32x4 v0 = acc[ai][0][m][0], v1 = acc[ai][0][m][1]; const f32x4 g0 = acc[ai][1][m][0], g1 = acc[ai][1][m][1];
#pragma unroll
                for (int i = 0; i < 4; ++i) { v0[i] = siluf_(v0[i]) * g0[i]; v1[i] = siluf_(v1[i]) * g1[i]; }
                u32x4 w; w.x = cvt_pk_bf16(v0[0], v0[1]); w.y = cvt_pk_bf16(v0[2], v0[3]); w.z = cvt_pk_bf16(v1[0], v1[1]); w.w = cvt_pk_bf16(v1[2], v1[3]);
                ST_U4(p0 + (size_t)(ai * HALF + m * 16) * EFF, w); }
    }
};
struct EpiMoeOut {
    static constexpr bool PERM = true, AFTER_DRAIN = false;
    bf16* CB; const float* GATE;
    __device__ __forceinline__ void operator()(f32x4 (&acc)[2][2][4][2], const Unit& u, int wr, int wc, int fr, int fq) const {
        const int colb = u.pn * BM + wc * 32 + 8 * fq;
        int dst[2][4]; float gt[2][4];
#pragma unroll
        for (int ai = 0; ai < 2; ++ai)
#pragma unroll
            for (int m = 0; m < 4; ++m) { const int r = ai * HALF + wr * 64 + m * 16 + fr; dst[ai][m] = u.rl[r < u.nv ? r : u.nv - 1]; }
#pragma unroll
        for (int ai = 0; ai < 2; ++ai)
#pragma unroll
            for (int m = 0; m < 4; ++m) gt[ai][m] = GATE[dst[ai][m]];
        __builtin_amdgcn_sched_barrier(0);
#pragma unroll
        for (int ai = 0; ai < 2; ++ai)
#pragma unroll
            for (int m = 0; m < 4; ++m) { const int r = ai * HALF + wr * 64 + m * 16 + fr;
                if (r < u.nv) { const float g = gt[ai][m]; bf16* rowp = CB + (size_t)dst[ai][m] * DM + colb;
#pragma unroll
                    for (int bj = 0; bj < 2; ++bj) { const f32x4 v0 = acc[ai][bj][m][0] * g, v1 = acc[ai][bj][m][1] * g; u32x4 w; w.x = cvt_pk_bf16(v0[0], v0[1]); w.y = cvt_pk_bf16(v0[2], v0[3]); w.z = cvt_pk_bf16(v1[0], v1[1]); w.w = cvt_pk_bf16(v1[2], v1[3]);
                        ST_U4(rowp + bj * HALF, w); } } }
    }
};

struct DenseOrder {
    const char* A; const char* Bt; int lda, ldb, nM, nN, G, c;
    __device__ __forceinline__ bool next(int i, Unit& u) const {
        const int L = i * G + c; if (L >= nM * nN) return false;
        tile_of(L, nM, nN, u.pm, u.pn); u.a = A + (size_t)u.pm * BM * lda * 2; u.b = Bt + (size_t)u.pn * BM * ldb * 2; u.rl = nullptr; u.nv = 256; u.e = 0; return true;
    }
};
struct ProjOrder {
    const char* HB; const char* WIN; int G, c;
    __device__ __forceinline__ bool next(int i, Unit& u) const {
        const int L = i * G + c; constexpr int NP = (MTOK / 256) * (NIN / 256);
        if (L >= NP) return false;
        u.rl = nullptr; u.nv = 256; tile_of(L, MTOK / 256, NIN / 256, u.pm, u.pn); u.a = HB + (size_t)u.pm * BM * DM * 2; u.b = WIN + (size_t)u.pn * BM * DM * 2; u.e = 0;
        return true;
    }
};
struct MemKVOrder {
    const char* MEMB; const char* WK; const char* WV; int c;
    __device__ __forceinline__ bool next(int i, Unit& u) const {
        if (i > 0 || c >= 32) return false;
        const int j = c; u.rl = nullptr; u.nv = 256; u.pm = (j & 15) >> 2; u.pn = j & 3;
        if (j < 16) { u.a = MEMB + (size_t)u.pm * BM * DM * 2; u.b = WK + (size_t)u.pn * BM * DM * 2; u.e = 1; }
        else { u.a = WV + (size_t)u.pm * BM * DM * 2; u.b = MEMB + (size_t)u.pn * BM * DM * 2; u.e = 2; }
        return true;
    }
};
struct XattnOrder {
    const char* A; const char* B; int mode, G, c;
    __device__ __forceinline__ bool next(int i, Unit& u) const {
        const int L = i * G + c; if (L >= (MTOK / 256) * 4) return false;
        tile_of(L, MTOK / 256, 4, u.pm, u.pn); const int bt = u.pm / (SEQ / 256);
        u.a = A + ((size_t)u.pm * BM * DM + u.pn * 256) * 2;
        u.b = mode == 0 ? B + ((size_t)bt * 256 * DM + u.pn * 256) * 2 : B + ((size_t)u.pn * 256 * DM + bt * 256) * 2;
        u.rl = nullptr; u.nv = 256; u.e = 0; return true;
    }
};
struct MoeOrder {
    const char* A; const char* W; const int* LIST; const LAS int* T; int mode  , G, c;
    __device__ __forceinline__ bool next(int i, Unit& u) const {
        const int L = i * G + c; const int ntile = T[16]; if (L >= ntile * 4) return false;
        const int mt = L >> 2; u.pn = L & 3; int e = 0;
#pragma unroll
        for (int j = 1; j < 16; ++j) e += (T[j] <= mt) ? 1 : 0;
        const int r0 = (mt - T[e]) * 256, ne = T[32 + e];
        u.e = e; u.pm = mt; u.nv = (ne - r0) < 256 ? (ne - r0) : 256; u.rl = LIST + (size_t)e * MTOK + r0;
        if (mode == 0) { u.a = A; u.b = W + ((size_t)e * 1024 + u.pn * 256) * DM * 2; }
        else { u.a = A + (size_t)mt * BM * EFF * 2; u.b = W + ((size_t)e * 1024 + u.pn * 256) * EFF * 2; }
        return true;
    }
};
}
#define XB_TMO      128
#define XB_XCNT(j)  (256  + 64 * (j))
#define XB_XSUB(j)  (1280 + 64 * (j))
#define XB_XGEN(j)  (2304 + 64 * (j))
#define XB_TOP      3328
#define XB_TOPGEN   3392
#define XCD_BAR_WORDS 3456
#define XB_SPIN_CAP (1u << 18)
__device__ __forceinline__ unsigned xb_ld(unsigned* p)              { return __hip_atomic_load(p, __ATOMIC_RELAXED, __HIP_MEMORY_SCOPE_AGENT); }
__device__ __forceinline__ unsigned xb_add(unsigned* p, unsigned v) { return __hip_atomic_fetch_add(p, v, __ATOMIC_RELAXED, __HIP_MEMORY_SCOPE_AGENT); }
__device__ __forceinline__ unsigned xb_xcc_id() { return (unsigned)__builtin_amdgcn_s_getreg((3 << 11) | 20) & 0xFu; }
#define XB_SPIN(cond, bar) do { unsigned _sp = 0; while (cond) { __builtin_amdgcn_s_sleep(1); \
    if ((++_sp & 255u) == 0u) { if (xb_ld(&(bar)[XB_TMO])) break; if (_sp > XB_SPIN_CAP) { atomicAdd(&(bar)[XB_TMO], 1u); break; } } } } while (0)
struct XcdBarrier { unsigned* bar; unsigned x; volatile LAS unsigned* st; };
__device__ __forceinline__ XcdBarrier xcd_barrier_post(unsigned* bar, volatile LAS unsigned* st) {
    XcdBarrier b; b.bar = bar; b.x = xb_xcc_id(); b.st = st;
    if (threadIdx.x == 0) (void)xb_add(&bar[XB_XCNT(b.x)], 1u);
    return b;
}
__device__ __forceinline__ void xcd_barrier_complete(unsigned* bar, unsigned x, unsigned& nloc, unsigned& nx) {
    const unsigned G = gridDim.x * gridDim.y * gridDim.z;
    unsigned sum, cnt, mine, sp = 0u;
    for (;;) {
        sum = 0u; cnt = 0u; mine = 0u;
#pragma unroll
        for (unsigned j = 0; j < 16; ++j) { const unsigned c = xb_ld(&bar[XB_XCNT(j)]); sum += c; cnt += (c > 0u) ? 1u : 0u; mine = (j == x) ? c : mine; }
        if (sum == G) break;
        __builtin_amdgcn_s_sleep(1);
        if ((++sp & 255u) == 0u) { if (xb_ld(&bar[XB_TMO])) break; if (sp > XB_SPIN_CAP) { atomicAdd(&bar[XB_TMO], 1u); break; } }
    }
    nloc = mine > 0u ? mine : 1u; nx = cnt > 0u ? cnt : 1u;
}
__device__ __forceinline__ void xcd_barrier(const XcdBarrier& b) {
    asm volatile("s_waitcnt vmcnt(0)" ::: "memory");
    __syncthreads();
    if (threadIdx.x == 0) {
        unsigned* bar = b.bar;
        __builtin_amdgcn_s_waitcnt(0);
        unsigned nloc = b.st[0], nx = b.st[1];
        if (nloc == 0u) { xcd_barrier_complete(bar, b.x, nloc, nx); b.st[0] = nloc; b.st[1] = nx; }
        const unsigned old = xb_add(&bar[XB_XSUB(b.x)], 1u);
        const unsigned gen = old / nloc;
        if (old + 1u == (gen + 1u) * nloc) {
            __builtin_amdgcn_fence(__ATOMIC_RELEASE, "agent");
            asm volatile("s_waitcnt vmcnt(0)" ::: "memory");
            const unsigned og = xb_add(&bar[XB_TOP], 1u);
            const unsigned tg = og / nx;
            if (og + 1u == (tg + 1u) * nx) xb_add(&bar[XB_TOPGEN], 1u);
            else XB_SPIN(xb_ld(&bar[XB_TOPGEN]) == tg, bar);
            __builtin_amdgcn_fence(__ATOMIC_ACQUIRE, "agent");
            xb_add(&bar[XB_XGEN(b.x)], 1u);
            asm volatile("s_waitcnt vmcnt(0)" ::: "memory");
        } else {
            XB_SPIN(xb_ld(&bar[XB_XGEN(b.x)]) == gen, bar);
            __builtin_amdgcn_fence(__ATOMIC_ACQUIRE, "agent");
            asm volatile("s_waitcnt vmcnt(0)" ::: "memory");
        }
    }
    __syncthreads();
}

struct Args { const GAS float* in[25]; GAS float* out; GAS unsigned char* ws; int ph_lo, ph_hi; };
enum { I_X = 0, I_MEM, I_LNIG, I_LNIB, I_WIN, I_FB, I_LQ1, I_LK1, I_LQ2, I_LK2, I_DNG, I_HLB, I_HNG, I_WOUT, I_WQ, I_WK, I_WV, I_WO, I_RW, I_RB, I_W1, I_W3, I_W2, I_LNG, I_LNB };

#define ARGS_T const __attribute__((address_space(4))) Args
struct Frame {
    LAS unsigned char* lds; GAS unsigned char* ws; gu32* ctl; GAS float* out;
    int tid, lane, wave, G, bid;
};
#define WSP(T, off) ((T*)(F.ws + (off)))
#define AIN(i) ((const float*)A.in[i])

__device__ __forceinline__ void tr_item(const float* W, int ldsrc, int nsrc0, bf16* WT, int ldd, int ndst0, int k0, LAS float* scr, int lane) {
    float t[32];
    const float* src = W + (size_t)(k0 + (lane >> 5)) * ldsrc + nsrc0 + (lane & 31);
#pragma unroll
    for (int i = 0; i < 32; ++i) t[i] = src[(size_t)(2 * i) * ldsrc];
#pragma unroll
    for (int i = 0; i < 32; ++i) scr[(2 * i + (lane >> 5)) * 33 + (lane & 31)] = t[i];
    LDS_WAIT(); asm volatile("" ::: "memory");
    const int c = lane & 7;
#pragma unroll
    for (int j = 0; j < 4; ++j) { const int n = (lane >> 3) + 8 * j; const LAS float* s = scr + (8 * c) * 33 + n;
        u32x4 o; o.x = cvt_pk_bf16(s[0 * 33], s[1 * 33]); o.y = cvt_pk_bf16(s[2 * 33], s[3 * 33]); o.z = cvt_pk_bf16(s[4 * 33], s[5 * 33]); o.w = cvt_pk_bf16(s[6 * 33], s[7 * 33]);
        *(u32x4*)(WT + (size_t)(ndst0 + n) * ldd + k0 + 8 * c) = o; }
    LDS_WAIT(); asm volatile("" ::: "memory");
}
__device__ __forceinline__ void convert_weights(const Frame& F, ARGS_T& A, int l) {
    LAS float* scr = (LAS float*)(F.lds + RING_OFF + F.wave * 16384);
    const int gw = F.bid * NWAVES + F.wave, NGW = F.G * NWAVES;
    constexpr int I_IN = 16 * 112, I_SQ = 16 * 32, I_13 = 16 * 2 * 16 * 16, I_2 = 16 * 8 * 32;
    constexpr int NITEMS = I_IN + 5 * I_SQ + I_13 + I_2;
    for (int it = gw; it < NITEMS; it += NGW) {
        int r = it;
        if (r < I_IN) { const int kb = r / 112, nb = r % 112; const int nd = nb * 32, ns = nd < 768 ? nd : nd + 4;
            tr_item(AIN(I_WIN) + (size_t)l * DM * INW, INW, ns, WSP(bf16, WS_WIN), DM, nd, kb * 64, scr, F.lane); continue; }
        r -= I_IN;
        if (r < 5 * I_SQ) { const int w = r / I_SQ, rr = r % I_SQ, kb = rr / 32, nb = rr % 32;
            const float* src = (w == 0 ? AIN(I_WOUT) : w == 1 ? AIN(I_WQ) : w == 2 ? AIN(I_WK) : w == 3 ? AIN(I_WV) : AIN(I_WO)) + (size_t)l * DM * DM;
            bf16* dst = (bf16*)(F.ws + (w == 0 ? WS_WOUT : w == 1 ? WS_WQ : w == 2 ? WS_WK : w == 3 ? WS_WV : WS_WO));
            tr_item(src, DM, nb * 32, dst, DM, nb * 32, kb * 64, scr, F.lane); continue; }
        r -= 5 * I_SQ;
        if (r < I_13) { const int e = r / 512, rr = r % 512, which = rr / 256, r2 = rr % 256, kb = r2 / 16, nb = r2 % 16;
            const float* src = (which == 0 ? AIN(I_W1) : AIN(I_W3)) + ((size_t)l * NEXP + e) * DM * EFF;
            const int j0 = nb * 32, nd = (j0 / 128) * 256 + which * 128 + (j0 % 128);
            tr_item(src, EFF, j0, WSP(bf16, WS_W13) + (size_t)e * 1024 * DM, DM, nd, kb * 64, scr, F.lane); continue; }
        r -= I_13;
        { const int e = r / 256, rr = r % 256, kb = rr / 32, nb = rr % 32;
            const float* src = AIN(I_W2) + ((size_t)l * NEXP + e) * EFF * DM;
            tr_item(src, DM, nb * 32, WSP(bf16, WS_W2) + (size_t)e * 1024 * EFF, EFF, nb * 32, kb * 64, scr, F.lane); }
    }
}

__device__ __forceinline__ void ln_regs(f32x4 (&v)[4], const float* g, const float* b, int lane) {
    float s = 0.f;
#pragma unroll
    for (int j = 0; j < 4; ++j) s += (v[j].x + v[j].y) + (v[j].z + v[j].w);
    const float mean = wave_sum(s) * (1.f / DM); float s2 = 0.f;
#pragma unroll
    for (int j = 0; j < 4; ++j) { v[j] = v[j] - mean; s2 += (v[j].x * v[j].x + v[j].y * v[j].y) + (v[j].z * v[j].z + v[j].w * v[j].w); }
    const float rstd = 1.f / sqrtf(wave_sum(s2) * (1.f / DM) + LN_EPS);
#pragma unroll
    for (int j = 0; j < 4; ++j) { const f32x4 gg = *(const f32x4*)(g + 4 * lane + 256 * j), bb = *(const f32x4*)(b + 4 * lane + 256 * j); v[j] = v[j] * rstd * gg + bb; }
}
__device__ __forceinline__ void store_row(const f32x4 (&v)[4], float* o32, bf16* o16, int lane) {
#pragma unroll
    for (int j = 0; j < 4; ++j) { if (o32) *(f32x4*)(o32 + 4 * lane + 256 * j) = v[j];
        if (o16) { u32x2 w; w.x = cvt_pk_bf16(v[j].x, v[j].y); w.y = cvt_pk_bf16(v[j].z, v[j].w); *(u32x2*)(o16 + 4 * lane + 256 * j) = w; } }
}
__device__ __forceinline__ void load_row_bf16(f32x4 (&v)[4], const bf16* row, int lane) {
#pragma unroll
    for (int j = 0; j < 4; ++j) { const u32x2 c = *(const u32x2*)(row + 4 * lane + 256 * j); v[j].x = __uint_as_float(c.x << 16); v[j].y = __uint_as_float(c.x & 0xffff0000u); v[j].z = __uint_as_float(c.y << 16); v[j].w = __uint_as_float(c.y & 0xffff0000u); }
}
__device__ __forceinline__ void unpack_row_bf16(f32x4 (&v)[4], const u32x2 (&c)[4]) {
#pragma unroll
    for (int j = 0; j < 4; ++j) { v[j].x = __uint_as_float(c[j].x << 16); v[j].y = __uint_as_float(c[j].x & 0xffff0000u); v[j].z = __uint_as_float(c[j].y << 16); v[j].w = __uint_as_float(c[j].y & 0xffff0000u); }
}
__device__ __forceinline__ void fox_forget(const f32x4 (&v)[4], const LAS float* WF, const float* fb, float* lf2row, int lane) {
    f32x4 a = {0.f, 0.f, 0.f, 0.f};
#pragma unroll
    for (int j = 0; j < 4; ++j)
#pragma unroll
        for (int i = 0; i < 4; ++i) { const f32x4 w = *(const LAS f32x4*)(WF + (4 * lane + 256 * j + i) * 4); a = a + w * v[j][i]; }
#pragma unroll
    for (int c = 0; c < 4; ++c) a[c] = wave_sum(a[c]);
    if (lane == 0) { f32x4 o;
#pragma unroll
        for (int c = 0; c < 4; ++c) o[c] = log_sigmoidf_(a[c] + fb[c]) * LOG2E;
        *(f32x4*)lf2row = o; }
}
__device__ __forceinline__ void load_wf(const Frame& F, ARGS_T& A, int l, LAS float* WF) {
    const float* w = AIN(I_WIN) + (size_t)l * DM * INW + 768;
    for (int k = F.tid; k < DM; k += NTHR) *(LAS f32x4*)(WF + 4 * k) = *(const f32x4*)(w + (size_t)k * INW);
    __syncthreads();
}

__device__ __forceinline__ void phase_prologue(const Frame& F, ARGS_T& A) {
    convert_weights(F, A, 0);
    __syncthreads();
    LAS float* WF = (LAS float*)(F.lds + XCH_OFF - 16384);
    load_wf(F, A, 0, WF);
    const int gw = F.bid * NWAVES + F.wave, NGW = F.G * NWAVES;
    for (int m = gw; m < NB * 256; m += NGW) { f32x4 v[4];
#pragma unroll
        for (int j = 0; j < 4; ++j) v[j] = *(const f32x4*)(AIN(I_MEM) + (size_t)m * DM + 4 * F.lane + 256 * j);
        store_row(v, nullptr, WSP(bf16, WS_MEMB) + (size_t)m * DM, F.lane); }
    f32x4 nx[4];
#pragma unroll
    for (int j = 0; j < 4; ++j) nx[j] = *(const f32x4*)(AIN(I_X) + (size_t)gw * DM + 4 * F.lane + 256 * j);
    for (int m = gw; m < MTOK; m += NGW) { f32x4 v[4];
#pragma unroll
        for (int j = 0; j < 4; ++j) v[j] = nx[j];
        if (m + NGW < MTOK) {
#pragma unroll
            for (int j = 0; j < 4; ++j) nx[j] = *(const f32x4*)(AIN(I_X) + (size_t)(m + NGW) * DM + 4 * F.lane + 256 * j); }
        ln_regs(v, AIN(I_LNIG), AIN(I_LNIB), F.lane);
        store_row(v, nullptr, WSP(bf16, WS_R1) + (size_t)m * DM, F.lane);
        fox_forget(v, WF, AIN(I_FB), WSP(float, WS_LF2) + (size_t)m * 4, F.lane); }
}
#define PREP(F) ((bf16*)(F).out + (size_t)MTOK * DM)
#define YMIXP(F) ((bf16*)(F).out)
#ifndef LN1_WIDE
#define LN1_WIDE 1
#endif
__device__ __forceinline__ void phase_ln1(const Frame& F, ARGS_T& A, int l) {
    const int gw = F.bid * NWAVES + F.wave, NGW = F.G * NWAVES;
    const float* g = AIN(I_LNG) + (size_t)(l * 3 + 0) * DM; const float* b = AIN(I_LNB) + (size_t)(l * 3 + 0) * DM;
#if LN1_WIDE
    u32x4 nx[2], ny[2];
#pragma unroll
    for (int j = 0; j < 2; ++j) { nx[j] = *(const u32x4*)(PREP(F) + (size_t)gw * DM + 8 * F.lane + 512 * j); ny[j] = *(const u32x4*)(PREP(F) + (size_t)(gw + NGW < MTOK ? gw + NGW : gw) * DM + 8 * F.lane + 512 * j); }
    for (int m = gw; m < MTOK; m += NGW) { f32x4 v[4]; u32x4 cu[2];
#pragma unroll
        for (int j = 0; j < 2; ++j) { cu[j] = nx[j]; nx[j] = ny[j]; }
        if (m + 2 * NGW < MTOK) {
#pragma unroll
            for (int j = 0; j < 2; ++j) ny[j] = *(const u32x4*)(PREP(F) + (size_t)(m + 2 * NGW) * DM + 8 * F.lane + 512 * j); }
#pragma unroll
        for (int j = 0; j < 2; ++j) { v[2 * j].x = __uint_as_float(cu[j].x << 16); v[2 * j].y = __uint_as_float(cu[j].x & 0xffff0000u); v[2 * j].z = __uint_as_float(cu[j].y << 16); v[2 * j].w = __uint_as_float(cu[j].y & 0xffff0000u);
            v[2 * j + 1].x = __uint_as_float(cu[j].z << 16); v[2 * j + 1].y = __uint_as_float(cu[j].z & 0xffff0000u); v[2 * j + 1].z = __uint_as_float(cu[j].w << 16); v[2 * j + 1].w = __uint_as_float(cu[j].w & 0xffff0000u); }
        float s = 0.f;
#pragma unroll
        for (int j = 0; j < 4; ++j) s += (v[j].x + v[j].y) + (v[j].z + v[j].w);
        const float mean = wave_sum(s) * (1.f / DM); float s2 = 0.f;
#pragma unroll
        for (int j = 0; j < 4; ++j) { v[j] = v[j] - mean; s2 += (v[j].x * v[j].x + v[j].y * v[j].y) + (v[j].z * v[j].z + v[j].w * v[j].w); }
        const float rstd = 1.f / sqrtf(wave_sum(s2) * (1.f / DM) + LN_EPS);
        bf16* o16 = WSP(bf16, WS_R1) + (size_t)m * DM;
#pragma unroll
        for (int j = 0; j < 2; ++j) { const int c0 = 8 * F.lane + 512 * j;
            const f32x4 g0 = *(const f32x4*)(g + c0), g1 = *(const f32x4*)(g + c0 + 4), b0 = *(const f32x4*)(b + c0), b1 = *(const f32x4*)(b + c0 + 4);
            const f32x4 y0 = v[2 * j] * rstd * g0 + b0, y1 = v[2 * j + 1] * rstd * g1 + b1;
            u32x4 w; w.x = cvt_pk_bf16(y0.x, y0.y); w.y = cvt_pk_bf16(y0.z, y0.w); w.z = cvt_pk_bf16(y1.x, y1.y); w.w = cvt_pk_bf16(y1.z, y1.w);
            *(u32x4*)(o16 + c0) = w; } }
#else
    u32x2 nx[4];
#pragma unroll
    for (int j = 0; j < 4; ++j) nx[j] = *(const u32x2*)(PREP(F) + (size_t)gw * DM + 4 * F.lane + 256 * j);
    for (int m = gw; m < MTOK; m += NGW) { f32x4 v[4]; u32x2 cu[4];
#pragma unroll
        for (int j = 0; j < 4; ++j) cu[j] = nx[j];
        if (m + NGW < MTOK) {
#pragma unroll
            for (int j = 0; j < 4; ++j) nx[j] = *(const u32x2*)(PREP(F) + (size_t)(m + NGW) * DM + 4 * F.lane + 256 * j); }
        unpack_row_bf16(v, cu);
        ln_regs(v, g, b, F.lane);
        store_row(v, nullptr, WSP(bf16, WS_R1) + (size_t)m * DM, F.lane); }
#endif
}
__device__ __forceinline__ void phase_ln3(const Frame& F, ARGS_T& A, int l) {
    LAS float* WF = (LAS float*)(F.lds + XCH_OFF - 16384);
    if (l == 0) { convert_weights(F, A, 1); __syncthreads(); load_wf(F, A, 1, WF); }
    const int gw = F.bid * NWAVES + F.wave, NGW = F.G * NWAVES;
    const float* g = AIN(I_LNG) + (size_t)(l * 3 + 2) * DM; const float* b = AIN(I_LNB) + (size_t)(l * 3 + 2) * DM;
    const bf16* CB = WSP(bf16, WS_CB);
    u32x2 nh[4], n0[4], n1[4];
#pragma unroll
    for (int j = 0; j < 4; ++j) { nh[j] = *(const u32x2*)(WSP(bf16, WS_R1) + (size_t)gw * DM + 4 * F.lane + 256 * j); n0[j] = *(const u32x2*)(CB + (size_t)(2 * gw) * DM + 4 * F.lane + 256 * j); n1[j] = *(const u32x2*)(CB + (size_t)(2 * gw + 1) * DM + 4 * F.lane + 256 * j); }
    for (int m = gw; m < MTOK; m += NGW) { f32x4 v[4]; u32x2 ch[4], cc0[4], cc1[4];
#pragma unroll
        for (int j = 0; j < 4; ++j) { ch[j] = nh[j]; cc0[j] = n0[j]; cc1[j] = n1[j]; }
        if (m + NGW < MTOK) { const size_t mn = (size_t)(m + NGW);
#pragma unroll
            for (int j = 0; j < 4; ++j) { nh[j] = *(const u32x2*)(WSP(bf16, WS_R1) + mn * DM + 4 * F.lane + 256 * j); n0[j] = *(const u32x2*)(CB + 2 * mn * DM + 4 * F.lane + 256 * j); n1[j] = *(const u32x2*)(CB + (2 * mn + 1) * DM + 4 * F.lane + 256 * j); } }
        unpack_row_bf16(v, ch);
#pragma unroll
        for (int j = 0; j < 4; ++j) {
            const u32x2 c0 = cc0[j], c1 = cc1[j];
            v[j].x = v[j].x * ALPHA + (__uint_as_float(c0.x << 16) + __uint_as_float(c1.x << 16)); v[j].y = v[j].y * ALPHA + (__uint_as_float(c0.x & 0xffff0000u) + __uint_as_float(c1.x & 0xffff0000u));
            v[j].z = v[j].z * ALPHA + (__uint_as_float(c0.y << 16) + __uint_as_float(c1.y << 16)); v[j].w = v[j].w * ALPHA + (__uint_as_float(c0.y & 0xffff0000u) + __uint_as_float(c1.y & 0xffff0000u)); }
        ln_regs(v, g, b, F.lane);
        store_row(v, l == 0 ? nullptr : (float*)F.out + (size_t)m * DM, l == 0 ? WSP(bf16, WS_R1) + (size_t)m * DM : nullptr, F.lane);
        if (l == 0) fox_forget(v, WF, AIN(I_FB) + 4, WSP(float, WS_LF2) + (size_t)m * 4, F.lane); }
}
__device__ __forceinline__ void fox_cumsum(const Frame& F) {
    if (F.bid >= 16) return;
    const int b = F.bid >> 2, h = F.bid & 3; const float* src = WSP(float, WS_LF2) + (size_t)b * SEQ * 4 + h; float* dst = WSP(float, WS_CUMF) + (size_t)F.bid * SEQ;
    LAS float* tot = (LAS float*)(F.lds + XCH_OFF);
    float v[16]; float run = 0.f;
#pragma unroll
    for (int i = 0; i < 16; ++i) { run += src[(size_t)(F.tid * 16 + i) * 4]; v[i] = run; }
    float inc = run;
#pragma unroll
    for (int o = 1; o < 64; o <<= 1) { const float t = __shfl_up(inc, o); if (F.lane >= o) inc += t; }
    if (F.lane == 63) tot[F.wave] = inc;
    __syncthreads();
    float base = inc - run;
    for (int w = 0; w < F.wave; ++w) base += tot[w];
#pragma unroll
    for (int i = 0; i < 16; ++i) dst[F.tid * 16 + i] = v[i] + base;
    __syncthreads();
}
#ifndef ROUTE_TT
#define ROUTE_TT 4
#endif
__device__ __forceinline__ void phase_ln2_route(const Frame& F, ARGS_T& A, int l) {
    constexpr int RW_BYTES = DM * 64 + (DM / 4) * 16;
    LAS unsigned char* RWB = F.lds + RING_OFF;
    LAS int* REC = (LAS int*)(F.lds + RING_OFF + RW_BYTES);
    LAS int* CNT = (LAS int*)(F.lds + RING_OFF + RW_BYTES + 2048);
    LAS int* BASE = CNT + 16; LAS int* NREC = CNT + 32;
    LAS float* LG = (LAS float*)(F.lds + RING_OFF + RW_BYTES + 4096) + F.wave * 64;
    for (int c = F.tid; c < DM * 4; c += NTHR) { const int row = c >> 2, q = c & 3; *(LAS f32x4*)(RWB + row * 64 + (row >> 2) * 16 + q * 16) = *(const f32x4*)(AIN(I_RW) + 4 * c); }
    if (F.tid < 16) CNT[F.tid] = 0;
    __syncthreads();
    const int gw = F.bid * NWAVES + F.wave, NGW = F.G * NWAVES;
    const float* g = AIN(I_LNG) + (size_t)(l * 3 + 1) * DM; const float* b = AIN(I_LNB) + (size_t)(l * 3 + 1) * DM;
    float* GATE = WSP(float, WS_GATE);
    constexpr int TT = ROUTE_TT, NR = TT * 16;
    int nrec = 0;
    u32x2 nx[TT][4];
#pragma unroll
    for (int t = 0; t < TT; ++t) { const int mr = gw + t * NGW < MTOK ? gw + t * NGW : MTOK - 1;
#pragma unroll
        for (int j = 0; j < 4; ++j) nx[t][j] = *(const u32x2*)(PREP(F) + (size_t)mr * DM + 4 * F.lane + 256 * j); }
    for (int m0 = gw; m0 < MTOK; m0 += TT * NGW) { f32x4 v[TT][4]; int ln_ = F.lane; asm volatile("" : "+v"(ln_));
#pragma unroll
        for (int t = 0; t < TT; ++t) unpack_row_bf16(v[t], nx[t]);
        if (m0 + TT * NGW < MTOK) {
#pragma unroll
            for (int t = 0; t < TT; ++t) { const int mr = m0 + (TT + t) * NGW < MTOK ? m0 + (TT + t) * NGW : MTOK - 1;
#pragma unroll
                for (int j = 0; j < 4; ++j) nx[t][j] = *(const u32x2*)(PREP(F) + (size_t)mr * DM + 4 * ln_ + 256 * j); } }
#pragma unroll
        for (int t = 0; t < TT; ++t) { ln_regs(v[t], g, b, ln_); if (m0 + t * NGW < MTOK) store_row(v[t], nullptr, WSP(bf16, WS_R1) + (size_t)(m0 + t * NGW) * DM, ln_); }
        f32x2 R2[NR / 2];
#pragma unroll
        for (int k = 0; k < NR / 2; ++k) R2[k] = (f32x2){0.f, 0.f};
#pragma unroll
        for (int j = 0; j < 4; ++j)
#pragma unroll
            for (int i = 0; i < 4; ++i) { const LAS f32x4* wr = (const LAS f32x4*)(RWB + ln_ * 272 + i * 64 + j * 17408); f32x2 wp[8];
#pragma unroll
                for (int q = 0; q < 4; ++q) { const f32x4 w = wr[q]; wp[2 * q] = (f32x2){w[0], w[1]}; wp[2 * q + 1] = (f32x2){w[2], w[3]}; }
#pragma unroll
                for (int t = 0; t < TT; ++t) { const float x = v[t][j][i]; const f32x2 x2 = {x, x};
#pragma unroll
                    for (int c = 0; c < 8; ++c) R2[t * 8 + c] = __builtin_elementwise_fma(wp[c], x2, R2[t * 8 + c]); } }
        float R[NR];
#pragma unroll
        for (int k = 0; k < NR / 2; ++k) { R[2 * k] = R2[k][0]; R[2 * k + 1] = R2[k][1]; }
#pragma unroll
        for (int P = NR / 2; P >= 1; P >>= 1) { const bool up = (ln_ & P) != 0;
#pragma unroll
            for (int k = 0; k < P; ++k) { const float keep = up ? R[k + P] : R[k], send = up ? R[k] : R[k + P]; R[k] = keep + __shfl_xor(send, P); } }
#pragma unroll
        for (int P = NR; P < 64; P <<= 1) R[0] += __shfl_xor(R[0], P);
        LG[ln_] = 1.f / (1.f + __expf(-R[0]));
        float sc[16], bi[16];
#pragma unroll
        for (int q = 0; q < 4; ++q) { const f32x4 sv = *(const LAS f32x4*)(LG + (ln_ & 48) + 4 * q);
#pragma unroll
            for (int i = 0; i < 4; ++i) { sc[q * 4 + i] = sv[i]; bi[q * 4 + i] = sv[i] + AIN(I_RB)[q * 4 + i]; } }
        int gs = 0; float best = -INFINITY;
#pragma unroll
        for (int q = 0; q < 4; ++q) { float m1 = -INFINITY, m2 = -INFINITY;
#pragma unroll
            for (int i = 0; i < 4; ++i) { const float x = bi[q * 4 + i]; if (x > m1) { m2 = m1; m1 = x; } else if (x > m2) m2 = x; }
            const float s = m1 + m2; if (s > best) { best = s; gs = q; } }
        float bq[4], sq[4];
#pragma unroll
        for (int i = 0; i < 4; ++i) { bq[i] = gs == 0 ? bi[i] : gs == 1 ? bi[4 + i] : gs == 2 ? bi[8 + i] : bi[12 + i]; sq[i] = gs == 0 ? sc[i] : gs == 1 ? sc[4 + i] : gs == 2 ? sc[8 + i] : sc[12 + i]; }
        int i0 = 0; float b0 = bq[0];
#pragma unroll
        for (int i = 1; i < 4; ++i) if (bq[i] > b0) { b0 = bq[i]; i0 = i; }
        int i1 = -1; float b1 = -INFINITY;
#pragma unroll
        for (int i = 0; i < 4; ++i) if (i != i0 && bq[i] > b1) { b1 = bq[i]; i1 = i; }
        const float s0 = i0 == 0 ? sq[0] : i0 == 1 ? sq[1] : i0 == 2 ? sq[2] : sq[3];
        const float s1 = i1 == 0 ? sq[0] : i1 == 1 ? sq[1] : i1 == 2 ? sq[2] : sq[3];
        const int e0 = gs * 4 + i0, e1 = gs * 4 + i1;
        const int m = m0 + ((ln_ >> 4) & (TT - 1)) * NGW;
        if ((ln_ & 15) == 0 && ln_ < NR && m < MTOK) { const float inv = 1.f / (s0 + s1); GATE[2 * m] = s0 * inv; GATE[2 * m + 1] = s1 * inv;
            const int r0 = __hip_atomic_fetch_add(&CNT[e0], 1, __ATOMIC_RELAXED, __HIP_MEMORY_SCOPE_WORKGROUP), r1 = __hip_atomic_fetch_add(&CNT[e1], 1, __ATOMIC_RELAXED, __HIP_MEMORY_SCOPE_WORKGROUP);
            LAS int* rec = REC + (F.wave * 16 + nrec + ((ln_ >> 4) & (TT - 1))) * 4; rec[0] = m; rec[1] = e0; rec[2] = e1; rec[3] = r0 | (r1 << 16); }
#pragma unroll
        for (int t = 0; t < TT; ++t) nrec += (m0 + t * NGW < MTOK) ? 1 : 0;
    }
    if (F.lane == 0) NREC[F.wave] = nrec;
    __syncthreads();
    if (F.tid < 16) BASE[F.tid] = (int)__hip_atomic_fetch_add((unsigned*)(F.ctl + CW_ECNT + (l * 16 + F.tid) * 64), (unsigned)CNT[F.tid], RLX_AGENT);
    __syncthreads();
    int* LIST = WSP(int, WS_LIST);
    if (F.tid < 128) { const int w = F.tid >> 4, i = F.tid & 15; const int cnt_w = NREC[w];
        if (i < cnt_w) { const LAS int* rec = REC + F.tid * 4; const int m = rec[0], e0 = rec[1], e1 = rec[2], rr = rec[3];
            LIST[(size_t)e0 * MTOK + BASE[e0] + (rr & 0xffff)] = 2 * m; LIST[(size_t)e1 * MTOK + BASE[e1] + (rr >> 16)] = 2 * m + 1; } }
    __syncthreads();
}
__device__ __forceinline__ void moe_tables(const Frame& F, int l) {
    LAS int* T = (LAS int*)(F.lds + TAB_OFF);
    if (F.tid == 0) { int cum = 0;
        for (int e = 0; e < 16; ++e) { const int n = (int)__hip_atomic_load((unsigned*)(F.ctl + CW_ECNT + (l * 16 + e) * 64), RLX_AGENT); T[e] = cum; T[32 + e] = n; cum += (n + 255) >> 8; }
        T[16] = cum; }
    __syncthreads();
}
#ifndef ATT_STAGGER
#define ATT_STAGGER 0
#endif
#ifndef DIFF_FAST_BOUND
#define DIFF_FAST_BOUND 60.f
#endif
#ifndef DIFF_LAG
#define DIFF_LAG 0
#endif
#ifndef DIFF_IL
#define DIFF_IL 1
#endif
#ifndef FOX_IL
#define FOX_IL 1
#endif
#ifndef USE_FAST_STEP
#define USE_FAST_STEP 0
#endif
#ifndef ONLY_FAST_TEST
#define ONLY_FAST_TEST 0
#endif
namespace att {
template <int V> struct IC { static constexpr int value = V; };
constexpr int SLOTB = 8192;
constexpr int L_K = 0, L_V = 4 * SLOTB, L_KX = 10 * SLOTB, L_WS = L_KX + 4 * 1024, L_END = L_WS + NWAVES * 256, L_OST = 0;
static_assert(L_END <= RING_BYTES, "attention LDS");
constexpr float THR = 10.f;
__device__ __forceinline__ int crow(int r, int hi) { return (r & 3) + 8 * (r >> 2) + 4 * hi; }
__device__ __forceinline__ void glds16(const void* gsrc, unsigned lds_dst) { unsigned keep;
    asm volatile("s_mov_b32 %0, m0\n\ts_mov_b32 m0, %2\n\ts_nop 0\n\tglobal_load_lds_dwordx4 %1, off\n\ts_mov_b32 m0, %0" : "=&s"(keep) : "v"(gsrc), "s"(lds_dst) : "memory"); }
__device__ __forceinline__ void glds16s(const void* sbase, unsigned voff, unsigned lds_dst) { unsigned keep;
    asm volatile("s_mov_b32 %0, m0\n\ts_mov_b32 m0, %3\n\ts_nop 0\n\tglobal_load_lds_dwordx4 %1, %2\n\ts_mov_b32 m0, %0" : "=&s"(keep) : "v"(voff), "s"(sbase), "s"(lds_dst) : "memory"); }
#ifndef ATT_USE_PRIO
#define ATT_USE_PRIO 1
#endif
#define ATT_PRIO(p) do { if (ATT_USE_PRIO) __builtin_amdgcn_s_setprio(p); } while (0)
#define ATT_WAIT_BAR() asm volatile("s_waitcnt vmcnt(0) lgkmcnt(0)\n\ts_barrier" ::: "memory")
typedef short v4i16_t __attribute__((ext_vector_type(4)));
__device__ __forceinline__ s16x4 vtr(const LAS unsigned char* p) { return __builtin_bit_cast(s16x4, __builtin_amdgcn_ds_read_tr16_b64_v4i16((LAS v4i16_t*)p)); }
__device__ __forceinline__ float rowmax32(const f32x16& p0, const f32x16& p1) {
    float a0 = fmaxf(p0[0], p1[0]), a1 = fmaxf(p0[1], p1[1]), a2 = fmaxf(p0[2], p1[2]), a3 = fmaxf(p0[3], p1[3]);
#pragma unroll
    for (int r = 4; r < 16; r += 4) { a0 = fmaxf(a0, fmaxf(p0[r], p1[r])); a1 = fmaxf(a1, fmaxf(p0[r + 1], p1[r + 1])); a2 = fmaxf(a2, fmaxf(p0[r + 2], p1[r + 2])); a3 = fmaxf(a3, fmaxf(p0[r + 3], p1[r + 3])); }
    const float a = fmaxf(fmaxf(a0, a1), fmaxf(a2, a3));
    auto rr = __builtin_amdgcn_permlane32_swap(__float_as_uint(a), __float_as_uint(a), false, false);
    return fmaxf(__uint_as_float(rr[0]), __uint_as_float(rr[1]));
}
__device__ __forceinline__ float half_sum(float a) { auto rr = __builtin_amdgcn_permlane32_swap(__float_as_uint(a), __float_as_uint(a), false, false); return __uint_as_float(rr[0]) + __uint_as_float(rr[1]); }
__device__ __forceinline__ bf16x8 pack8(const f32x16& p, int b) { u32x4 w; w.x = cvt_pk_bf16(p[b], p[b + 1]); w.y = cvt_pk_bf16(p[b + 2], p[b + 3]); w.z = cvt_pk_bf16(p[b + 4], p[b + 5]); w.w = cvt_pk_bf16(p[b + 6], p[b + 7]); return __builtin_bit_cast(bf16x8, w); }
__device__ __forceinline__ bf16x8 make_qx(float m, int hi) {
    const float a = -m; const unsigned h0 = cvt_pk_bf16(a, 0.f) & 0xffffu; const float r1 = a - __uint_as_float(h0 << 16); const unsigned h1 = cvt_pk_bf16(r1, 0.f) & 0xffffu; const float r2 = r1 - __uint_as_float(h1 << 16); const unsigned h2 = cvt_pk_bf16(r2, 0.f) & 0xffffu;
    u32x4 w; w.x = 0x3F803F80u; w.y = h0 | (h1 << 16); w.z = h2; w.w = 0u; if (hi) { w.x = 0u; w.y = 0u; w.z = 0u; } return __builtin_bit_cast(bf16x8, w);
}
__device__ __forceinline__ void softmax_step(f32x16& p0, f32x16& p1, float& m, float& l, f32x16 (&o)[2], bf16x8 (&pa)[4], LAS float* wsf, int r32, int hi, bool first) {
    const float rm = rowmax32(p0, p1);
    if (first || __any(rm > THR)) {
        const float d = first ? rm : fmaxf(rm, 0.f); m += d; const float sc = fast_exp2(-d); l *= sc;
        if (!first) { if (hi == 0) wsf[r32] = sc; LDS_WAIT();
#pragma unroll
            for (int g = 0; g < 4; ++g) { const f32x4 f = *(const LAS f32x4*)(wsf + 4 * hi + 8 * g);
#pragma unroll
                for (int i = 0; i < 4; ++i) { o[0][4 * g + i] *= f[i]; o[1][4 * g + i] *= f[i]; } } }
#pragma unroll
        for (int r = 0; r < 16; ++r) { p0[r] -= d; p1[r] -= d; }
    }
    float s0 = 0.f, s1 = 0.f, s2 = 0.f, s3 = 0.f;
#pragma unroll
    for (int r = 0; r < 16; r += 2) { p0[r] = fast_exp2(p0[r]); p0[r + 1] = fast_exp2(p0[r + 1]); p1[r] = fast_exp2(p1[r]); p1[r + 1] = fast_exp2(p1[r + 1]); s0 += p0[r]; s1 += p0[r + 1]; s2 += p1[r]; s3 += p1[r + 1]; }
    l += (s0 + s1) + (s2 + s3);
    pa[0] = pack8(p0, 0); pa[1] = pack8(p0, 8); pa[2] = pack8(p1, 0); pa[3] = pack8(p1, 8);
}

template <int ABL = 0>
__device__ __forceinline__ void exp_step(f32x16& p0, f32x16& p1, float& l, bf16x8 (&pa)[4]) {
#define EXPX(x) ((ABL & 1) ? (x) : fast_exp2(x))
    float s0 = 0.f, s1 = 0.f, s2 = 0.f, s3 = 0.f;
#pragma unroll
    for (int r = 0; r < 16; r += 2) { p0[r] = EXPX(p0[r]); p0[r + 1] = EXPX(p0[r + 1]); p1[r] = EXPX(p1[r]); p1[r + 1] = EXPX(p1[r + 1]); s0 += p0[r]; s1 += p0[r + 1]; s2 += p1[r]; s3 += p1[r + 1]; }
    l += (s0 + s1) + (s2 + s3);
    pa[0] = pack8(p0, 0); pa[1] = pack8(p0, 8); pa[2] = pack8(p1, 0); pa[3] = pack8(p1, 8);
}
#undef EXPX
struct St { float m1, l1, m2, l2; f32x16 o1[2], o2[2]; bf16x8 qx; bool first, mnz; };
template <int ABL = 0>
__device__ __forceinline__ void tile_fast_diff(St& S, const LAS unsigned char* kb, const LAS unsigned char* vb, const bf16x8 (&qr)[4]) {
    bf16x8 kf[8];
#pragma unroll
    for (int d0 = 0; d0 < 4; ++d0) { kf[2 * d0] = *(const LAS bf16x8*)(kb + d0 * 2048); kf[2 * d0 + 1] = *(const LAS bf16x8*)(kb + d0 * 2048 + 512); }
    __builtin_amdgcn_sched_barrier(0);
    f32x16 a0 = f32x16{}, a1 = f32x16{}, b0 = f32x16{}, b1 = f32x16{};
    ATT_PRIO(1);
    if (!(ABL & 4)) {
    a0 = __builtin_amdgcn_mfma_f32_32x32x16_bf16(kf[0], qr[0], a0, 0, 0, 0); a1 = __builtin_amdgcn_mfma_f32_32x32x16_bf16(kf[1], qr[0], a1, 0, 0, 0);
    b0 = __builtin_amdgcn_mfma_f32_32x32x16_bf16(kf[4], qr[2], b0, 0, 0, 0); b1 = __builtin_amdgcn_mfma_f32_32x32x16_bf16(kf[5], qr[2], b1, 0, 0, 0);
    a0 = __builtin_amdgcn_mfma_f32_32x32x16_bf16(kf[2], qr[1], a0, 0, 0, 0); a1 = __builtin_amdgcn_mfma_f32_32x32x16_bf16(kf[3], qr[1], a1, 0, 0, 0);
    b0 = __builtin_amdgcn_mfma_f32_32x32x16_bf16(kf[6], qr[3], b0, 0, 0, 0); b1 = __builtin_amdgcn_mfma_f32_32x32x16_bf16(kf[7], qr[3], b1, 0, 0, 0); }
    else { a0[0] = __builtin_bit_cast(float, (int)kf[0][0] + (int)kf[1][1] + (int)kf[2][0] + (int)kf[3][0]); b0[0] = __builtin_bit_cast(float, (int)kf[4][0] + (int)kf[5][0] + (int)kf[6][0] + (int)kf[7][0]); }
    bf16x8 vf0[4], vf1[4];
#pragma unroll
    for (int ks = 0; ks < 4; ++ks) { const s16x4 lo = vtr(vb + ks * 1024), hi4 = vtr(vb + ks * 1024 + 512); vf0[ks] = (bf16x8){lo[0], lo[1], lo[2], lo[3], hi4[0], hi4[1], hi4[2], hi4[3]}; }
    __builtin_amdgcn_sched_barrier(0);
    bf16x8 pa1[4], pa2[4];
    ATT_PRIO(0);
    exp_step<ABL>(a0, a1, S.l1, pa1);
    exp_step<ABL>(b0, b1, S.l2, pa2);
    __builtin_amdgcn_sched_barrier(0);
#pragma unroll
    for (int ks = 0; ks < 4; ++ks) { const s16x4 lo = vtr(vb + 4096 + ks * 1024), hi4 = vtr(vb + 4096 + ks * 1024 + 512); vf1[ks] = (bf16x8){lo[0], lo[1], lo[2], lo[3], hi4[0], hi4[1], hi4[2], hi4[3]}; }
#pragma unroll
    ATT_PRIO(1);
    for (int ks = 0; ks < 4; ++ks) { if (!(ABL & 2)) { S.o1[0] = __builtin_amdgcn_mfma_f32_32x32x16_bf16(pa1[ks], vf0[ks], S.o1[0], 0, 0, 0); S.o2[0] = __builtin_amdgcn_mfma_f32_32x32x16_bf16(pa2[ks], vf0[ks], S.o2[0], 0, 0, 0); } else { S.o1[0][0] += __builtin_bit_cast(float, (int)pa1[ks][0] + (int)vf0[ks][0]); S.o2[0][0] += __builtin_bit_cast(float, (int)pa2[ks][0] + (int)vf0[ks][4]); } }
    __builtin_amdgcn_sched_barrier(0);
#pragma unroll
    for (int ks = 0; ks < 4; ++ks) { if (!(ABL & 2)) { S.o1[1] = __builtin_amdgcn_mfma_f32_32x32x16_bf16(pa1[ks], vf1[ks], S.o1[1], 0, 0, 0); S.o2[1] = __builtin_amdgcn_mfma_f32_32x32x16_bf16(pa2[ks], vf1[ks], S.o2[1], 0, 0, 0); } else { S.o1[1][0] += __builtin_bit_cast(float, (int)pa1[ks][1] + (int)vf1[ks][0]); S.o2[1][0] += __builtin_bit_cast(float, (int)pa2[ks][1] + (int)vf1[ks][4]); } }
    ATT_PRIO(0);
    __builtin_amdgcn_sched_barrier(0);
}


template <int B>
__device__ __forceinline__ void exp4(const f32x16& p, float& l, unsigned& w0, unsigned& w1) {
    const float e0 = fast_exp2(p[B]), e1 = fast_exp2(p[B + 1]), e2 = fast_exp2(p[B + 2]), e3 = fast_exp2(p[B + 3]);
    l += (e0 + e1) + (e2 + e3); w0 = cvt_pk_bf16(e0, e1); w1 = cvt_pk_bf16(e2, e3);
}
#define EXP8(P, B0, L, DST) do { unsigned x0_, x1_, x2_, x3_; exp4<B0>(P, L, x0_, x1_); exp4<B0 + 4>(P, L, x2_, x3_); DST = __builtin_bit_cast(bf16x8, (u32x4){x0_, x1_, x2_, x3_}); } while (0)
__device__ __forceinline__ void tile_fast_diff_il(St& S, const LAS unsigned char* kb, const LAS unsigned char* vb, const bf16x8 (&qr)[4]) {
    bf16x8 kf[8], vf0[4], vf1[4];
#pragma unroll
    for (int d0 = 0; d0 < 4; ++d0) { kf[2 * d0] = *(const LAS bf16x8*)(kb + d0 * 2048); kf[2 * d0 + 1] = *(const LAS bf16x8*)(kb + d0 * 2048 + 512); }
    __builtin_amdgcn_sched_barrier(0);
    f32x16 a0 = f32x16{}, a1 = f32x16{}, b0 = f32x16{}, b1 = f32x16{};
    a0 = __builtin_amdgcn_mfma_f32_32x32x16_bf16(kf[0], qr[0], a0, 0, 0, 0); a1 = __builtin_amdgcn_mfma_f32_32x32x16_bf16(kf[1], qr[0], a1, 0, 0, 0);
    a0 = __builtin_amdgcn_mfma_f32_32x32x16_bf16(kf[2], qr[1], a0, 0, 0, 0); a1 = __builtin_amdgcn_mfma_f32_32x32x16_bf16(kf[3], qr[1], a1, 0, 0, 0);
#pragma unroll
    for (int ks = 0; ks < 4; ++ks) { const s16x4 lo = vtr(vb + ks * 1024), hi4 = vtr(vb + ks * 1024 + 512); vf0[ks] = (bf16x8){lo[0], lo[1], lo[2], lo[3], hi4[0], hi4[1], hi4[2], hi4[3]}; }
#pragma unroll
    for (int ks = 0; ks < 4; ++ks) { const s16x4 lo = vtr(vb + 4096 + ks * 1024), hi4 = vtr(vb + 4096 + ks * 1024 + 512); vf1[ks] = (bf16x8){lo[0], lo[1], lo[2], lo[3], hi4[0], hi4[1], hi4[2], hi4[3]}; }
    __builtin_amdgcn_sched_barrier(0);
    bf16x8 pa1[4], pa2[4]; float la = 0.f, lb = 0.f; unsigned w0, w1, w2, w3;
#define MF(acc, A_, B_) acc = __builtin_amdgcn_mfma_f32_32x32x16_bf16(A_, B_, acc, 0, 0, 0)
#define PK(dst) dst = __builtin_bit_cast(bf16x8, (u32x4){w0, w1, w2, w3})
#define SB() __builtin_amdgcn_sched_barrier(0)
    MF(b0, kf[4], qr[2]); exp4<0>(a0, la, w0, w1); SB();
    MF(b1, kf[5], qr[2]); exp4<4>(a0, lb, w2, w3); PK(pa1[0]); SB();
    MF(b0, kf[6], qr[3]); exp4<8>(a0, la, w0, w1); SB();
    MF(b1, kf[7], qr[3]); exp4<12>(a0, lb, w2, w3); PK(pa1[1]); SB();
    MF(S.o1[0], pa1[0], vf0[0]); exp4<0>(a1, la, w0, w1); SB();
    MF(S.o1[1], pa1[0], vf1[0]); exp4<4>(a1, lb, w2, w3); PK(pa1[2]); SB();
    MF(S.o1[0], pa1[1], vf0[1]); exp4<8>(a1, la, w0, w1); SB();
    MF(S.o1[1], pa1[1], vf1[1]); exp4<12>(a1, lb, w2, w3); PK(pa1[3]); SB();
    S.l1 += la + lb; la = 0.f; lb = 0.f;
    MF(S.o1[0], pa1[2], vf0[2]); exp4<0>(b0, la, w0, w1); SB();
    MF(S.o1[1], pa1[2], vf1[2]); exp4<4>(b0, lb, w2, w3); PK(pa2[0]); SB();
    MF(S.o1[0], pa1[3], vf0[3]); MF(S.o2[0], pa2[0], vf0[0]); exp4<8>(b0, la, w0, w1); SB();
    MF(S.o1[1], pa1[3], vf1[3]); MF(S.o2[1], pa2[0], vf1[0]); exp4<12>(b0, lb, w2, w3); PK(pa2[1]); SB();
    MF(S.o2[0], pa2[1], vf0[1]); exp4<0>(b1, la, w0, w1); SB();
    MF(S.o2[1], pa2[1], vf1[1]); exp4<4>(b1, lb, w2, w3); PK(pa2[2]); SB();
    MF(S.o2[0], pa2[2], vf0[2]); exp4<8>(b1, la, w0, w1); SB();
    MF(S.o2[1], pa2[2], vf1[2]); exp4<12>(b1, lb, w2, w3); PK(pa2[3]); SB();
    S.l2 += la + lb;
    MF(S.o2[0], pa2[3], vf0[3]); MF(S.o2[1], pa2[3], vf1[3]); SB();
#undef MF
#undef PK
#undef SB
}
#undef EXP8

template <int ABL = 0>
__device__ __forceinline__ void diff_front(St& S, const LAS unsigned char* kb, const bf16x8 (&qr)[4], bf16x8 (&pa1)[4], bf16x8 (&pa2)[4]) {
    bf16x8 kf[8];
#pragma unroll
    for (int d0 = 0; d0 < 4; ++d0) { kf[2 * d0] = *(const LAS bf16x8*)(kb + d0 * 2048); kf[2 * d0 + 1] = *(const LAS bf16x8*)(kb + d0 * 2048 + 512); }
    __builtin_amdgcn_sched_barrier(0);
    f32x16 a0 = f32x16{}, a1 = f32x16{}, b0 = f32x16{}, b1 = f32x16{};
    ATT_PRIO(1);
    if (!(ABL & 4)) {
    a0 = __builtin_amdgcn_mfma_f32_32x32x16_bf16(kf[0], qr[0], a0, 0, 0, 0); a1 = __builtin_amdgcn_mfma_f32_32x32x16_bf16(kf[1], qr[0], a1, 0, 0, 0);
    b0 = __builtin_amdgcn_mfma_f32_32x32x16_bf16(kf[4], qr[2], b0, 0, 0, 0); b1 = __builtin_amdgcn_mfma_f32_32x32x16_bf16(kf[5], qr[2], b1, 0, 0, 0);
    a0 = __builtin_amdgcn_mfma_f32_32x32x16_bf16(kf[2], qr[1], a0, 0, 0, 0); a1 = __builtin_amdgcn_mfma_f32_32x32x16_bf16(kf[3], qr[1], a1, 0, 0, 0);
    b0 = __builtin_amdgcn_mfma_f32_32x32x16_bf16(kf[6], qr[3], b0, 0, 0, 0); b1 = __builtin_amdgcn_mfma_f32_32x32x16_bf16(kf[7], qr[3], b1, 0, 0, 0); }
    else { a0[0] = __builtin_bit_cast(float, (int)kf[0][0] + (int)kf[1][1] + (int)kf[2][0] + (int)kf[3][0]); b0[0] = __builtin_bit_cast(float, (int)kf[4][0] + (int)kf[5][0] + (int)kf[6][0] + (int)kf[7][0]); }
    __builtin_amdgcn_sched_barrier(0);
    ATT_PRIO(0);
    exp_step<ABL>(a0, a1, S.l1, pa1);
    exp_step<ABL>(b0, b1, S.l2, pa2);
    __builtin_amdgcn_sched_barrier(0);
}
template <int ABL = 0>
__device__ __forceinline__ void diff_back(St& S, const LAS unsigned char* vb, const bf16x8 (&pa1)[4], const bf16x8 (&pa2)[4]) {
    bf16x8 vf0[4], vf1[4];
#pragma unroll
    for (int ks = 0; ks < 4; ++ks) { const s16x4 lo = vtr(vb + ks * 1024), hi4 = vtr(vb + ks * 1024 + 512); vf0[ks] = (bf16x8){lo[0], lo[1], lo[2], lo[3], hi4[0], hi4[1], hi4[2], hi4[3]}; }
#pragma unroll
    for (int ks = 0; ks < 4; ++ks) { const s16x4 lo = vtr(vb + 4096 + ks * 1024), hi4 = vtr(vb + 4096 + ks * 1024 + 512); vf1[ks] = (bf16x8){lo[0], lo[1], lo[2], lo[3], hi4[0], hi4[1], hi4[2], hi4[3]}; }
    __builtin_amdgcn_sched_barrier(0);
#pragma unroll
    ATT_PRIO(1);
    for (int ks = 0; ks < 4; ++ks) { if (!(ABL & 2)) { S.o1[0] = __builtin_amdgcn_mfma_f32_32x32x16_bf16(pa1[ks], vf0[ks], S.o1[0], 0, 0, 0); S.o2[0] = __builtin_amdgcn_mfma_f32_32x32x16_bf16(pa2[ks], vf0[ks], S.o2[0], 0, 0, 0); } else { S.o1[0][0] += __builtin_bit_cast(float, (int)pa1[ks][0] + (int)vf0[ks][0]); S.o2[0][0] += __builtin_bit_cast(float, (int)pa2[ks][0] + (int)vf0[ks][4]); } }
#pragma unroll
    for (int ks = 0; ks < 4; ++ks) { if (!(ABL & 2)) { S.o1[1] = __builtin_amdgcn_mfma_f32_32x32x16_bf16(pa1[ks], vf1[ks], S.o1[1], 0, 0, 0); S.o2[1] = __builtin_amdgcn_mfma_f32_32x32x16_bf16(pa2[ks], vf1[ks], S.o2[1], 0, 0, 0); } else { S.o1[1][0] += __builtin_bit_cast(float, (int)pa1[ks][1] + (int)vf1[ks][0]); S.o2[1][0] += __builtin_bit_cast(float, (int)pa2[ks][1] + (int)vf1[ks][4]); } }
    ATT_PRIO(0);
    __builtin_amdgcn_sched_barrier(0);
}

__device__ __forceinline__ void tile_fox(St& S, const LAS unsigned char* kb, const LAS unsigned char* vb, const LAS unsigned char* kx, const bf16x8 (&qr)[4], int t, int qmin, int qrow, LAS float* wsf, int r32, int hi) {
    bf16x8 kf[8];
#pragma unroll
    for (int d0 = 0; d0 < 4; ++d0) { kf[2 * d0] = *(const LAS bf16x8*)(kb + d0 * 2048); kf[2 * d0 + 1] = *(const LAS bf16x8*)(kb + d0 * 2048 + 512); }
    const bf16x8 x0 = *(const LAS bf16x8*)kx, x1 = *(const LAS bf16x8*)(kx + 512);
    __builtin_amdgcn_sched_barrier(0);
    f32x16 p0 = f32x16{}, p1 = f32x16{};
#pragma unroll
    for (int d0 = 0; d0 < 4; ++d0) { p0 = __builtin_amdgcn_mfma_f32_32x32x16_bf16(kf[2 * d0], qr[d0], p0, 0, 0, 0); p1 = __builtin_amdgcn_mfma_f32_32x32x16_bf16(kf[2 * d0 + 1], qr[d0], p1, 0, 0, 0); }
    p0 = __builtin_amdgcn_mfma_f32_32x32x16_bf16(x0, S.qx, p0, 0, 0, 0); p1 = __builtin_amdgcn_mfma_f32_32x32x16_bf16(x1, S.qx, p1, 0, 0, 0);
    bf16x8 vf0[4], vf1[4];
#pragma unroll
    for (int ks = 0; ks < 4; ++ks) { const s16x4 lo = vtr(vb + ks * 1024), hi4 = vtr(vb + ks * 1024 + 512); vf0[ks] = (bf16x8){lo[0], lo[1], lo[2], lo[3], hi4[0], hi4[1], hi4[2], hi4[3]}; }
    __builtin_amdgcn_sched_barrier(0);
    if (64 * t + 63 > qmin) {
#pragma unroll
        for (int r = 0; r < 16; ++r) { const int kv = 64 * t + crow(r, hi); if (kv > qrow) p0[r] = -INFINITY; if (kv + 32 > qrow) p1[r] = -INFINITY; } }
    bf16x8 pa1[4];
#if FOX_IL
    {
        const float rm = rowmax32(p0, p1);
        if (S.first || __any(rm > THR)) {
            const float d = S.first ? rm : fmaxf(rm, 0.f); S.m1 += d; const float sc = fast_exp2(-d); S.l1 *= sc;
            if (!S.first) { if (hi == 0) wsf[r32] = sc; LDS_WAIT();
#pragma unroll
                for (int g = 0; g < 4; ++g) { const f32x4 f = *(const LAS f32x4*)(wsf + 4 * hi + 8 * g);
#pragma unroll
                    for (int i = 0; i < 4; ++i) { S.o1[0][4 * g + i] *= f[i]; S.o1[1][4 * g + i] *= f[i]; } } }
#pragma unroll
            for (int r = 0; r < 16; ++r) { p0[r] -= d; p1[r] -= d; }
        }
        S.qx = make_qx(S.m1, hi);
#pragma unroll
        for (int ks = 0; ks < 4; ++ks) { const s16x4 lo = vtr(vb + 4096 + ks * 1024), hi4 = vtr(vb + 4096 + ks * 1024 + 512); vf1[ks] = (bf16x8){lo[0], lo[1], lo[2], lo[3], hi4[0], hi4[1], hi4[2], hi4[3]}; }
        __builtin_amdgcn_sched_barrier(0);
        float la = 0.f, lb = 0.f; unsigned w0, w1, w2, w3;
#define MF(acc, A_, B_) acc = __builtin_amdgcn_mfma_f32_32x32x16_bf16(A_, B_, acc, 0, 0, 0)
#define PK(dst) dst = __builtin_bit_cast(bf16x8, (u32x4){w0, w1, w2, w3})
#define SB() __builtin_amdgcn_sched_barrier(0)
        exp4<0>(p0, la, w0, w1); SB();
        exp4<4>(p0, lb, w2, w3); PK(pa1[0]); SB();
        MF(S.o1[0], pa1[0], vf0[0]); exp4<8>(p0, la, w0, w1); SB();
        MF(S.o1[1], pa1[0], vf1[0]); exp4<12>(p0, lb, w2, w3); PK(pa1[1]); SB();
        MF(S.o1[0], pa1[1], vf0[1]); exp4<0>(p1, la, w0, w1); SB();
        MF(S.o1[1], pa1[1], vf1[1]); exp4<4>(p1, lb, w2, w3); PK(pa1[2]); SB();
        MF(S.o1[0], pa1[2], vf0[2]); exp4<8>(p1, la, w0, w1); SB();
        MF(S.o1[1], pa1[2], vf1[2]); exp4<12>(p1, lb, w2, w3); PK(pa1[3]); SB();
        S.l1 += la + lb;
        MF(S.o1[0], pa1[3], vf0[3]); MF(S.o1[1], pa1[3], vf1[3]); SB();
#undef MF
#undef PK
#undef SB
    }
#else
    softmax_step(p0, p1, S.m1, S.l1, S.o1, pa1, wsf, r32, hi, S.first);
    S.qx = make_qx(S.m1, hi);
    __builtin_amdgcn_sched_barrier(0);
#pragma unroll
    for (int ks = 0; ks < 4; ++ks) { const s16x4 lo = vtr(vb + 4096 + ks * 1024), hi4 = vtr(vb + 4096 + ks * 1024 + 512); vf1[ks] = (bf16x8){lo[0], lo[1], lo[2], lo[3], hi4[0], hi4[1], hi4[2], hi4[3]}; }
#pragma unroll
    for (int ks = 0; ks < 4; ++ks) S.o1[0] = __builtin_amdgcn_mfma_f32_32x32x16_bf16(pa1[ks], vf0[ks], S.o1[0], 0, 0, 0);
    __builtin_amdgcn_sched_barrier(0);
#pragma unroll
    for (int ks = 0; ks < 4; ++ks) S.o1[1] = __builtin_amdgcn_mfma_f32_32x32x16_bf16(pa1[ks], vf1[ks], S.o1[1], 0, 0, 0);
    __builtin_amdgcn_sched_barrier(0);
#endif
    S.first = false;
}
template <int MODE, bool FAST>
__device__ __forceinline__ void tile_compute(St& S, const LAS unsigned char* kb, const LAS unsigned char* vb, const LAS unsigned char* kx, const bf16x8 (&qr)[4], int t, int qmin, int qrow, LAS float* wsf, int r32, int hi) {
    bf16x8 pa1[4], pa2[4];
    {   f32x16 p0 = f32x16{}, p1 = f32x16{};
#pragma unroll
        for (int d0 = 0; d0 < (MODE == 0 ? 4 : 2); ++d0) { const bf16x8 k0 = *(const LAS bf16x8*)(kb + d0 * 2048), k1 = *(const LAS bf16x8*)(kb + d0 * 2048 + 512);
            p0 = __builtin_amdgcn_mfma_f32_32x32x16_bf16(k0, qr[d0], p0, 0, 0, 0); p1 = __builtin_amdgcn_mfma_f32_32x32x16_bf16(k1, qr[d0], p1, 0, 0, 0); }
        if (MODE == 0) {
            const bf16x8 x0 = *(const LAS bf16x8*)kx, x1 = *(const LAS bf16x8*)(kx + 512);
            p0 = __builtin_amdgcn_mfma_f32_32x32x16_bf16(x0, S.qx, p0, 0, 0, 0); p1 = __builtin_amdgcn_mfma_f32_32x32x16_bf16(x1, S.qx, p1, 0, 0, 0);
            if (64 * t + 63 > qmin) {
#pragma unroll
                for (int r = 0; r < 16; ++r) { const int kv = 64 * t + crow(r, hi); if (kv > qrow) p0[r] = -INFINITY; if (kv + 32 > qrow) p1[r] = -INFINITY; } }
        } else if (!FAST && S.mnz) {
#pragma unroll
            for (int r = 0; r < 16; ++r) { p0[r] -= S.m1; p1[r] -= S.m1; } }
        if (FAST) { exp_step(p0, p1, S.l1, pa1); __builtin_amdgcn_sched_barrier(0); } else
        softmax_step(p0, p1, S.m1, S.l1, S.o1, pa1, wsf, r32, hi, MODE == 0 ? S.first : false);
        if (MODE == 0) { if (S.first || __any(S.m1 != 0.f)) S.qx = make_qx(S.m1, hi); }
    }
    if (MODE == 1) {
        f32x16 p0 = f32x16{}, p1 = f32x16{};
#pragma unroll
        for (int d0 = 2; d0 < 4; ++d0) { const bf16x8 k0 = *(const LAS bf16x8*)(kb + d0 * 2048), k1 = *(const LAS bf16x8*)(kb + d0 * 2048 + 512);
            p0 = __builtin_amdgcn_mfma_f32_32x32x16_bf16(k0, qr[d0], p0, 0, 0, 0); p1 = __builtin_amdgcn_mfma_f32_32x32x16_bf16(k1, qr[d0], p1, 0, 0, 0); }
        if (!FAST && S.mnz) {
#pragma unroll
            for (int r = 0; r < 16; ++r) { p0[r] -= S.m2; p1[r] -= S.m2; } }
        if (FAST) { exp_step(p0, p1, S.l2, pa2); __builtin_amdgcn_sched_barrier(0); } else {
        softmax_step(p0, p1, S.m2, S.l2, S.o2, pa2, wsf, r32, hi, false);
        S.mnz = __any(S.m1 != 0.f || S.m2 != 0.f); }
    }
#pragma unroll
    for (int d0 = 0; d0 < 2; ++d0) { bf16x8 vf[4];
#pragma unroll
        for (int ks = 0; ks < 4; ++ks) { const s16x4 lo = vtr(vb + d0 * 4096 + ks * 1024), hi4 = vtr(vb + d0 * 4096 + ks * 1024 + 512); vf[ks] = (bf16x8){lo[0], lo[1], lo[2], lo[3], hi4[0], hi4[1], hi4[2], hi4[3]}; }
        if (MODE == 0) __builtin_amdgcn_sched_barrier(0);
#pragma unroll
        for (int ks = 0; ks < 4; ++ks) { S.o1[d0] = __builtin_amdgcn_mfma_f32_32x32x16_bf16(pa1[ks], vf[ks], S.o1[d0], 0, 0, 0);
            if (MODE == 1) S.o2[d0] = __builtin_amdgcn_mfma_f32_32x32x16_bf16(pa2[ks], vf[ks], S.o2[d0], 0, 0, 0); }
        if (MODE == 0) __builtin_amdgcn_sched_barrier(0);
    }
    S.first = false;
}

#define SBAR() __builtin_amdgcn_sched_barrier(0)
#define DQK(P0, P1, j, d0a) do { const LAS unsigned char* kb_ = kq + (j) * SLOTB; P0 = f32x16{}; P1 = f32x16{}; \
        _Pragma("unroll") for (int d0 = (d0a); d0 < (d0a) + 2; ++d0) { const bf16x8 k0 = *(const LAS bf16x8*)(kb_ + d0 * 2048), k1 = *(const LAS bf16x8*)(kb_ + d0 * 2048 + 512); \
            P0 = __builtin_amdgcn_mfma_f32_32x32x16_bf16(k0, qr[d0], P0, 0, 0, 0); P1 = __builtin_amdgcn_mfma_f32_32x32x16_bf16(k1, qr[d0], P1, 0, 0, 0); } } while (0)
#define DPV(j) do { const LAS unsigned char* vb_ = vq + (j) * SLOTB; \
        _Pragma("unroll") for (int d0 = 0; d0 < 2; ++d0) { _Pragma("unroll") for (int ks = 0; ks < 4; ++ks) { const s16x4 lo = vtr(vb_ + d0 * 4096 + ks * 1024), hi4 = vtr(vb_ + d0 * 4096 + ks * 1024 + 512); \
            const bf16x8 vf = (bf16x8){lo[0], lo[1], lo[2], lo[3], hi4[0], hi4[1], hi4[2], hi4[3]}; \
            S.o1[d0] = __builtin_amdgcn_mfma_f32_32x32x16_bf16(pa1[ks], vf, S.o1[d0], 0, 0, 0); S.o2[d0] = __builtin_amdgcn_mfma_f32_32x32x16_bf16(pa2[ks], vf, S.o2[d0], 0, 0, 0); } SBAR(); } } while (0)
__device__ __forceinline__ void diff_fast_step(St& S, const LAS unsigned char* kq, const LAS unsigned char* vq, const bf16x8 (&qr)[4], int ntl) {
    f32x16 pA0, pA1, pB0, pB1; bf16x8 pa1[4], pa2[4];
    if (ntl == 2) {
        DQK(pA0, pA1, 0, 0); SBAR();
        DQK(pB0, pB1, 0, 2); exp_step(pA0, pA1, S.l1, pa1); SBAR();
        DQK(pA0, pA1, 1, 0); exp_step(pB0, pB1, S.l2, pa2); SBAR();
        DPV(0);
        DQK(pB0, pB1, 1, 2); exp_step(pA0, pA1, S.l1, pa1); SBAR();
        exp_step(pB0, pB1, S.l2, pa2); SBAR();
        DPV(1);
    } else if (ntl == 1) {
        DQK(pA0, pA1, 0, 0); SBAR();
        DQK(pB0, pB1, 0, 2); exp_step(pA0, pA1, S.l1, pa1); SBAR();
        exp_step(pB0, pB1, S.l2, pa2); SBAR();
        DPV(0);
    }
}
#undef DQK
#undef DPV
#undef SBAR

template <int MODE, bool FAST, int ABL = 0>
__device__ __forceinline__ void attn_unit(const Frame& F, ARGS_T& A, int l, int b, int h, int qb) {
    LAS unsigned char* shm = F.lds + RING_OFF;
    int lane = F.lane; asm volatile("" : "+v"(lane));
    const int r32 = lane & 31, hi = lane >> 5, wid = F.wave, tid_ = wid * 64 + lane;
    const bf16* PA = WSP(bf16, WS_PA);
    const size_t rowbase = (size_t)b * SEQ; const int q0 = qb * 256;
    constexpr int QC = MODE == 0 ? 0 : 768, KC = MODE == 0 ? 256 : 1024, VC = MODE == 0 ? 512 : 1280;
    const bf16* Qw = PA + (rowbase + q0 + wid * 32 + r32) * PA_LD + QC + h * 64;
    const bf16* Kh = PA + rowbase * PA_LD + KC + h * 64; const bf16* Vh = PA + rowbase * PA_LD + VC + h * 64;
    const unsigned lds0 = (unsigned)(uintptr_t)shm;
    LAS float* wsf = (LAS float*)(shm + L_WS) + wid * 64;
    unsigned koff = (unsigned)(lane * PA_LD + wid * 8) * 2u, voff = (unsigned)((16 * (wid & 3) + (lane >> 2)) * PA_LD + (wid >> 2) * 32 + (lane & 3) * 8) * 2u;
    asm volatile("" : "+v"(koff), "+v"(voff));
    const unsigned kdst = lds0 + L_K + wid * 1024, vdst = lds0 + L_V + wid * 1024;
#define DMA_KV(t, slot, vslot) do { glds16s(Kh + (size_t)(t) * 64 * PA_LD, koff, (unsigned)__builtin_amdgcn_readfirstlane(kdst + (slot) * SLOTB)); glds16s(Vh + (size_t)(t) * 64 * PA_LD, voff, (unsigned)__builtin_amdgcn_readfirstlane(vdst + (vslot) * SLOTB)); } while (0)
    bf16x8 qr[4];
#pragma unroll
    for (int d0 = 0; d0 < 4; ++d0) qr[d0] = *(const bf16x8*)(Qw + d0 * 16 + hi * 8);
    const int NTF = 4 * qb + 4;
    const float* cum = WSP(float, WS_CUMF) + (size_t)(b * 4 + h) * SEQ;
    float cq0 = 0.f; if (MODE == 0) cq0 = cum[q0];
    int tlo = 0;
    if (MODE == 0) { const unsigned* NRM = (const unsigned*)(F.ctl + CW_NRM + l * 128); const int bh_ = b * 4 + h;
        const float nq = __uint_as_float(__hip_atomic_load(NRM + (0 * 16 + bh_) * 2, RLX_AGENT)) + __uint_as_float(__hip_atomic_load(NRM + (0 * 16 + bh_) * 2 + 1, RLX_AGENT));
        const float nk = __uint_as_float(__hip_atomic_load(NRM + (1 * 16 + bh_) * 2, RLX_AGENT)) + __uint_as_float(__hip_atomic_load(NRM + (1 * 16 + bh_) * 2 + 1, RLX_AGENT));
        const float thr = 2.f * 1.02f * sqrtf(nq * nk) + 37.f;
        LAS int* TL = (LAS int*)(shm + L_WS + NWAVES * 256 - 16);
        if (tid_ == 0) *TL = NTF - 4;
        __syncthreads();
        if (tid_ < NTF - 4) { if (cq0 - cum[tid_ * 64 + 63] >= -thr) __hip_atomic_fetch_min(TL, tid_, __ATOMIC_RELAXED, __HIP_MEMORY_SCOPE_WORKGROUP); }
        __syncthreads();
        tlo = *TL; __syncthreads(); }
    const int NT = NTF - tlo, NT2 = (NT + 1) >> 1;
#define TILE_OF(i) (MODE == 0 ? (NTF - 1 - (i)) : (i))
#define KX_LOAD(i2) ((2 * (i2) + (tid_ >> 6) < NT) ? cq0 - cum[TILE_OF(2 * (i2) + (tid_ >> 6)) * 64 + (tid_ & 63)] : 0.f)
#define KX_STORE(base, bv) do { const float b_ = (bv); const unsigned hb_ = cvt_pk_bf16(b_, 0.f) & 0xffffu; const float lo_ = b_ - __uint_as_float(hb_ << 16); u32x4 w_; w_.x = hb_ | (cvt_pk_bf16(lo_, 0.f) << 16); w_.y = 0x3F803F80u; w_.z = 0x3F80u; w_.w = 0u; \
        *(LAS u32x4*)(shm + L_KX + ((base) + (tid_ >> 6)) * 1024 + (tid_ & 63) * 16) = w_; } while (0)
    float kxv = 0.f;
    DMA_KV(TILE_OF(0), 0, 0); if (NT > 1) DMA_KV(TILE_OF(1), 1, 1);
    if (MODE == 0 && tid_ < 128) { kxv = KX_LOAD(0); KX_STORE(0, kxv); }
    St S; S.m1 = 0.f; S.l1 = 0.f; S.m2 = 0.f; S.l2 = 0.f; S.first = true; S.mnz = false; S.qx = make_qx(0.f, hi);
#pragma unroll
    for (int d = 0; d < 2; ++d) { S.o1[d] = f32x16{}; S.o2[d] = f32x16{}; }
    const int qmin = q0 + wid * 32, qrow = qmin + r32;
    ATT_WAIT_BAR();
    asm volatile("" : "+v"(qr[0]), "+v"(qr[1]), "+v"(qr[2]), "+v"(qr[3]), "+v"(cq0));
    constexpr bool LAGP = (MODE == 1 && FAST && DIFF_LAG);
    auto step_loop = [&](auto role_) { constexpr bool LAGW = decltype(role_)::value != 0;
    int vcur = 0, pend = -1; bf16x8 pp1[4], pp2[4];
    if (LAGW) {
#pragma unroll
        for (int ks = 0; ks < 4; ++ks) { pp1[ks] = bf16x8{}; pp2[ks] = bf16x8{}; } }
    for (int it = 0; it < NT2; ++it) {
        const int base = (it & 1) * 2; const int vnxt = LAGP ? (vcur == 4 ? 0 : vcur + 2) : (base ^ 2);
        if (!LAGP) vcur = base;
        if (it + 1 < NT2) { DMA_KV(TILE_OF(2 * it + 2), base ^ 2, vnxt); if (2 * it + 3 < NT) DMA_KV(TILE_OF(2 * it + 3), (base ^ 2) + 1, vnxt + 1); if (MODE == 0 && tid_ < 128) kxv = KX_LOAD(it + 1); }
        const LAS unsigned char* kq = shm + L_K + base * SLOTB + hi * 1024 + r32 * 16; const LAS unsigned char* vq = shm + L_V + (LAGP ? 0 : base * SLOTB) + ((lane >> 4) & 1) * 32 + (lane & 3) * 8 + (4 * hi + ((lane & 15) >> 2)) * 64;
        const LAS unsigned char* kxq = shm + L_KX + base * 1024 + r32 * 16;
        asm volatile("" : "+v"(kq), "+v"(vq), "+v"(kxq));
        if (MODE == 1 && FAST && ATT_STAGGER > 0) { if (wid >= 4) __builtin_amdgcn_s_sleep(ATT_STAGGER); }
#pragma unroll
        for (int j = 0; j < 2; ++j) { const int i = 2 * it + j;
            if (i < NT) { const int t = TILE_OF(i); const bool active = (MODE == 0 ? (64 * t <= qmin + 31) : (t <= 4 * qb + (wid >> 1))) && !((ABL & 8) && wid >= 4) && !((ABL & 16) && wid < 4);
                if (active) { if constexpr (LAGP) { if constexpr (!LAGW) { if constexpr (DIFF_IL && ABL == 0) tile_fast_diff_il(S, kq + j * SLOTB, vq + (vcur + j) * SLOTB, qr); else tile_fast_diff<ABL>(S, kq + j * SLOTB, vq + (vcur + j) * SLOTB, qr); }
                        else { if (pend >= 0) diff_back<ABL>(S, vq + pend * SLOTB, pp1, pp2); diff_front<ABL>(S, kq + j * SLOTB, qr, pp1, pp2); pend = vcur + j; } }
                    else if constexpr (MODE == 1 && FAST) { if constexpr (DIFF_IL && ABL == 0) tile_fast_diff_il(S, kq + j * SLOTB, vq + j * SLOTB, qr); else tile_fast_diff<ABL>(S, kq + j * SLOTB, vq + j * SLOTB, qr); } else if constexpr (MODE == 0) tile_fox(S, kq + j * SLOTB, vq + j * SLOTB, kxq + j * 1024, qr, t, qmin, qrow, wsf, r32, hi); else tile_compute<MODE, FAST>(S, kq + j * SLOTB, vq + j * SLOTB, kxq + j * 1024, qr, t, qmin, qrow, wsf, r32, hi); } }
            __builtin_amdgcn_sched_barrier(0); }
        if (MODE == 0 && it + 1 < NT2 && tid_ < 128) KX_STORE(base ^ 2, kxv);
        ATT_WAIT_BAR();
        vcur = vnxt;
    }
    if constexpr (LAGW) {
        if (pend >= 0) { const LAS unsigned char* vq = shm + L_V + ((lane >> 4) & 1) * 32 + (lane & 3) * 8 + (4 * hi + ((lane & 15) >> 2)) * 64; diff_back<ABL>(S, vq + pend * SLOTB, pp1, pp2); } }
    };
    if constexpr (LAGP) { if (wid >= 4) step_loop(IC<1>{}); else step_loop(IC<0>{}); ATT_WAIT_BAR(); }
    else step_loop(IC<0>{});
    float l1 = half_sum(S.l1), l2 = 1.f; if (MODE == 1) l2 = half_sum(S.l2);
    float lam = 0.f, post = 1.f;
    if (MODE == 1) { float d1 = 0.f, d2 = 0.f;
        for (int i = 0; i < 32; ++i) { d1 += AIN(I_LQ1)[l * 32 + i] * AIN(I_LK1)[l * 32 + i]; d2 += AIN(I_LQ2)[l * 32 + i] * AIN(I_LK2)[l * 32 + i]; }
        const float lam_init = 0.8f - 0.6f * __expf(-0.3f * (float)l); lam = __expf(d1) - __expf(d2) + lam_init; post = 1.f - lam_init; }
    if (hi == 0) { wsf[r32] = 1.f / l1; if (MODE == 1) wsf[32 + r32] = lam / l2; }
    LDS_WAIT();
    LAS float* stg = (LAS float*)(shm + L_OST) + wid * 2048;
#pragma unroll
    for (int g = 0; g < 4; ++g) { const f32x4 c1 = *(const LAS f32x4*)(wsf + 4 * hi + 8 * g); f32x4 c2 = {0.f, 0.f, 0.f, 0.f}; if (MODE == 1) c2 = *(const LAS f32x4*)(wsf + 32 + 4 * hi + 8 * g);
#pragma unroll
        for (int i = 0; i < 4; ++i) { const int r = 4 * g + i, orow = crow(r, hi);
#pragma unroll
            for (int d0 = 0; d0 < 2; ++d0) { float v = S.o1[d0][r] * c1[i]; if (MODE == 1) v -= S.o2[d0][r] * c2[i]; stg[orow * 64 + d0 * 32 + r32] = v; } } }
    LDS_WAIT();
    bf16* Y = YMIXP(F) + (rowbase + q0 + wid * 32) * DM + (MODE == 0 ? 0 : 256) + h * 64;
    const float* gn = AIN(I_DNG) + l * 64;
    int lane_e = lane; asm volatile("" : "+v"(lane_e));
#pragma unroll
    for (int i = 0; i < 4; ++i) { const int row = i * 8 + (lane_e >> 3), ch = lane_e & 7; f32x4 a = *(const LAS f32x4*)(stg + row * 64 + ch * 8), c = *(const LAS f32x4*)(stg + row * 64 + ch * 8 + 4);
        if (MODE == 1) { float ss = (a[0] * a[0] + a[1] * a[1]) + (a[2] * a[2] + a[3] * a[3]) + (c[0] * c[0] + c[1] * c[1]) + (c[2] * c[2] + c[3] * c[3]);
            ss += __shfl_xor(ss, 1); ss += __shfl_xor(ss, 2); ss += __shfl_xor(ss, 4);
            const float rs = post / sqrtf(ss * (1.f / 64.f) + LN_EPS); const f32x4 g0 = *(const f32x4*)(gn + ch * 8), g1 = *(const f32x4*)(gn + ch * 8 + 4);
            a = a * rs * g0; c = c * rs * g1; }
        u32x4 w; w.x = cvt_pk_bf16(a[0], a[1]); w.y = cvt_pk_bf16(a[2], a[3]); w.z = cvt_pk_bf16(c[0], c[1]); w.w = cvt_pk_bf16(c[2], c[3]);
        *(u32x4*)(Y + (size_t)row * DM + ch * 8) = w; }
    ATT_WAIT_BAR();
#undef DMA_KV
#undef TILE_OF
#undef KX_LOAD
#undef KX_STORE
}
template <int MODE, int ABL = 0>
__device__ __forceinline__ void attn_phase(const Frame& F, ARGS_T& A, int l) {
    for (int c0 = F.bid; c0 < 256; c0 += F.G) { const int c = (F.G == 256) ? (c0 & 7) * 32 + (c0 >> 3) : c0;
        const int bh = c >> 4, s = c & 15;
        bool fast = false;
        if (MODE == 1) {
            const unsigned* NRM = (const unsigned*)(F.ctl + CW_NRM + l * 128); float bmax = 0.f;
            for (int j = 0; j < 2; ++j) { const float nq = __uint_as_float(__hip_atomic_load(NRM + (2 * 16 + bh) * 2 + j, RLX_AGENT)), nk = __uint_as_float(__hip_atomic_load(NRM + (3 * 16 + bh) * 2 + j, RLX_AGENT)); bmax = fmaxf(bmax, 1.02f * sqrtf(nq * nk)); }
            fast = bmax <= DIFF_FAST_BOUND; }
        if (MODE == 1 && fast) { attn_unit<MODE, true, ABL>(F, A, l, bh >> 2, bh & 3, 31 - s); attn_unit<MODE, true, ABL>(F, A, l, bh >> 2, bh & 3, s); }
        else if (MODE == 0 || !ONLY_FAST_TEST) { attn_unit<MODE, false>(F, A, l, bh >> 2, bh & 3, 31 - s); attn_unit<MODE, false>(F, A, l, bh >> 2, bh & 3, s); } }
}
}
namespace hg {
constexpr int PQ = 136, PV = 72;
constexpr int L_QD = 0, L_KD = 17408, L_KO = 34816, L_QS = 43520, L_VT = 60928, L_ST = 79360, L_SEG = 114176, L_END = 116224, L_OST = 0;
static_assert(L_END <= RING_BYTES, "hgrn LDS");
struct Prep { float q[16], k[16], bc[16]; float blast, b31; };
#define HG_BAR() do { asm volatile("s_waitcnt lgkmcnt(0)" ::: "memory"); __builtin_amdgcn_s_barrier(); asm volatile("" ::: "memory"); } while (0)
struct Raw { float x[16]; bf16 q[16], v[16]; u32x4 st[4]; u32x4 g[2]; };
template <bool P3>
__device__ __forceinline__ void load_raw(const Frame& F, int U, Raw& R) {
    const int bh = U >> 7, n = U & 127, b = bh >> 2, h = bh & 3; const int c = F.tid & 127, seg = F.tid >> 7; const size_t tok0 = (size_t)b * SEQ + n * 64 + seg * 16; const int ch = h * 128 + c;
    const float* HF = WSP(float, WS_HF) + tok0 * 512 + ch; const bf16* HQ = WSP(bf16, WS_HQ) + tok0 * 512 + ch; const bf16* HI = WSP(bf16, WS_HI) + tok0 * 512 + ch;
#pragma unroll
    for (int i = 0; i < 16; ++i) { R.x[i] = HF[(size_t)i * 512]; R.v[i] = HI[(size_t)i * 512]; if (P3) R.q[i] = HQ[(size_t)i * 512]; }
    if (P3) { if (n > 0) { const bf16* ST = WSP(bf16, WS_ST) + (size_t)(U - 1) * 16384;
#pragma unroll
            for (int i = 0; i < 4; ++i) { const int idx = F.tid + i * NTHR; R.st[i] = *(const u32x4*)(ST + (idx >> 4) * 128 + (idx & 15) * 8); } }
        const int t = F.tid >> 3, v0 = (F.tid & 7) * 16; const bf16* HG = WSP(bf16, WS_HG) + ((size_t)b * SEQ + n * 64 + t) * 512 + h * 128 + v0; R.g[0] = *(const u32x4*)HG; R.g[1] = *(const u32x4*)(HG + 8); }
}
__device__ __forceinline__ void prep(const Frame& F, ARGS_T& A, int l, int h, const Raw& R, bool need_q, Prep& P) {
    const int c = F.tid & 127, seg = F.tid >> 7; const int ch = h * 128 + c;
    float lb = 0.f; if (l == 1) { const float b0 = AIN(I_HLB)[ch], b1 = AIN(I_HLB)[512 + ch]; lb = 1.f / (1.f + __expf(b0 - b1)); }
    LAS float* SEG = (LAS float*)(F.lds + L_SEG);
    float run = 0.f;
#pragma unroll
    for (int i = 0; i < 16; ++i) { const float x = R.x[i]; const float e = fast_exp2(-fabsf(x) * LOG2E);
        const float s = (x >= 0.f ? 1.f : e) * fast_rcp(1.f + e);
        const float lf2 = (l == 0) ? (fminf(x, 0.f) * LOG2E - __builtin_amdgcn_logf(1.f + e)) : __builtin_amdgcn_logf(lb + (1.f - lb) * s);
        run += lf2; P.bc[i] = run; P.k[i] = (1.f - lb) * (1.f - s); P.q[i] = need_q ? bf2f(R.q[i]) : 0.f; }
    SEG[seg * 128 + c] = run;
    HG_BAR();
    const float s0 = SEG[c], s1 = SEG[128 + c], s2 = SEG[256 + c], s3 = SEG[384 + c];
    const float pre = seg == 0 ? 0.f : seg == 1 ? s0 : seg == 2 ? s0 + s1 : s0 + s1 + s2;
#pragma unroll
    for (int i = 0; i < 16; ++i) P.bc[i] += pre;
    P.b31 = s0 + s1; P.blast = (s0 + s1) + (s2 + s3);
}
__device__ __forceinline__ void store16(LAS unsigned char* dst, const float (&v)[16]) {
    u32x4 a, b; a.x = cvt_pk_bf16(v[0], v[1]); a.y = cvt_pk_bf16(v[2], v[3]); a.z = cvt_pk_bf16(v[4], v[5]); a.w = cvt_pk_bf16(v[6], v[7]);
    b.x = cvt_pk_bf16(v[8], v[9]); b.y = cvt_pk_bf16(v[10], v[11]); b.z = cvt_pk_bf16(v[12], v[13]); b.w = cvt_pk_bf16(v[14], v[15]);
    *(LAS u32x4*)dst = a; *(LAS u32x4*)(dst + 16) = b;
}
__device__ __forceinline__ void store_vt(const Frame& F, const Raw& R) {
    const int c = F.tid & 127, seg = F.tid >> 7; u32x4 a, b;
    a.x = R.v[0] | ((unsigned)R.v[1] << 16); a.y = R.v[2] | ((unsigned)R.v[3] << 16); a.z = R.v[4] | ((unsigned)R.v[5] << 16); a.w = R.v[6] | ((unsigned)R.v[7] << 16);
    b.x = R.v[8] | ((unsigned)R.v[9] << 16); b.y = R.v[10] | ((unsigned)R.v[11] << 16); b.z = R.v[12] | ((unsigned)R.v[13] << 16); b.w = R.v[14] | ((unsigned)R.v[15] << 16);
    LAS unsigned char* dst = F.lds + L_VT + c * (PV * 2) + seg * 32; *(LAS u32x4*)dst = a; *(LAS u32x4*)(dst + 16) = b;
}
__device__ __forceinline__ void pass1_unit(const Frame& F0_, ARGS_T& A, int l, int U, Raw& R, int Unext) {
    Frame F = F0_; { int t_ = F.tid; asm volatile("" : "+v"(t_)); F.tid = t_; F.lane = t_ & 63; }
    const int bh = U >> 7, h = bh & 3; const int c = F.tid & 127, seg = F.tid >> 7;
    Prep P; prep(F, A, l, h, R, false, P);
    { float kd[16];
#pragma unroll
      for (int i = 0; i < 16; ++i) kd[i] = P.k[i] * fast_exp2(P.blast - P.bc[i]);
      store16(F.lds + L_KD + c * (PV * 2) + seg * 32, kd); }
    store_vt(F, R);
    if (seg == 0) WSP(float, WS_HDEC)[(size_t)U * 128 + c] = fast_exp2(P.blast);
    HG_BAR();
    if (Unext < 2048) load_raw<false>(F, Unext, R);
    const int lane = F.lane, r32 = lane & 31, hi = lane >> 5, vb = F.wave >> 1, db0 = (F.wave & 1) * 2;
    f32x16 acc[2]; acc[0] = f32x16{}; acc[1] = f32x16{};
#pragma unroll
    for (int ks = 0; ks < 4; ++ks) { const bf16x8 a = *(const LAS bf16x8*)(F.lds + L_VT + (vb * 32 + r32) * (PV * 2) + ks * 32 + hi * 16);
#pragma unroll
        for (int j = 0; j < 2; ++j) { const bf16x8 bb = *(const LAS bf16x8*)(F.lds + L_KD + ((db0 + j) * 32 + r32) * (PV * 2) + ks * 32 + hi * 16);
            acc[j] = __builtin_amdgcn_mfma_f32_32x32x16_bf16(a, bb, acc[j], 0, 0, 0); } }
    bf16* ST = WSP(bf16, WS_ST) + (size_t)U * 16384;
#pragma unroll
    for (int j = 0; j < 2; ++j)
#pragma unroll
        for (int r = 0; r < 16; ++r) { const int v = vb * 32 + (r & 3) + 8 * (r >> 2) + 4 * hi; ST[v * 128 + (db0 + j) * 32 + r32] = f2bf(acc[j][r]); }
    HG_BAR();
}
__device__ __forceinline__ void phase_pass1(const Frame& F, ARGS_T& A, int l) {
    Raw R; if (F.bid < 2048) load_raw<false>(F, F.bid, R);
    for (int U = F.bid; U < 2048; U += F.G) pass1_unit(F, A, l, U, R, U + F.G);
}

__device__ __forceinline__ void phase_scan(const Frame& F, int skip) {
    u32x2* ST = WSP(u32x2, WS_ST); const float* HD = WSP(float, WS_HDEC);
    if (F.bid < skip) return;
    for (int g = (F.bid - skip) * NTHR + F.tid; g < 16 * 4096; g += (F.G - skip) * NTHR) { const int bh = g >> 12, rem = g & 4095, v = rem >> 5, d4 = rem & 31;
        u32x2* p = ST + ((size_t)bh * 128 * 16384 + v * 128) / 4 + d4; const float* dp = HD + (size_t)bh * 128 * 128 + 4 * d4;
        float s0 = 0.f, s1 = 0.f, s2 = 0.f, s3 = 0.f;
        for (int n0 = 0; n0 < 128; n0 += 8) { u32x2 x[8]; f32x4 dc[8];
#pragma unroll
            for (int j = 0; j < 8; ++j) { x[j] = p[(size_t)(n0 + j) * 4096]; dc[j] = *(const f32x4*)(dp + (size_t)(n0 + j) * 128); }
#pragma unroll
            for (int j = 0; j < 8; ++j) { s0 = s0 * dc[j].x + __uint_as_float(x[j].x << 16); s1 = s1 * dc[j].y + __uint_as_float(x[j].x & 0xffff0000u);
                s2 = s2 * dc[j].z + __uint_as_float(x[j].y << 16); s3 = s3 * dc[j].w + __uint_as_float(x[j].y & 0xffff0000u);
                u32x2 o; o.x = cvt_pk_bf16(s0, s1); o.y = cvt_pk_bf16(s2, s3); p[(size_t)(n0 + j) * 4096] = o; } }
    }
}
__device__ __forceinline__ void pass3_unit(const Frame& F0_, ARGS_T& A, int l, int U, Raw& R, int Unext) {
    Frame F = F0_; { int t_ = F.tid; asm volatile("" : "+v"(t_)); F.tid = t_; F.lane = t_ & 63; }
    const int bh = U >> 7, n = U & 127, b = bh >> 2, h = bh & 3; const int c = F.tid & 127, seg = F.tid >> 7;
    if (n > 0) {
#pragma unroll
        for (int i = 0; i < 4; ++i) { const int idx = F.tid + i * NTHR, v = idx >> 4, ch = idx & 15; *(LAS u32x4*)(F.lds + L_ST + v * (PQ * 2) + ch * 16) = R.st[i]; } }
    Prep P; prep(F, A, l, h, R, true, P);
    { const float ref = seg < 2 ? 0.f : P.b31;
      LAS bf16* QD = (LAS bf16*)(F.lds + L_QD); LAS bf16* KD = (LAS bf16*)(F.lds + L_KD); LAS bf16* KO = (LAS bf16*)(F.lds + L_KO); LAS bf16* QS = (LAS bf16*)(F.lds + L_QS);
#pragma unroll
      for (int i = 0; i < 16; ++i) { const int t = seg * 16 + i;
          QD[t * PQ + c] = f2bf(P.q[i] * fast_exp2(P.bc[i] - ref)); KD[t * PQ + c] = f2bf(P.k[i] * fast_exp2(ref - P.bc[i])); QS[t * PQ + c] = f2bf(P.q[i] * fast_exp2(P.bc[i]));
          if (seg < 2) KO[t * PQ + c] = f2bf(P.k[i] * fast_exp2(P.b31 - P.bc[i])); } }
    store_vt(F, R);
    u32x4 g0 = R.g[0], g1 = R.g[1]; asm volatile("" : "+v"(g0), "+v"(g1));
    HG_BAR();
    if (Unext < 2048) load_raw<true>(F, Unext, R);
    const int lane = F.lane, r32 = lane & 31, hi = lane >> 5, tb = F.wave >> 2, vb = F.wave & 3;
    f32x16 o = f32x16{};
    const LAS unsigned char* qd = F.lds + L_QD + (tb * 32 + r32) * (PQ * 2) + hi * 16;
    const LAS unsigned char* vt = F.lds + L_VT + (vb * 32 + r32) * (PV * 2) + hi * 8;
#pragma unroll
    for (int sb = 0; sb < 2; ++sb) {
        if (sb <= tb) {
            const LAS unsigned char* kk = (sb == tb) ? F.lds + L_KD + (sb * 32 + r32) * (PQ * 2) + hi * 16 : F.lds + L_KO + r32 * (PQ * 2) + hi * 16;
            bf16x8 ka[8], qa[8];
#pragma unroll
            for (int ks = 0; ks < 8; ++ks) { ka[ks] = *(const LAS bf16x8*)(kk + ks * 32); qa[ks] = *(const LAS bf16x8*)(qd + ks * 32); }
            __builtin_amdgcn_sched_barrier(0);
            f32x16 x = f32x16{};
#pragma unroll
            for (int ks = 0; ks < 8; ++ks) x = __builtin_amdgcn_mfma_f32_32x32x16_bf16(ka[ks], qa[ks], x, 0, 0, 0);
            if (sb == tb) {
#pragma unroll
                for (int r = 0; r < 16; ++r) { const int s = (r & 3) + 8 * (r >> 2) + 4 * hi; if (s > r32) x[r] = 0.f; } }
#pragma unroll
            for (int s2 = 0; s2 < 2; ++s2) { const bf16x8 pa = att::pack8(x, 8 * s2);
                const s16x4 lo = *(const LAS s16x4*)(vt + (sb * 32 + s2 * 16) * 2), hh = *(const LAS s16x4*)(vt + (sb * 32 + s2 * 16 + 8) * 2);
                const bf16x8 vf = (bf16x8){lo[0], lo[1], lo[2], lo[3], hh[0], hh[1], hh[2], hh[3]};
                o = __builtin_amdgcn_mfma_f32_32x32x16_bf16(pa, vf, o, 0, 0, 0); }
        }
    }
    if (n > 0) { const LAS unsigned char* qs = F.lds + L_QS + (tb * 32 + r32) * (PQ * 2) + hi * 16; const LAS unsigned char* st = F.lds + L_ST + (vb * 32 + r32) * (PQ * 2) + hi * 16;
        bf16x8 qa[8], sa[8];
#pragma unroll
        for (int ks = 0; ks < 8; ++ks) { qa[ks] = *(const LAS bf16x8*)(qs + ks * 32); sa[ks] = *(const LAS bf16x8*)(st + ks * 32); }
        __builtin_amdgcn_sched_barrier(0);
#pragma unroll
        for (int ks = 0; ks < 8; ++ks) o = __builtin_amdgcn_mfma_f32_32x32x16_bf16(qa[ks], sa[ks], o, 0, 0, 0); }
    HG_BAR();
    LAS float* OST = (LAS float*)(F.lds + L_OST);
#pragma unroll
    for (int r = 0; r < 16; ++r) { const int t = tb * 32 + (r & 3) + 8 * (r >> 2) + 4 * hi; OST[t * 132 + vb * 32 + r32] = o[r]; }
    HG_BAR();
    { const int t = F.tid >> 3, v0 = (F.tid & 7) * 16; const size_t tok = (size_t)b * SEQ + n * 64 + t;
      f32x4 x[4]; float ss = 0.f;
#pragma unroll
      for (int j = 0; j < 4; ++j) { x[j] = *(const LAS f32x4*)(OST + t * 132 + v0 + 4 * j); ss += (x[j][0] * x[j][0] + x[j][1] * x[j][1]) + (x[j][2] * x[j][2] + x[j][3] * x[j][3]); }
      ss += __shfl_xor(ss, 1); ss += __shfl_xor(ss, 2); ss += __shfl_xor(ss, 4);
      const float rs = 1.f / sqrtf(ss * (1.f / 128.f) + LN_EPS);
      const float* gn = AIN(I_HNG) + l * 128 + v0;
      unsigned gw[8] = {g0.x, g0.y, g0.z, g0.w, g1.x, g1.y, g1.z, g1.w};
      unsigned w[8];
#pragma unroll
      for (int j = 0; j < 4; ++j) { const f32x4 gg = *(const f32x4*)(gn + 4 * j);
          const float y0 = x[j][0] * rs * gg[0] * __uint_as_float(gw[2 * j] << 16), y1 = x[j][1] * rs * gg[1] * __uint_as_float(gw[2 * j] & 0xffff0000u);
          const float y2 = x[j][2] * rs * gg[2] * __uint_as_float(gw[2 * j + 1] << 16), y3 = x[j][3] * rs * gg[3] * __uint_as_float(gw[2 * j + 1] & 0xffff0000u);
          w[2 * j] = cvt_pk_bf16(y0, y1); w[2 * j + 1] = cvt_pk_bf16(y2, y3); }
      bf16* Y = YMIXP(F) + tok * DM + 512 + h * 128 + v0;
      *(u32x4*)Y = (u32x4){w[0], w[1], w[2], w[3]}; *(u32x4*)(Y + 8) = (u32x4){w[4], w[5], w[6], w[7]}; }
    HG_BAR();
}
__device__ __forceinline__ void phase_pass3(const Frame& F, ARGS_T& A, int l) {
    Raw R; if (F.bid < 2048) load_raw<true>(F, F.bid, R);
    for (int U = F.bid; U < 2048; U += F.G) pass3_unit(F, A, l, U, R, U + F.G);
}
}
#define DEBUG_AFTER_PHASE(p) do{}while(0)
#define DEBUG_BEFORE_PHASE(p) do{}while(0)
#define DEBUG_FINAL() do{}while(0)
#ifndef DUP_B
#define DUP_B 1
#endif
#ifndef DUP_F
#define DUP_F 1
#endif
#ifndef DUP_G
#define DUP_G 1
#endif
#ifndef DUP_K
#define DUP_K 1
#endif
#ifndef DUP_LN1
#define DUP_LN1 1
#endif
#ifndef DUP_PRO
#define DUP_PRO 1
#endif
#ifndef DUP_BAR
#define DUP_BAR 1
#endif
#ifndef DUP_D
#define DUP_D 1
#endif
#ifndef DUP_HG1
#define DUP_HG1 1
#endif
#ifndef DUP_HG3
#define DUP_HG3 1
#endif
#ifndef DUP_FOX
#define DUP_FOX 1
#endif
#ifndef DUP_BAR
#define DUP_BAR 1
#endif
#ifndef DUP_DIFF
#define DUP_DIFF 1
#endif
#ifndef MK_N_LAUNCHES
#define MK_N_LAUNCHES 1
#endif

__global__ void __launch_bounds__(NTHR, 2) mk_fwd(Args args) {
    extern __shared__ __attribute__((aligned(16))) unsigned char lds_raw[];
    Frame F;
    F.lds = (LAS unsigned char*)lds_raw; F.ws = args.ws; F.ctl = (gu32*)(args.ws + WS_CTL); F.out = args.out;
    F.tid = threadIdx.x; F.lane = F.tid & 63; F.wave = __builtin_amdgcn_readfirstlane(F.tid >> 6); F.G = gridDim.x; F.bid = blockIdx.x;
    volatile LAS unsigned* MISC = (volatile LAS unsigned*)(F.lds + MISC_OFF);
    if (F.tid < 32) MISC[F.tid] = 0u;
    __syncthreads();
    const int lo = args.ph_lo, hi = args.ph_hi;
    XcdBarrier bar; bar.bar = (unsigned*)(F.ctl + CW_BAR); bar.x = 0; bar.st = nullptr;
    if (hi - lo > 1) bar = xcd_barrier_post((unsigned*)(F.ctl + CW_BAR), MISC + 8);
#ifdef ONLY_PH
#define IN(k) (((k) == 0 ? 0 : ((k) - 1) % NPH_L + 1) == ONLY_PH && lo <= (k) && (k) < hi)
#else
#define IN(k) (lo <= (k) && (k) < hi)
#endif
#if defined(TS_REPORT) || defined(TS_DELAY)
#define TS_STAMP(k) do { if (F0.bid == 0 && threadIdx.x == 0) __hip_atomic_store((unsigned*)(F0.ctl + 20000 + (k)), (unsigned)__builtin_amdgcn_s_memrealtime(), RLX_AGENT); } while (0)
#define SEAM(k) do { if ((k) + 1 < hi) { XcdBarrier b2_ = bar; asm volatile("" : "+s"(b2_.bar)); xcd_barrier(b2_); } TS_STAMP((k) + 1); } while (0)
#else
#define TS_STAMP(k) do {} while (0)
#define SEAM(k) do { if ((k) + 1 < hi) { XcdBarrier b2_ = bar; asm volatile("" : "+s"(b2_.bar)); for (int rb_ = 0; rb_ < DUP_BAR; ++rb_) xcd_barrier(b2_); } } while (0)
#endif
    ARGS_T* Ap = (ARGS_T*)__builtin_amdgcn_kernarg_segment_ptr();
#define A (*Ap)
    const Frame F0 = F;
#define FRESH() do { F = F0; int t_ = threadIdx.x; asm volatile("" : "+v"(t_)); F.tid = t_; F.lane = t_ & 63; Ap = (ARGS_T*)__builtin_amdgcn_kernarg_segment_ptr(); asm volatile("" : "+s"(Ap)); GAS unsigned char* w_ = Ap->ws; asm volatile("" : "+s"(w_)); F.ws = w_; F.ctl = (gu32*)(w_ + WS_CTL); GAS float* o_ = Ap->out; asm volatile("" : "+s"(o_)); F.out = o_; } while (0)
    TS_STAMP(0);
    if (IN(0)) { FRESH(); for (int rep_ = 0; rep_ < DUP_PRO; ++rep_) phase_prologue(F, A); SEAM(0); }
#pragma clang loop unroll(full)
    for (int l = 0; l < 2; ++l) {
        const int pb = 1 + NPH_L * l;
        if (IN(pb + 0)) { FRESH();
            fox_cumsum(F);
            pg8::ProjOrder S{(const char*)WSP(bf16, WS_R1), (const char*)WSP(bf16, WS_WIN), F.G, F.bid};
            pg8::EpiProj E{WSP(bf16, WS_PA), WSP(bf16, WS_HQ), WSP(bf16, WS_HI), WSP(bf16, WS_HG), WSP(bf16, WS_KMEM), WSP(bf16, WS_VT), WSP(float, WS_HF), (unsigned*)(F.ctl + CW_NRM + l * 128)};
#ifdef PROBE_PART_B
            { pg8::EpiPart<PROBE_PART_B> EN{WSP(bf16, WS_PA)}; pg8::gemm_phase<pg8::EpiPart<PROBE_PART_B>, pg8::ProjOrder, false, true>(F.lds + RING_OFF, DM, DM, DM, S, EN); }
#endif
#ifdef PROBE_NULL_B
            { pg8::EpiNull EN{WSP(float, WS_ST)}; pg8::gemm_phase<pg8::EpiNull, pg8::ProjOrder, false, true>(F.lds + RING_OFF, DM, DM, DM, S, EN); }
#endif
#ifdef PROBE_CLK
            const unsigned long long pc0_ = __builtin_readcyclecounter(), pr0_ = __builtin_amdgcn_s_memrealtime();
#endif
#ifdef PROBE_IMB
            const unsigned long long q0_ = __builtin_amdgcn_s_memrealtime();
            pg8::gemm_phase<pg8::EpiProj, pg8::ProjOrder, false, true>(F.lds + RING_OFF, DM, DM, DM, S, E);
            if (l == 0 && threadIdx.x == 0) { const unsigned d_ = (unsigned)(__builtin_amdgcn_s_memrealtime() - q0_);
                atomicMax((unsigned*)(F.ctl + CW_DBG), d_); atomicMax((unsigned*)(F.ctl + CW_DBG + 1), 1000000u - d_); atomicMax((unsigned*)(F.ctl + CW_DBG + 2), (d_ << 8) | (unsigned)F.bid); atomicMax((unsigned*)(F.ctl + CW_DBG + 3), ((1000000u - d_) << 8) | (unsigned)F.bid); }
            SEAM(pb + 0);
            if (l == 0 && F.bid == 0 && threadIdx.x == 0) {
                const unsigned mx_ = __hip_atomic_load((unsigned*)(F.ctl + CW_DBG), RLX_AGENT), mn_ = 1000000u - __hip_atomic_load((unsigned*)(F.ctl + CW_DBG + 1), RLX_AGENT);
                const unsigned bmx_ = __hip_atomic_load((unsigned*)(F.ctl + CW_DBG + 2), RLX_AGENT) & 255u, bmn_ = __hip_atomic_load((unsigned*)(F.ctl + CW_DBG + 3), RLX_AGENT) & 255u;
                const unsigned long long v_ = PROBE_IMB == 1 ? (unsigned long long)(mx_ - mn_) * 10ull : PROBE_IMB == 2 ? (unsigned long long)mx_ * 5ull : PROBE_IMB == 3 ? (unsigned long long)bmx_ * 1000ull : PROBE_IMB == 4 ? (unsigned long long)mn_ * 5ull : (unsigned long long)bmn_ * 1000ull;
                const unsigned long long until = __builtin_amdgcn_s_memrealtime() + v_;
                while (__builtin_amdgcn_s_memrealtime() < until) __builtin_amdgcn_s_sleep(32); }
            if (0) {
#elif defined(PROBE_GT) && !defined(PROBE_GD)
            unsigned long long pt_[6] = {0ull, 0ull, 0ull, 0ull, 0ull, 0ull}; unsigned long long pt3_[3] = {0ull, 0ull, 0ull};
            pg8::gemm_phase<pg8::EpiProj, pg8::ProjOrder, false, true>(F.lds + RING_OFF, DM, DM, DM, S, E, pt_);
            if (l == 0 && F.bid == PROBE_BID && threadIdx.x == 0) { const unsigned long long v_ = PROBE_GT == 1 ? pt_[0] : (PROBE_GT == 2 ? pt_[1] : pt_[2]);
                const unsigned long long until = __builtin_amdgcn_s_memrealtime() + v_ * (unsigned long long)PROBE_SCALE;
                while (__builtin_amdgcn_s_memrealtime() < until) __builtin_amdgcn_s_sleep(32); }
#else
            for (int rep_ = 0; rep_ < DUP_B; ++rep_) { pg8::gemm_phase<pg8::EpiProj, pg8::ProjOrder, false, true>(F.lds + RING_OFF, DM, DM, DM, S, E); }
#endif
#ifdef PROBE_IMB
            }
#endif
#ifdef PROBE_CLK
            if (l == 0) { const unsigned long long pc1_ = __builtin_readcyclecounter(), pr1_ = __builtin_amdgcn_s_memrealtime();
                if (F.bid == 0 && threadIdx.x == 0) { const float cpt = (float)(pc1_ - pc0_) / (float)(pr1_ - pr0_);
                    const unsigned steps = (unsigned)(cpt + 0.5f); const unsigned long long until = pr1_ + (unsigned long long)steps * 10000ull;
                    while (__builtin_amdgcn_s_memrealtime() < until) __builtin_amdgcn_s_sleep(32); } }
#endif
            SEAM(pb + 0);
        }
        if (IN(pb + 1)) { FRESH(); for (int rep_ = 0; rep_ < DUP_HG1; ++rep_) hg::phase_pass1(F, A, l); TS_STAMP(100 + l); for (int rep_ = 0; rep_ < DUP_FOX; ++rep_) att::attn_phase<0>(F, A, l); SEAM(pb + 1); }
        if (IN(pb + 2)) { FRESH();
            const int skip = F.G >= 64 ? 32 : 0;
            if (F.bid < 32) { pg8::MemKVOrder S{(const char*)WSP(bf16, WS_MEMB), (const char*)WSP(bf16, WS_WK), (const char*)WSP(bf16, WS_WV), F.bid};
                pg8::EpiProj E{WSP(bf16, WS_PA), WSP(bf16, WS_HQ), WSP(bf16, WS_HI), WSP(bf16, WS_HG), WSP(bf16, WS_KMEM), WSP(bf16, WS_VT), WSP(float, WS_HF), (unsigned*)(F.ctl + CW_NRM + l * 128)};
                pg8::gemm_phase<pg8::EpiProj, pg8::MemKVOrder, false, true>(F.lds + RING_OFF, DM, DM, DM, S, E); }
            hg::phase_scan(F, skip); SEAM(pb + 2); }
        if (IN(pb + 3)) { FRESH(); for (int rep_ = 0; rep_ < DUP_HG3; ++rep_) hg::phase_pass3(F, A, l); TS_STAMP(110 + l);
#ifdef ABL_DIFF
            att::attn_phase<1, ABL_DIFF>(F, A, l);
#endif
            for (int rep_ = 0; rep_ < DUP_DIFF; ++rep_) att::attn_phase<1>(F, A, l); SEAM(pb + 3); }
        if (IN(pb + 4)) { FRESH();
            pg8::DenseOrder S{(const char*)YMIXP(F), (const char*)WSP(bf16, WS_WOUT), DM, DM, MTOK / 256, 4, F.G, F.bid};
            pg8::EpiRes E{WSP(bf16, WS_R1), PREP(F)};
#ifdef PROBE_GD
            unsigned long long pt_[6] = {0ull, 0ull, 0ull, 0ull, 0ull, 0ull}; const unsigned long long qd0_ = __builtin_amdgcn_s_memrealtime();
            pg8::gemm_phase<pg8::EpiRes, pg8::DenseOrder, false, true>(F.lds + RING_OFF, DM, DM, DM, S, E, pt_);
            const unsigned long long qd1_ = __builtin_amdgcn_s_memrealtime();
            SEAM(pb + 4);
            if (l == 0 && F.bid == PROBE_BID && threadIdx.x == 0) { const unsigned long long qd2_ = __builtin_amdgcn_s_memrealtime();
                const unsigned long long v_ = PROBE_GD == 1 ? pt_[0] : PROBE_GD == 2 ? pt_[1] : PROBE_GD == 4 ? pt_[3] : PROBE_GD == 5 ? pt_[4] : PROBE_GD == 6 ? qd1_ - qd0_ : qd2_ - qd1_;
                const unsigned long long until = __builtin_amdgcn_s_memrealtime() + v_ * (unsigned long long)PROBE_SCALE;
                while (__builtin_amdgcn_s_memrealtime() < until) __builtin_amdgcn_s_sleep(32); }
#else
            for (int rep_ = 0; rep_ < DUP_D; ++rep_) { pg8::gemm_phase<pg8::EpiRes, pg8::DenseOrder, false, true>(F.lds + RING_OFF, DM, DM, DM, S, E); }
            SEAM(pb + 4);
#endif
        }
        if (IN(pb + 5)) { FRESH(); for (int rep_ = 0; rep_ < DUP_LN1; ++rep_) phase_ln1(F, A, l); SEAM(pb + 5); }
        if (IN(pb + 6)) { FRESH();
            { pg8::DenseOrder S{(const char*)WSP(bf16, WS_R1), (const char*)WSP(bf16, WS_WQ), DM, DM, MTOK / 256, 4, F.G, F.bid};
              pg8::EpiBf16 E{WSP(bf16, WS_Q), DM, pg8::C2_MEM};
              for (int rep_ = 0; rep_ < DUP_F; ++rep_) { pg8::gemm_phase<pg8::EpiBf16, pg8::DenseOrder, false, true>(F.lds + RING_OFF, DM, DM, DM, S, E); } }
            VM_WAIT(); __syncthreads();
            { pg8::XattnOrder S{(const char*)WSP(bf16, WS_Q), (const char*)WSP(bf16, WS_KMEM), 0, F.G, F.bid};
              pg8::EpiSoftmax E{WSP(bf16, WS_PATT), F.lds + XCH_OFF};
              for (int rep_ = 0; rep_ < DUP_G; ++rep_) { pg8::gemm_phase<pg8::EpiSoftmax, pg8::XattnOrder, false, true>(F.lds + RING_OFF, DM, DM, 256, S, E); } }
            VM_WAIT(); __syncthreads();
            { pg8::XattnOrder S{(const char*)WSP(bf16, WS_PATT), (const char*)WSP(bf16, WS_VT), 1, F.G, F.bid};
              pg8::EpiBf16 E{WSP(bf16, WS_OATT), DM, 1.f};
              for (int rep_ = 0; rep_ < DUP_G; ++rep_) { pg8::gemm_phase<pg8::EpiBf16, pg8::XattnOrder, false, true>(F.lds + RING_OFF, DM, DM, 256, S, E); } }
            SEAM(pb + 6);
        }
        if (IN(pb + 9)) { FRESH();
            pg8::DenseOrder S{(const char*)WSP(bf16, WS_OATT), (const char*)WSP(bf16, WS_WO), DM, DM, MTOK / 256, 4, F.G, F.bid};
            pg8::EpiRes E{WSP(bf16, WS_R1), PREP(F)};
            for (int rep_ = 0; rep_ < DUP_D; ++rep_) { pg8::gemm_phase<pg8::EpiRes, pg8::DenseOrder, false, true>(F.lds + RING_OFF, DM, DM, DM, S, E); }
            SEAM(pb + 9);
        }
        if (IN(pb + 10)) { FRESH(); phase_ln2_route(F, A, l); SEAM(pb + 10); }
        if (IN(pb + 11)) { FRESH();
            moe_tables(F, l);
            pg8::MoeOrder S{(const char*)WSP(bf16, WS_R1), (const char*)WSP(bf16, WS_W13), WSP(int, WS_LIST), (const LAS int*)(F.lds + TAB_OFF), 0, F.G, F.bid};
            pg8::EpiSwiGLU E{WSP(bf16, WS_HID)};
            for (int rep_ = 0; rep_ < DUP_K; ++rep_) { pg8::gemm_phase<pg8::EpiSwiGLU, pg8::MoeOrder, true, true>(F.lds + RING_OFF, DM, DM, DM, S, E); }
            SEAM(pb + 11);
        }
        if (IN(pb + 12)) { FRESH();
            moe_tables(F, l);
            pg8::MoeOrder S{(const char*)WSP(bf16, WS_HID), (const char*)WSP(bf16, WS_W2), WSP(int, WS_LIST), (const LAS int*)(F.lds + TAB_OFF), 1, F.G, F.bid};
            pg8::EpiMoeOut E{WSP(bf16, WS_CB), WSP(float, WS_GATE)};
            for (int rep_ = 0; rep_ < DUP_K; ++rep_) { pg8::gemm_phase<pg8::EpiMoeOut, pg8::MoeOrder, false, true>(F.lds + RING_OFF, EFF, EFF, EFF, S, E); }
            SEAM(pb + 12);
        }
        if (IN(pb + 13)) { FRESH(); phase_ln3(F, A, l); SEAM(pb + 13); }
    }
#ifdef TS_DELAY
    if (F0.bid == 0 && threadIdx.x == 0) { constexpr int ka = TS_DELAY; unsigned tot = 0;
        for (int l = 0; l < 2 && ka < 20; ++l) { const int pa = ka == 0 ? 0 : 1 + NPH_L * l + ka - 1; if (ka != 0 || l == 0) tot += __hip_atomic_load((unsigned*)(F0.ctl + 20000 + pa + 1), RLX_AGENT) - __hip_atomic_load((unsigned*)(F0.ctl + 20000 + (ka == 10 ? pa - 2 : pa)), RLX_AGENT); }
        if (ka == 20) tot = (__hip_atomic_load((unsigned*)(F0.ctl + 20100), RLX_AGENT) - __hip_atomic_load((unsigned*)(F0.ctl + 20000 + 2), RLX_AGENT)) + (__hip_atomic_load((unsigned*)(F0.ctl + 20101), RLX_AGENT) - __hip_atomic_load((unsigned*)(F0.ctl + 20000 + 2 + NPH_L), RLX_AGENT));
        if (ka == 21) tot = (__hip_atomic_load((unsigned*)(F0.ctl + 20110), RLX_AGENT) - __hip_atomic_load((unsigned*)(F0.ctl + 20000 + 4), RLX_AGENT)) + (__hip_atomic_load((unsigned*)(F0.ctl + 20111), RLX_AGENT) - __hip_atomic_load((unsigned*)(F0.ctl + 20000 + 4 + NPH_L), RLX_AGENT));
        if (ka >= 30 && ka < 30 + NPHASE) tot = __hip_atomic_load((unsigned*)(F0.ctl + 20000 + (ka - 30) + 1), RLX_AGENT) - __hip_atomic_load((unsigned*)(F0.ctl + 20000 + (ka - 30)), RLX_AGENT);
        if (ka == 99) tot = __hip_atomic_load((unsigned*)(F0.ctl + 20000 + NPHASE), RLX_AGENT) - __hip_atomic_load((unsigned*)(F0.ctl + 20000), RLX_AGENT);
        const unsigned long long until = __builtin_amdgcn_s_memrealtime() + (unsigned long long)tot * (unsigned long long)TS_SCALE;
        while (__builtin_amdgcn_s_memrealtime() < until) __builtin_amdgcn_s_sleep(32); }
#endif
#undef IN
#undef SEAM
#undef A
}

#ifdef TS_REPORT
__global__ void ts_encode(float* out, unsigned char* ws) {
    const unsigned* T = (const unsigned*)(ws + WS_CTL) + 20000; constexpr int ka = TS_REPORT; float ta = 0.f;
    for (int l = 0; l < 2; ++l) { const int pa = ka == 0 ? 0 : 1 + NPH_L * l + ka - 1; if (ka != 0 || l == 0) ta += 0.01f * (float)(T[pa + 1] - T[pa]); }
    const float c = sqrtf(ta * 0.1f);
    for (size_t i = (size_t)blockIdx.x * 256 + threadIdx.x; i < (size_t)MTOK * DM; i += (size_t)gridDim.x * 256) out[i] = c;
}
#endif
extern "C" void kernel_launch(void* const* d_in, const int* in_sizes, int n_in, void* d_out, int out_size, void* d_ws, size_t ws_size, hipStream_t stream) {
    static int grid = 0;
    if (grid == 0) {
        if (n_in != 25 || out_size != MTOK * DM || ws_size < WS_END) { fprintf(stderr, "kernel_launch: unexpected problem (n_in %d, out %d, ws %zu)\n", n_in, out_size, ws_size); grid = -1; return; }
        int dev = 0, cus = 0, per_cu = 0;
        if (hipGetDevice(&dev) != hipSuccess || hipDeviceGetAttribute(&cus, hipDeviceAttributeMultiprocessorCount, dev) != hipSuccess) { grid = -1; return; }
        if (hipFuncSetAttribute((const void*)mk_fwd, hipFuncAttributeMaxDynamicSharedMemorySize, LDS_BYTES) != hipSuccess) { fprintf(stderr, "kernel_launch: hipFuncSetAttribute failed\n"); grid = -1; return; }
        if (hipOccupancyMaxActiveBlocksPerMultiprocessor(&per_cu, (const void*)mk_fwd, NTHR, LDS_BYTES) != hipSuccess || per_cu < 1) fprintf(stderr, "kernel_launch: occupancy query says %d\n", per_cu);
        (void)hipGetLastError();
        grid = cus < 256 ? cus : 256;
    }
    if (grid < 0) return;
    (void)hipMemsetAsync((char*)d_ws + WS_CTL, 0, CTL_ZERO_BYTES, stream);
    Args a{};
    for (int i = 0; i < 25; ++i) a.in[i] = (const GAS float*)d_in[i];
    a.out = (GAS float*)d_out; a.ws = (GAS unsigned char*)d_ws;
#if MK_N_LAUNCHES == 1
    a.ph_lo = 0; a.ph_hi = NPHASE;
    hipLaunchKernelGGL(mk_fwd, dim3(grid), dim3(NTHR), LDS_BYTES, stream, a);
#ifdef TS_REPORT
    hipLaunchKernelGGL(ts_encode, dim3(1024), dim3(256), 0, stream, (float*)d_out, (unsigned char*)d_ws);
#endif
#else
    for (int p = 0; p < NPHASE; ++p) { DEBUG_BEFORE_PHASE(p); a.ph_lo = p; a.ph_hi = p + 1; hipLaunchKernelGGL(mk_fwd, dim3(grid), dim3(NTHR), LDS_BYTES, stream, a);
        DEBUG_AFTER_PHASE(p); }
    DEBUG_FINAL();
#endif
}
```

```cpp
#include <hip/hip_runtime.h>
#include <cstdio>
#include <cstdint>

#define GAS __attribute__((address_space(1)))
#define LAS __attribute__((address_space(3)))
typedef unsigned short bf16;
typedef short bf16x8 __attribute__((ext_vector_type(8)));
typedef short s16x4 __attribute__((ext_vector_type(4)));
typedef float f32x4 __attribute__((ext_vector_type(4)));
typedef float f32x2 __attribute__((ext_vector_type(2)));
typedef float f32x16 __attribute__((ext_vector_type(16)));
typedef unsigned u32x4 __attribute__((ext_vector_type(4)));
typedef unsigned u32x2 __attribute__((ext_vector_type(2)));
typedef GAS unsigned gu32;
#define RLX_AGENT __ATOMIC_RELAXED, __HIP_MEMORY_SCOPE_AGENT
#define LDS_WAIT() asm volatile("s_waitcnt lgkmcnt(0)" ::: "memory")
#define VM_WAIT() asm volatile("s_waitcnt vmcnt(0)" ::: "memory")

constexpr int DM = 1024, NB = 4, SEQ = 8192, MTOK = NB * SEQ;
constexpr int NIN = 3584;
constexpr int INW = 3588;
constexpr int NEXP = 16, EFF = 512;
constexpr float LN_EPS = 1e-5f;
constexpr float ALPHA = 1.4142135623730951f;
constexpr float LOG2E = 1.4426950408889634f;
constexpr int PA_LD = 1536;
constexpr int NWAVES = 8, NTHR = 512;

constexpr size_t MiB = 1u << 20;
constexpr size_t WS_CTL = 0, CTL_ZERO_BYTES = 1 * MiB;
constexpr size_t WS_CUMF = 1 * MiB;
constexpr size_t WS_LF2 = 1 * MiB + 512 * 1024;
constexpr size_t WS_LIST = 2 * MiB;
constexpr size_t WS_GATE = 4 * MiB;
constexpr size_t WS_HDEC = 4 * MiB + 512 * 1024;
constexpr size_t WS_MEMB = 6 * MiB;
constexpr size_t WS_KMEM = 8 * MiB;
constexpr size_t WS_VT = 10 * MiB;
constexpr size_t WS_WIN = 16 * MiB, WS_WOUT = 23 * MiB, WS_WQ = 25 * MiB, WS_WK = 27 * MiB, WS_WV = 29 * MiB, WS_WO = 31 * MiB, WS_W13 = 33 * MiB, WS_W2 = 65 * MiB;
constexpr size_t WS_R1 = 81 * MiB;
constexpr size_t WS_BIG = 145 * MiB;
constexpr size_t WS_PA = WS_BIG, WS_HQ = WS_BIG + 96 * MiB, WS_HI = WS_BIG + 128 * MiB, WS_HG = WS_BIG + 160 * MiB, WS_HF = WS_BIG + 192 * MiB, WS_ST = WS_BIG + 256 * MiB;
constexpr size_t WS_Q = WS_BIG, WS_PATT = WS_BIG + 64 * MiB, WS_OATT = WS_BIG + 128 * MiB;
constexpr size_t WS_HID = WS_BIG, WS_CB = WS_BIG + 68 * MiB;
constexpr size_t WS_END = WS_BIG + 320 * MiB;
static_assert(WS_CB + (size_t)MTOK * 2 * DM * 2 <= WS_END, "ws map");
constexpr int CW_TMO = 0, CW_CODE = 1, CW_BAR = 4096, CW_ECNT = 8192  , CW_DBG = 16384, CW_NRM = 12288  ;

__device__ __forceinline__ unsigned cvt_pk_bf16(float lo, float hi) { typedef __bf16 bf2 __attribute__((ext_vector_type(2))); f32x2 v = {lo, hi}; bf2 b = __builtin_convertvector(v, bf2); return __builtin_bit_cast(unsigned, b); }
__device__ __forceinline__ bf16 f2bf(float f) { return (bf16)(cvt_pk_bf16(f, 0.f) & 0xffffu); }
__device__ __forceinline__ float bf2f(bf16 b) { return __uint_as_float(((unsigned)b) << 16); }
__device__ __forceinline__ float wave_sum(float v) {
#pragma unroll
    for (int o = 1; o < 64; o <<= 1) v += __shfl_xor(v, o);
    return v;
}
__device__ __forceinline__ float fast_exp2(float x) { return __builtin_amdgcn_exp2f(x); }
__device__ __forceinline__ float fast_rcp(float x) { return __builtin_amdgcn_rcpf(x); }
__device__ __forceinline__ float sigmoidf_(float x) { return fast_rcp(1.f + fast_exp2(-x * LOG2E)); }
__device__ __forceinline__ float siluf_(float x) { return x * sigmoidf_(x); }
__device__ __forceinline__ float log_sigmoidf_(float x) { return fminf(x, 0.f) - log1pf(__expf(-fabsf(x))); }
constexpr int NPH_L = 14, NPHASE = 1 + 2 * NPH_L;
namespace pg8 {
constexpr int BM = 256, BK = 64, HALF = 128, HTB = HALF * BK * 2, STAGE_BYTES = 8 * HTB, NXCD = 8, WGM = 8;
__host__ __device__ __forceinline__ int lds_byte(int r, int c) { const int st = (r >> 4) * 2 + (c >> 5), rr = r & 15, cc = c & 31, ob = rr * 64 + cc * 2; return st * 1024 + (ob ^ (((ob >> 9) & 1) << 5)); }
__host__ __device__ __forceinline__ void stage_rc(int b, int& R, int& C) { const int st = b / 1024, sb = b % 1024, swz = sb ^ (((sb >> 9) & 1) << 5); R = (st >> 1) * 16 + swz / 64; C = (st & 1) * 32 + (swz % 64) / 2; }
__host__ __device__ __forceinline__ int perm32(int rho) { const int n = rho >> 4, i = rho & 15; return 8 * (i >> 2) + 4 * n + (i & 3); }

struct Unit { const char* a; const char* b; const int* rl; int pm, pn, nv, e; };

__device__ __forceinline__ void tile_of(int L, int nM, int nN, int& pm, int& pn) {
    const int nwg = nM * nN; int wgid = L; { const int q = nwg / NXCD, r = nwg % NXCD, xcd = wgid % NXCD, off = wgid / NXCD; wgid = (xcd < r ? xcd * (q + 1) : r * (q + 1) + (xcd - r) * q) + off; }
    const int nig = WGM * nN, gid = wgid / nig, fm = gid * WGM, gsz = (nM - fm) < WGM ? (nM - fm) : WGM;
    pm = fm + ((wgid % nig) % gsz); pn = (wgid % nig) / gsz;
}

template <class Epi, class Sched, bool GATHER, bool ALIGN_EPI>
__device__ __forceinline__ void gemm_phase(LAS unsigned char* lds, const int lda, const int ldb, const int K, const Sched& S, const Epi& E, unsigned long long* PT = nullptr) {
#ifdef PROBE_GT
#define PG8_RT(x) do { x = __builtin_amdgcn_s_memrealtime(); asm volatile("s_waitcnt lgkmcnt(0)" ::: "memory"); } while (0)
    unsigned long long ps0_ = 0, ps1_ = 0, ps2_ = 0, ps3_ = 0, pe_ = 0; bool pfirst_ = true;
    PG8_RT(pe_);
#endif
    int tid = threadIdx.x; asm volatile("" : "+v"(tid));
    const int wid = __builtin_amdgcn_readfirstlane(tid >> 6), lane = tid & 63, wr = wid >> 2, wc = wid & 3, fr = lane & 15, fq = lane >> 4;
    const int nt = K / BK;
    unsigned vB[2];
#pragma unroll
    for (int i = 0; i < 2; ++i) { int R, C; stage_rc(tid * 16 + i * 8192, R, C); const int Rb = Epi::PERM ? ((R & ~31) + perm32(R & 31)) : R; vB[i] = (unsigned)(Rb * ldb + C) * 2u; }
    const size_t kstep = (size_t)(BK * 2);
    const size_t hstepB = (size_t)HALF * ldb * 2;
    const unsigned ldsw = (unsigned)wid * 1024u;
    const int aoff = lds_byte(wr * 64 + fr, fq * 8), boff = lds_byte(wc * 32 + fr, fq * 8);
#define PG8_SA(b, h) (((b) * 2 + (h)) * HTB)
#define PG8_SB(b, h) ((4 + (b) * 2 + (h)) * HTB)
#define PG8_STAGE2(bufoff, gbase, v0, v1) do { \
        __builtin_amdgcn_global_load_lds((const unsigned*)((const char*)(gbase) + (v0)), (LAS unsigned*)(lds + (bufoff) + ldsw), 16, 0, 0); \
        __builtin_amdgcn_global_load_lds((const unsigned*)((const char*)(gbase) + (v1)), (LAS unsigned*)(lds + (bufoff) + ldsw + 8192), 16, 0, 0); } while (0)
#define PG8_STAGEB(bufoff, gbase) PG8_STAGE2(bufoff, gbase, vB[0], vB[1])
#define PG8_LDA(dst, b, h) do { _Pragma("unroll") for (int m = 0; m < 4; ++m) _Pragma("unroll") for (int k = 0; k < 2; ++k) dst[m][k] = *(const LAS bf16x8*)(lds + PG8_SA(b, h) + aoff + m * 2048 + k * 1024); } while (0)
#define PG8_LDB(dst, b, h) do { _Pragma("unroll") for (int n = 0; n < 2; ++n) _Pragma("unroll") for (int k = 0; k < 2; ++k) dst[n][k] = *(const LAS bf16x8*)(lds + PG8_SB(b, h) + boff + n * 2048 + k * 1024); } while (0)
#define PG8_MMA(ai, bj, At, Bt) do { __builtin_amdgcn_s_setprio(1); _Pragma("unroll") for (int m = 0; m < 4; ++m) _Pragma("unroll") for (int n = 0; n < 2; ++n) _Pragma("unroll") for (int k = 0; k < 2; ++k) \
        acc[ai][bj][m][n] = __builtin_amdgcn_mfma_f32_16x16x32_bf16(Bt[n][k], At[m][k], acc[ai][bj][m][n], 0, 0, 0); __builtin_amdgcn_s_setprio(0); } while (0)
#define PG8_WAIT_V(n) asm volatile("s_waitcnt vmcnt(" #n ")" ::: "memory")
#define PG8_WAIT_L(n) asm volatile("s_waitcnt lgkmcnt(" #n ")" ::: "memory")
#define PG8_BAR __builtin_amdgcn_s_barrier()
#define PG8_SCHED __builtin_amdgcn_sched_barrier(0)
    Unit cur, nxt; int ui = 0;
    if (!S.next(0, cur)) return;
    unsigned vA[2][2], nvA[2][2];
#define PG8_AOFFS(dst, u) do { int t2_ = tid; if constexpr (GATHER) asm volatile("" : "+v"(t2_)); _Pragma("unroll") for (int i_ = 0; i_ < 2; ++i_) { int R_, C_; stage_rc(t2_ * 16 + i_ * 8192, R_, C_); \
        _Pragma("unroll") for (int h_ = 0; h_ < 2; ++h_) { \
        if constexpr (GATHER) { int rr_ = h_ * HALF + R_; rr_ = rr_ < (u).nv ? rr_ : (u).nv - 1; const int tok_ = (u).rl[rr_] >> 1; dst[h_][i_] = (unsigned)(tok_ * lda + C_) * 2u; } \
        else dst[h_][i_] = (unsigned)((h_ * HALF + R_) * lda + C_) * 2u; } } } while (0)
    PG8_AOFFS(vA, cur);
    f32x4 acc[2][2][4][2];
#pragma unroll
    for (int a = 0; a < 2; ++a)
#pragma unroll
        for (int b = 0; b < 2; ++b)
#pragma unroll
            for (int m = 0; m < 4; ++m)
#pragma unroll
                for (int n = 0; n < 2; ++n) acc[a][b][m][n] = (f32x4){0.f, 0.f, 0.f, 0.f};
    bf16x8 At[4][2], B0[2][2], B1[2][2];
    const char* cA = cur.a; const char* cB = cur.b;
    PG8_STAGEB(PG8_SB(0, 0), cB); PG8_STAGEB(PG8_SB(0, 1), cB + hstepB); PG8_STAGE2(PG8_SA(0, 0), cA, vA[0][0], vA[0][1]); PG8_STAGE2(PG8_SA(0, 1), cA, vA[1][0], vA[1][1]);
    if (wr == 1) PG8_BAR;
    PG8_WAIT_V(2); PG8_BAR;
    PG8_STAGEB(PG8_SB(1, 0), cB + kstep); PG8_STAGE2(PG8_SA(1, 0), cA + kstep, vA[0][0], vA[0][1]); PG8_STAGEB(PG8_SB(1, 1), cB + hstepB + kstep);
    PG8_WAIT_V(6); PG8_BAR;
    for (;;) {
        const bool has_next = S.next(ui + 1, nxt);
        const char* nA = has_next ? nxt.a : cA; const char* nB = has_next ? nxt.b : cB;
        if constexpr (GATHER) { if (has_next) { PG8_AOFFS(nvA, nxt); } else {
#pragma unroll
            for (int h_ = 0; h_ < 2; ++h_)
#pragma unroll
                for (int i_ = 0; i_ < 2; ++i_) nvA[h_][i_] = vA[h_][i_]; } }
#ifdef PROBE_GT
        PG8_RT(ps0_);
        if (pfirst_ && PT) { PT[3] += ps0_ - pe_; pfirst_ = false; }
#endif
#pragma nounroll
        for (int t = 0; t < nt; t += 2) {
            const bool last = (t == nt - 2);
            const char* a1 = cA + (size_t)(t + 1) * kstep;
            const char* a2 = last ? nA : cA + (size_t)(t + 2) * kstep; const char* b2 = last ? nB : cB + (size_t)(t + 2) * kstep;
            const char* a3 = a2 + kstep; const char* b3 = b2 + kstep;
            unsigned x00, x01, x10, x11;
            if constexpr (GATHER) { x00 = last ? nvA[0][0] : vA[0][0]; x01 = last ? nvA[0][1] : vA[0][1]; x10 = last ? nvA[1][0] : vA[1][0]; x11 = last ? nvA[1][1] : vA[1][1]; }
            else { x00 = vA[0][0]; x01 = vA[0][1]; x10 = vA[1][0]; x11 = vA[1][1]; }
            PG8_LDB(B0, 0, 0); PG8_LDB(B1, 0, 1); PG8_SCHED; PG8_LDA(At, 0, 0); PG8_STAGE2(PG8_SA(1, 1), a1, vA[1][0], vA[1][1]);
            PG8_WAIT_V(8); PG8_WAIT_L(0); PG8_BAR; PG8_MMA(0, 0, At, B0); PG8_MMA(0, 1, At, B1); PG8_BAR; PG8_SCHED;
            PG8_LDA(At, 0, 1); PG8_STAGEB(PG8_SB(0, 0), b2); PG8_STAGEB(PG8_SB(0, 1), b2 + hstepB); PG8_STAGE2(PG8_SA(0, 0), a2, x00, x01);
            PG8_WAIT_V(8); PG8_WAIT_L(0); PG8_BAR; PG8_MMA(1, 0, At, B0); PG8_MMA(1, 1, At, B1); PG8_BAR; PG8_SCHED;
            PG8_LDB(B0, 1, 0); PG8_LDB(B1, 1, 1); PG8_SCHED; PG8_LDA(At, 1, 0); PG8_STAGE2(PG8_SA(0, 1), a2, x10, x11);
            PG8_WAIT_V(8); PG8_WAIT_L(0); PG8_BAR; PG8_MMA(0, 0, At, B0); PG8_MMA(0, 1, At, B1); PG8_BAR; PG8_SCHED;
            PG8_LDA(At, 1, 1); PG8_STAGEB(PG8_SB(1, 0), b3); PG8_STAGEB(PG8_SB(1, 1), b3 + hstepB); PG8_STAGE2(PG8_SA(1, 0), a3, x00, x01);
            PG8_WAIT_V(8); PG8_WAIT_L(0); PG8_BAR; PG8_MMA(1, 0, At, B0); PG8_MMA(1, 1, At, B1); PG8_BAR; PG8_SCHED;
        }
#ifdef PROBE_GT
        PG8_RT(ps1_);
#endif
        if constexpr (ALIGN_EPI) { if (wr == 0) PG8_BAR; }
        if constexpr (!Epi::AFTER_DRAIN) { int fr_ = fr, fq_ = fq; asm volatile("" : "+v"(fr_), "+v"(fq_)); E(acc, cur, wr, wc, fr_, fq_); }
#ifdef PROBE_GT
        PG8_RT(ps2_);
        if (PROBE_GT == 3 && PT) { asm volatile("s_waitcnt vmcnt(0)" ::: "memory"); PG8_RT(ps3_); }
        if (PT) { PT[0] += ps1_ - ps0_; PT[1] += ps2_ - ps1_; if (PROBE_GT == 3) PT[2] += ps3_ - ps2_; }
#endif
        if (!has_next) break;
#pragma unroll
        for (int a = 0; a < 2; ++a)
#pragma unroll
            for (int b = 0; b < 2; ++b)
#pragma unroll
                for (int m = 0; m < 4; ++m)
#pragma unroll
                    for (int n = 0; n < 2; ++n) acc[a][b][m][n] = (f32x4){0.f, 0.f, 0.f, 0.f};
        cur = nxt; cA = nA; cB = nB; ++ui;
        if constexpr (GATHER) {
#pragma unroll
            for (int h_ = 0; h_ < 2; ++h_)
#pragma unroll
                for (int i_ = 0; i_ < 2; ++i_) vA[h_][i_] = nvA[h_][i_]; }
        if constexpr (ALIGN_EPI) { if (wr == 1) PG8_BAR; }
    }
    PG8_WAIT_V(0);
    if constexpr (!ALIGN_EPI) { if (wr == 0) PG8_BAR; }
    PG8_BAR;
    if constexpr (Epi::AFTER_DRAIN) { E.fused(acc, cur, wr, wc, fr, fq, lds, wid, lane); }
#ifdef PROBE_GT
    PG8_RT(ps3_); if (PT) PT[4] += ps3_ - ps2_;
#endif
#undef PG8_AOFFS
#undef PG8_SA
#undef PG8_SB
#undef PG8_STAGE2
#undef PG8_STAGEB
#undef PG8_LDA
#undef PG8_LDB
#undef PG8_MMA
#undef PG8_WAIT_V
#undef PG8_WAIT_L
#undef PG8_BAR
#undef PG8_SCHED
}
}
constexpr int RING_OFF = 0, RING_BYTES = 131072;
constexpr int XCH_OFF = RING_BYTES;
constexpr int TAB_OFF = XCH_OFF + 8192;
constexpr int MISC_OFF = TAB_OFF + 512;
constexpr int LDS_BYTES = 147456;
static_assert(MISC_OFF + 128 <= LDS_BYTES, "LDS map");

#ifdef NT_STORES
#define ST_U4(p, v) __builtin_nontemporal_store((v), (u32x4*)(p))
#define ST_F4(p, v) __builtin_nontemporal_store((v), (f32x4*)(p))
#else
#define ST_U4(p, v) (*(u32x4*)(p) = (v))
#define ST_F4(p, v) (*(f32x4*)(p) = (v))
#endif
namespace pg8 {
template <int ACT>
__device__ __forceinline__ void tile_store_bf16(const f32x4 (&acc)[2][2][4][2], bf16* dst, int ld, float sc, int wr, int wc, int fr, int fq) {
    bf16* p0 = dst + (size_t)(wr * 64 + fr) * ld + wc * 32 + 8 * fq;
#pragma unroll
    for (int ai = 0; ai < 2; ++ai)
#pragma unroll
        for (int m = 0; m < 4; ++m) { bf16* rowp = p0 + (size_t)(ai * HALF + m * 16) * ld;
#pragma unroll
            for (int bj = 0; bj < 2; ++bj) { f32x4 v0 = acc[ai][bj][m][0], v1 = acc[ai][bj][m][1];
                if (ACT == 1) {
#pragma unroll
                    for (int i = 0; i < 4; ++i) { v0[i] = siluf_(v0[i]); v1[i] = siluf_(v1[i]); } }
                v0 = v0 * sc; v1 = v1 * sc; u32x4 w; w.x = cvt_pk_bf16(v0[0], v0[1]); w.y = cvt_pk_bf16(v0[2], v0[3]); w.z = cvt_pk_bf16(v1[0], v1[1]); w.w = cvt_pk_bf16(v1[2], v1[3]);
                ST_U4(rowp + bj * HALF, w); } }
}
__device__ __forceinline__ void tile_store_f32(const f32x4 (&acc)[2][2][4][2], float* dst, int ld, int wr, int wc, int fr, int fq) {
    float* p0 = dst + (size_t)(wr * 64 + fr) * ld + wc * 32 + 8 * fq;
#pragma unroll
    for (int ai = 0; ai < 2; ++ai)
#pragma unroll
        for (int m = 0; m < 4; ++m) { float* rowp = p0 + (size_t)(ai * HALF + m * 16) * ld;
#pragma unroll
            for (int bj = 0; bj < 2; ++bj) { ST_F4(rowp + bj * HALF, acc[ai][bj][m][0]); ST_F4(rowp + bj * HALF + 4, acc[ai][bj][m][1]); } }
}

constexpr float C2_FOX = 0.125f * LOG2E, C2_DIFF = 0.17677669529663687f * LOG2E, C2_MEM = 0.0625f * LOG2E;

struct EpiProj {
    static constexpr bool PERM = true, AFTER_DRAIN = false;
    bf16 *PA, *HQ, *HI, *HG, *KMEM, *VT; float* HF; unsigned* NRM;
    __device__ __forceinline__ void operator()(f32x4 (&acc)[2][2][4][2], const Unit& u, int wr, int wc, int fr, int fq) const {
        const size_t row0 = (size_t)u.pm * BM; const int pn = u.pn;
        if (u.e == 0) {
            if (pn < 6) { const float sc = pn == 0 ? C2_FOX : (pn == 3 ? C2_DIFF : 1.f); tile_store_bf16<0>(acc, PA + row0 * PA_LD + pn * 256, PA_LD, sc, wr, wc, fr, fq);
                if (pn != 2 && pn != 5) {
#pragma unroll
                    for (int bj = 0; bj < 2; ++bj) { float mx = 0.f;
#pragma unroll
                        for (int ai = 0; ai < 2; ++ai)
#pragma unroll
                            for (int m = 0; m < 4; ++m) { const f32x4 a = acc[ai][bj][m][0] * sc, b = acc[ai][bj][m][1] * sc; float ss = (a[0] * a[0] + a[1] * a[1]) + (a[2] * a[2] + a[3] * a[3]) + (b[0] * b[0] + b[1] * b[1]) + (b[2] * b[2] + b[3] * b[3]);
                                ss += __shfl_xor(ss, 16); ss += __shfl_xor(ss, 32); mx = fmaxf(mx, ss); }
#pragma unroll
                        for (int o = 1; o < 16; o <<= 1) mx = fmaxf(mx, __shfl_xor(mx, o));
                        if (fr == 0 && fq == 0) { const int bh = (u.pm / (SEQ / 256)) * 4 + 2 * bj + (wc >> 1); atomicMax(NRM + (((pn < 2 ? pn : pn - 1) * 16 + bh) * 2 + (wc & 1)), __float_as_uint(mx)); } } } }
            else if (pn < 8) tile_store_bf16<1>(acc, HQ + row0 * 512 + (pn - 6) * 256, 512, 1.f, wr, wc, fr, fq);
            else if (pn < 10) tile_store_f32(acc, HF + row0 * 512 + (pn - 8) * 256, 512, wr, wc, fr, fq);
            else if (pn < 12) tile_store_bf16<0>(acc, HI + row0 * 512 + (pn - 10) * 256, 512, 1.f, wr, wc, fr, fq);
            else tile_store_bf16<1>(acc, HG + row0 * 512 + (pn - 12) * 256, 512, 1.f, wr, wc, fr, fq);
        } else if (u.e == 1) tile_store_bf16<0>(acc, KMEM + row0 * 1024 + pn * 256, 1024, 1.f, wr, wc, fr, fq);
        else tile_store_bf16<0>(acc, VT + row0 * 1024 + pn * 256, 1024, 1.f, wr, wc, fr, fq);
    }
};
struct EpiNull {
    static constexpr bool PERM = true, AFTER_DRAIN = false;
    float* sink;
    __device__ __forceinline__ void operator()(f32x4 (&acc)[2][2][4][2], const Unit& u, int wr, int wc, int fr, int fq) const {
        f32x4 s = {0.f, 0.f, 0.f, 0.f};
#pragma unroll
        for (int ai = 0; ai < 2; ++ai)
#pragma unroll
            for (int bj = 0; bj < 2; ++bj)
#pragma unroll
                for (int m = 0; m < 4; ++m) { s += acc[ai][bj][m][0]; s += acc[ai][bj][m][1]; }
        if ((s[0] + s[1]) + (s[2] + s[3]) == 1234567.125f) sink[fr] = s[0];
    }
};
template <int AIS> struct EpiPart {
    static constexpr bool PERM = true, AFTER_DRAIN = false;
    bf16* O;
    __device__ __forceinline__ void operator()(f32x4 (&acc)[2][2][4][2], const Unit& u, int wr, int wc, int fr, int fq) const {
        bf16* p0 = O + ((size_t)u.pm * BM + wr * 64 + fr) * NIN + u.pn * BM + wc * 32 + 8 * fq;
#pragma unroll
        for (int ai = 0; ai < AIS; ++ai)
#pragma unroll
            for (int m = 0; m < 4; ++m) { bf16* rowp = p0 + (size_t)(ai * HALF + m * 16) * NIN;
#pragma unroll
                for (int bj = 0; bj < 2; ++bj) { const f32x4 v0 = acc[ai][bj][m][0], v1 = acc[ai][bj][m][1]; u32x4 w; w.x = cvt_pk_bf16(v0[0], v0[1]); w.y = cvt_pk_bf16(v0[2], v0[3]); w.z = cvt_pk_bf16(v1[0], v1[1]); w.w = cvt_pk_bf16(v1[2], v1[3]);
                    ST_U4(rowp + bj * HALF, w); } }
        if (AIS < 2) { f32x4 s = {0.f, 0.f, 0.f, 0.f};
#pragma unroll
            for (int bj = 0; bj < 2; ++bj)
#pragma unroll
                for (int m = 0; m < 4; ++m) { s += acc[1][bj][m][0]; s += acc[1][bj][m][1]; }
            if ((s[0] + s[1]) + (s[2] + s[3]) == 1234567.125f) O[fr] = 0; }
    }
};
struct EpiBf16 {
    static constexpr bool PERM = true, AFTER_DRAIN = false;
    bf16* O; int ld; float sc;
    __device__ __forceinline__ void operator()(f32x4 (&acc)[2][2][4][2], const Unit& u, int wr, int wc, int fr, int fq) const {
        tile_store_bf16<0>(acc, O + (size_t)u.pm * BM * ld + u.pn * BM, ld, sc, wr, wc, fr, fq);
    }
};
struct EpiRes {
    static constexpr bool PERM = true, AFTER_DRAIN = false;
    const bf16* H; bf16* PRE;
    __device__ __forceinline__ void operator()(f32x4 (&acc)[2][2][4][2], const Unit& u, int wr, int wc, int fr, int fq) const {
        const size_t o0 = ((size_t)u.pm * BM + wr * 64 + fr) * DM + u.pn * BM + wc * 32 + 8 * fq;
        u32x4 hv[2][4][2];
#pragma unroll
        for (int ai = 0; ai < 2; ++ai)
#pragma unroll
            for (int m = 0; m < 4; ++m)
#pragma unroll
                for (int bj = 0; bj < 2; ++bj) hv[ai][m][bj] = *(const u32x4*)(H + o0 + (size_t)(ai * HALF + m * 16) * DM + bj * HALF);
        __builtin_amdgcn_sched_barrier(0);
#pragma unroll
        for (int ai = 0; ai < 2; ++ai)
#pragma unroll
            for (int m = 0; m < 4; ++m) { const size_t o1 = o0 + (size_t)(ai * HALF + m * 16) * DM;
#pragma unroll
                for (int bj = 0; bj < 2; ++bj) { const u32x4 h4 = hv[ai][m][bj]; const f32x4 a = acc[ai][bj][m][0], b = acc[ai][bj][m][1]; u32x4 w;
                    w.x = cvt_pk_bf16(__uint_as_float(h4.x << 16) * ALPHA + a[0], __uint_as_float(h4.x & 0xffff0000u) * ALPHA + a[1]); w.y = cvt_pk_bf16(__uint_as_float(h4.y << 16) * ALPHA + a[2], __uint_as_float(h4.y & 0xffff0000u) * ALPHA + a[3]);
                    w.z = cvt_pk_bf16(__uint_as_float(h4.z << 16) * ALPHA + b[0], __uint_as_float(h4.z & 0xffff0000u) * ALPHA + b[1]); w.w = cvt_pk_bf16(__uint_as_float(h4.w << 16) * ALPHA + b[2], __uint_as_float(h4.w & 0xffff0000u) * ALPHA + b[3]);
                    ST_U4(PRE + o1 + bj * HALF, w); } }
    }
};
struct EpiSoftmax {
    static constexpr bool PERM = true, AFTER_DRAIN = false;
    bf16* P; LAS unsigned char* xch;
    __device__ __forceinline__ void operator()(f32x4 (&acc)[2][2][4][2], const Unit& u, int wr, int wc, int fr, int fq) const {
        LAS float* X1 = (LAS float*)xch; LAS float* X2 = X1 + 1024;
        float mx[2][4];
#pragma unroll
        for (int ai = 0; ai < 2; ++ai)
#pragma unroll
            for (int m = 0; m < 4; ++m) { float v = -INFINITY;
#pragma unroll
                for (int bj = 0; bj < 2; ++bj)
#pragma unroll
                    for (int n = 0; n < 2; ++n) { const f32x4 x = acc[ai][bj][m][n]; v = fmaxf(v, fmaxf(fmaxf(x[0], x[1]), fmaxf(x[2], x[3]))); }
                v = fmaxf(v, __shfl_xor(v, 16)); v = fmaxf(v, __shfl_xor(v, 32)); mx[ai][m] = v;
                if (fq == 0) X1[(ai * HALF + wr * 64 + m * 16 + fr) * 4 + wc] = v; }
        asm volatile("s_waitcnt lgkmcnt(0)" ::: "memory"); __builtin_amdgcn_s_barrier(); asm volatile("" ::: "memory");
        float sm[2][4];
#pragma unroll
        for (int ai = 0; ai < 2; ++ai)
#pragma unroll
            for (int m = 0; m < 4; ++m) { const f32x4 q = *(const LAS f32x4*)(X1 + (ai * HALF + wr * 64 + m * 16 + fr) * 4); const float M_ = fmaxf(fmaxf(q[0], q[1]), fmaxf(q[2], q[3])); float s = 0.f;
#pragma unroll
                for (int bj = 0; bj < 2; ++bj)
#pragma unroll
                    for (int n = 0; n < 2; ++n) { f32x4 x = acc[ai][bj][m][n];
#pragma unroll
                        for (int i = 0; i < 4; ++i) { x[i] = fast_exp2(x[i] - M_); s += x[i]; } acc[ai][bj][m][n] = x; }
                s += __shfl_xor(s, 16); s += __shfl_xor(s, 32); sm[ai][m] = s;
                if (fq == 0) X2[(ai * HALF + wr * 64 + m * 16 + fr) * 4 + wc] = s; }
        asm volatile("s_waitcnt lgkmcnt(0)" ::: "memory"); __builtin_amdgcn_s_barrier(); asm volatile("" ::: "memory");
        bf16* p0 = P + ((size_t)u.pm * BM + wr * 64 + fr) * DM + u.pn * BM + wc * 32 + 8 * fq;
#pragma unroll
        for (int ai = 0; ai < 2; ++ai)
#pragma unroll
            for (int m = 0; m < 4; ++m) { const f32x4 q = *(const LAS f32x4*)(X2 + (ai * HALF + wr * 64 + m * 16 + fr) * 4); const float inv = fast_rcp((q[0] + q[1]) + (q[2] + q[3]));
                bf16* rowp = p0 + (size_t)(ai * HALF + m * 16) * DM;
#pragma unroll
                for (int bj = 0; bj < 2; ++bj) { const f32x4 v0 = acc[ai][bj][m][0] * inv, v1 = acc[ai][bj][m][1] * inv; u32x4 w; w.x = cvt_pk_bf16(v0[0], v0[1]); w.y = cvt_pk_bf16(v0[2], v0[3]); w.z = cvt_pk_bf16(v1[0], v1[1]); w.w = cvt_pk_bf16(v1[2], v1[3]);
                    ST_U4(rowp + bj * HALF, w); } }
        (void)mx; (void)sm;
    }
};
struct EpiSwiGLU {
    static constexpr bool PERM = true, AFTER_DRAIN = false;
    bf16* HID;
    __device__ __forceinline__ void operator()(f32x4 (&acc)[2][2][4][2], const Unit& u, int wr, int wc, int fr, int fq) const {
        bf16* p0 = HID + ((size_t)u.pm * BM + wr * 64 + fr) * EFF + u.pn * 128 + wc * 32 + 8 * fq;
#pragma unroll
        for (int ai = 0; ai < 2; ++ai)
#pragma unroll
            for (int m = 0; m < 4; ++m) { f32x4 v0 = acc[ai][0][m][0], v1 = acc[ai][0][m][1]; const f32x4 g0 = acc[ai][1][m][0], g1 = acc[ai][1][m][1];
#pragma unroll
                for (int i = 0; i < 4; ++i) { v0[i] = siluf_(v0[i]) * g0[i]; v1[i] = siluf_(v1[i]) * g1[i]; }
                u32x4 w; w.x = cvt_pk_bf16(v0[0], v0[1]); w.y = cvt_pk_bf16(v0[2], v0[3]); w.z = cvt_pk_bf16(v1[0], v1[1]); w.w = cvt_pk_bf16(v1[2], v1[3]);
                ST_U4(p0 + (size_t)(ai * HALF + m * 16) * EFF, w); }
    }
};
struct EpiMoeOut {
    static constexpr bool PERM = true, AFTER_DRAIN = false;
    bf16* CB; const float* GATE;
    __device__ __forceinline__ void operator()(f32x4 (&acc)[2][2][4][2], const Unit& u, int wr, int wc, int fr, int fq) const {
        const int colb = u.pn * BM + wc * 32 + 8 * fq;
        int dst[2][4]; float gt[2][4];
#pragma unroll
        for (int ai = 0; ai < 2; ++ai)
#pragma unroll
            for (int m = 0; m < 4; ++m) { const int r = ai * HALF + wr * 64 + m * 16 + fr; dst[ai][m] = u.rl[r < u.nv ? r : u.nv - 1]; }
#pragma unroll
        for (int ai = 0; ai < 2; ++ai)
#pragma unroll
            for (int m = 0; m < 4; ++m) gt[ai][m] = GATE[dst[ai][m]];
        __builtin_amdgcn_sched_barrier(0);
#pragma unroll
        for (int ai = 0; ai < 2; ++ai)
#pragma unroll
            for (int m = 0; m < 4; ++m) { const int r = ai * HALF + wr * 64 + m * 16 + fr;
                if (r < u.nv) { const float g = gt[ai][m]; bf16* rowp = CB + (size_t)dst[ai][m] * DM + colb;
#pragma unroll
                    for (int bj = 0; bj < 2; ++bj) { const f32x4 v0 = acc[ai][bj][m][0] * g, v1 = acc[ai][bj][m][1] * g; u32x4 w; w.x = cvt_pk_bf16(v0[0], v0[1]); w.y = cvt_pk_bf16(v0[2], v0[3]); w.z = cvt_pk_bf16(v1[0], v1[1]); w.w = cvt_pk_bf16(v1[2], v1[3]);
                        ST_U4(rowp + bj * HALF, w); } } }
    }
};

struct DenseOrder {
    const char* A; const char* Bt; int lda, ldb, nM, nN, G, c;
    __device__ __forceinline__ bool next(int i, Unit& u) const {
        const int L = i * G + c; if (L >= nM * nN) return false;
        tile_of(L, nM, nN, u.pm, u.pn); u.a = A + (size_t)u.pm * BM * lda * 2; u.b = Bt + (size_t)u.pn * BM * ldb * 2; u.rl = nullptr; u.nv = 256; u.e = 0; return true;
    }
};
struct ProjOrder {
    const char* HB; const char* WIN; int G, c;
    __device__ __forceinline__ bool next(int i, Unit& u) const {
        const int L = i * G + c; constexpr int NP = (MTOK / 256) * (NIN / 256);
        if (L >= NP) return false;
        u.rl = nullptr; u.nv = 256; tile_of(L, MTOK / 256, NIN / 256, u.pm, u.pn); u.a = HB + (size_t)u.pm * BM * DM * 2; u.b = WIN + (size_t)u.pn * BM * DM * 2; u.e = 0;
        return true;
    }
};
struct MemKVOrder {
    const char* MEMB; const char* WK; const char* WV; int c;
    __device__ __forceinline__ bool next(int i, Unit& u) const {
        if (i > 0 || c >= 32) return false;
        const int j = c; u.rl = nullptr; u.nv = 256; u.pm = (j & 15) >> 2; u.pn = j & 3;
        if (j < 16) { u.a = MEMB + (size_t)u.pm * BM * DM * 2; u.b = WK + (size_t)u.pn * BM * DM * 2; u.e = 1; }
        else { u.a = WV + (size_t)u.pm * BM * DM * 2; u.b = MEMB + (size_t)u.pn * BM * DM * 2; u.e = 2; }
        return true;
    }
};
struct XattnOrder {
    const char* A; const char* B; int mode, G, c;
    __device__ __forceinline__ bool next(int i, Unit& u) const {
        const int L = i * G + c; if (L >= (MTOK / 256) * 4) return false;
        tile_of(L, MTOK / 256, 4, u.pm, u.pn); const int bt = u.pm / (SEQ / 256);
        u.a = A + ((size_t)u.pm * BM * DM + u.pn * 256) * 2;
        u.b = mode == 0 ? B + ((size_t)bt * 256 * DM + u.pn * 256) * 2 : B + ((size_t)u.pn * 256 * DM + bt * 256) * 2;
        u.rl = nullptr; u.nv = 256; u.e = 0; return true;
    }
};
#ifndef MOE_XCD
#define MOE_XCD 1
#endif
struct MoeOrder {
    const char* A; const char* W; const int* LIST; const LAS int* T; int mode  , G, c;
    __device__ __forceinline__ bool next(int i, Unit& u) const {
        const int ntile = T[16]; int mt, pn_;
        if (MOE_XCD && G == 256) { const int x = c & 7, k = c >> 3; mt = (i * 8 + (k >> 2)) * 8 + x; pn_ = k & 3; if (mt >= ntile) return false; }
        else { const int L = i * G + c; if (L >= ntile * 4) return false; mt = L >> 2; pn_ = L & 3; }
        u.pn = pn_; int e = 0;
#pragma unroll
        for (int j = 1; j < 16; ++j) e += (T[j] <= mt) ? 1 : 0;
        const int r0 = (mt - T[e]) * 256, ne = T[32 + e];
        u.e = e; u.pm = mt; u.nv = (ne - r0) < 256 ? (ne - r0) : 256; u.rl = LIST + (size_t)e * MTOK + r0;
        if (mode == 0) { u.a = A; u.b = W + ((size_t)e * 1024 + u.pn * 256) * DM * 2; }
        else { u.a = A + (size_t)mt * BM * EFF * 2; u.b = W + ((size_t)e * 1024 + u.pn * 256) * EFF * 2; }
        return true;
    }
};
}
#define XB_TMO      128
#define XB_XCNT(j)  (256  + 64 * (j))
#define XB_XSUB(j)  (1280 + 64 * (j))
#define XB_XGEN(j)  (2304 + 64 * (j))
#define XB_TOP      3328
#define XB_TOPGEN   3392
#define XCD_BAR_WORDS 3456
#define XB_SPIN_CAP (1u << 18)
__device__ __forceinline__ unsigned xb_ld(unsigned* p)              { return __hip_atomic_load(p, __ATOMIC_RELAXED, __HIP_MEMORY_SCOPE_AGENT); }
__device__ __forceinline__ unsigned xb_add(unsigned* p, unsigned v) { return __hip_atomic_fetch_add(p, v, __ATOMIC_RELAXED, __HIP_MEMORY_SCOPE_AGENT); }
__device__ __forceinline__ unsigned xb_xcc_id() { return (unsigned)__builtin_amdgcn_s_getreg((3 << 11) | 20) & 0xFu; }
#define XB_SPIN(cond, bar) do { unsigned _sp = 0; while (cond) { __builtin_amdgcn_s_sleep(1); \
    if ((++_sp & 255u) == 0u) { if (xb_ld(&(bar)[XB_TMO])) break; if (_sp > XB_SPIN_CAP) { atomicAdd(&(bar)[XB_TMO], 1u); break; } } } } while (0)
struct XcdBarrier { unsigned* bar; unsigned x; volatile LAS unsigned* st; };
__device__ __forceinline__ XcdBarrier xcd_barrier_post(unsigned* bar, volatile LAS unsigned* st) {
    XcdBarrier b; b.bar = bar; b.x = xb_xcc_id(); b.st = st;
    if (threadIdx.x == 0) (void)xb_add(&bar[XB_XCNT(b.x)], 1u);
    return b;
}
__device__ __forceinline__ void xcd_barrier_complete(unsigned* bar, unsigned x, unsigned& nloc, unsigned& nx) {
    const unsigned G = gridDim.x * gridDim.y * gridDim.z;
    unsigned sum, cnt, mine, sp = 0u;
    for (;;) {
        sum = 0u; cnt = 0u; mine = 0u;
#pragma unroll
        for (unsigned j = 0; j < 16; ++j) { const unsigned c = xb_ld(&bar[XB_XCNT(j)]); sum += c; cnt += (c > 0u) ? 1u : 0u; mine = (j == x) ? c : mine; }
        if (sum == G) break;
        __builtin_amdgcn_s_sleep(1);
        if ((++sp & 255u) == 0u) { if (xb_ld(&bar[XB_TMO])) break; if (sp > XB_SPIN_CAP) { atomicAdd(&bar[XB_TMO], 1u); break; } }
    }
    nloc = mine > 0u ? mine : 1u; nx = cnt > 0u ? cnt : 1u;
}
__device__ __forceinline__ void xcd_barrier(const XcdBarrier& b) {
    asm volatile("s_waitcnt vmcnt(0)" ::: "memory");
    __syncthreads();
    if (threadIdx.x == 0) {
        unsigned* bar = b.bar;
        __builtin_amdgcn_s_waitcnt(0);
        unsigned nloc = b.st[0], nx = b.st[1];
        if (nloc == 0u) { xcd_barrier_complete(bar, b.x, nloc, nx); b.st[0] = nloc; b.st[1] = nx; }
        const unsigned old = xb_add(&bar[XB_XSUB(b.x)], 1u);
        const unsigned gen = old / nloc;
        if (old + 1u == (gen + 1u) * nloc) {
            __builtin_amdgcn_fence(__ATOMIC_RELEASE, "agent");
            asm volatile("s_waitcnt vmcnt(0)" ::: "memory");
            const unsigned og = xb_add(&bar[XB_TOP], 1u);
            const unsigned tg = og / nx;
            if (og + 1u == (tg + 1u) * nx) xb_add(&bar[XB_TOPGEN], 1u);
            else XB_SPIN(xb_ld(&bar[XB_TOPGEN]) == tg, bar);
            __builtin_amdgcn_fence(__ATOMIC_ACQUIRE, "agent");
            xb_add(&bar[XB_XGEN(b.x)], 1u);
            asm volatile("s_waitcnt vmcnt(0)" ::: "memory");
        } else {
            XB_SPIN(xb_ld(&bar[XB_XGEN(b.x)]) == gen, bar);
            __builtin_amdgcn_fence(__ATOMIC_ACQUIRE, "agent");
            asm volatile("s_waitcnt vmcnt(0)" ::: "memory");
        }
    }
    __syncthreads();
}

struct Args { const GAS float* in[25]; GAS float* out; GAS unsigned char* ws; int ph_lo, ph_hi; };
enum { I_X = 0, I_MEM, I_LNIG, I_LNIB, I_WIN, I_FB, I_LQ1, I_LK1, I_LQ2, I_LK2, I_DNG, I_HLB, I_HNG, I_WOUT, I_WQ, I_WK, I_WV, I_WO, I_RW, I_RB, I_W1, I_W3, I_W2, I_LNG, I_LNB };

#define ARGS_T const __attribute__((address_space(4))) Args
struct Frame {
    LAS unsigned char* lds; GAS unsigned char* ws; gu32* ctl; GAS float* out;
    int tid, lane, wave, G, bid;
};
#define WSP(T, off) ((T*)(F.ws + (off)))
#define AIN(i) ((const float*)A.in[i])

__device__ __forceinline__ void tr_item(const float* W, int ldsrc, int nsrc0, bf16* WT, int ldd, int ndst0, int k0, LAS float* scr, int lane) {
    float t[32];
    const float* src = W + (size_t)(k0 + (lane >> 5)) * ldsrc + nsrc0 + (lane & 31);
#pragma unroll
    for (int i = 0; i < 32; ++i) t[i] = src[(size_t)(2 * i) * ldsrc];
#pragma unroll
    for (int i = 0; i < 32; ++i) scr[(2 * i + (lane >> 5)) * 33 + (lane & 31)] = t[i];
    LDS_WAIT(); asm volatile("" ::: "memory");
    const int c = lane & 7;
#pragma unroll
    for (int j = 0; j < 4; ++j) { const int n = (lane >> 3) + 8 * j; const LAS float* s = scr + (8 * c) * 33 + n;
        u32x4 o; o.x = cvt_pk_bf16(s[0 * 33], s[1 * 33]); o.y = cvt_pk_bf16(s[2 * 33], s[3 * 33]); o.z = cvt_pk_bf16(s[4 * 33], s[5 * 33]); o.w = cvt_pk_bf16(s[6 * 33], s[7 * 33]);
        *(u32x4*)(WT + (size_t)(ndst0 + n) * ldd + k0 + 8 * c) = o; }
    LDS_WAIT(); asm volatile("" ::: "memory");
}
__device__ __forceinline__ void convert_weights(const Frame& F, ARGS_T& A, int l) {
    LAS float* scr = (LAS float*)(F.lds + RING_OFF + F.wave * 16384);
    const int gw = F.bid * NWAVES + F.wave, NGW = F.G * NWAVES;
    constexpr int I_IN = 16 * 112, I_SQ = 16 * 32, I_13 = 16 * 2 * 16 * 16, I_2 = 16 * 8 * 32;
    constexpr int NITEMS = I_IN + 5 * I_SQ + I_13 + I_2;
    for (int it = gw; it < NITEMS; it += NGW) {
        int r = it;
        if (r < I_IN) { const int kb = r / 112, nb = r % 112; const int nd = nb * 32, ns = nd < 768 ? nd : nd + 4;
            tr_item(AIN(I_WIN) + (size_t)l * DM * INW, INW, ns, WSP(bf16, WS_WIN), DM, nd, kb * 64, scr, F.lane); continue; }
        r -= I_IN;
        if (r < 5 * I_SQ) { const int w = r / I_SQ, rr = r % I_SQ, kb = rr / 32, nb = rr % 32;
            const float* src = (w == 0 ? AIN(I_WOUT) : w == 1 ? AIN(I_WQ) : w == 2 ? AIN(I_WK) : w == 3 ? AIN(I_WV) : AIN(I_WO)) + (size_t)l * DM * DM;
            bf16* dst = (bf16*)(F.ws + (w == 0 ? WS_WOUT : w == 1 ? WS_WQ : w == 2 ? WS_WK : w == 3 ? WS_WV : WS_WO));
            tr_item(src, DM, nb * 32, dst, DM, nb * 32, kb * 64, scr, F.lane); continue; }
        r -= 5 * I_SQ;
        if (r < I_13) { const int e = r / 512, rr = r % 512, which = rr / 256, r2 = rr % 256, kb = r2 / 16, nb = r2 % 16;
            const float* src = (which == 0 ? AIN(I_W1) : AIN(I_W3)) + ((size_t)l * NEXP + e) * DM * EFF;
            const int j0 = nb * 32, nd = (j0 / 128) * 256 + which * 128 + (j0 % 128);
            tr_item(src, EFF, j0, WSP(bf16, WS_W13) + (size_t)e * 1024 * DM, DM, nd, kb * 64, scr, F.lane); continue; }
        r -= I_13;
        { const int e = r / 256, rr = r % 256, kb = rr / 32, nb = rr % 32;
            const float* src = AIN(I_W2) + ((size_t)l * NEXP + e) * EFF * DM;
            tr_item(src, DM, nb * 32, WSP(bf16, WS_W2) + (size_t)e * 1024 * EFF, EFF, nb * 32, kb * 64, scr, F.lane); }
    }
}

__device__ __forceinline__ void ln_regs(f32x4 (&v)[4], const float* g, const float* b, int lane) {
    float s = 0.f;
#pragma unroll
    for (int j = 0; j < 4; ++j) s += (v[j].x + v[j].y) + (v[j].z + v[j].w);
    const float mean = wave_sum(s) * (1.f / DM); float s2 = 0.f;
#pragma unroll
    for (int j = 0; j < 4; ++j) { v[j] = v[j] - mean; s2 += (v[j].x * v[j].x + v[j].y * v[j].y) + (v[j].z * v[j].z + v[j].w * v[j].w); }
    const float rstd = 1.f / sqrtf(wave_sum(s2) * (1.f / DM) + LN_EPS);
#pragma unroll
    for (int j = 0; j < 4; ++j) { const f32x4 gg = *(const f32x4*)(g + 4 * lane + 256 * j), bb = *(const f32x4*)(b + 4 * lane + 256 * j); v[j] = v[j] * rstd * gg + bb; }
}
__device__ __forceinline__ void store_row(const f32x4 (&v)[4], float* o32, bf16* o16, int lane) {
#pragma unroll
    for (int j = 0; j < 4; ++j) { if (o32) *(f32x4*)(o32 + 4 * lane + 256 * j) = v[j];
        if (o16) { u32x2 w; w.x = cvt_pk_bf16(v[j].x, v[j].y); w.y = cvt_pk_bf16(v[j].z, v[j].w); *(u32x2*)(o16 + 4 * lane + 256 * j) = w; } }
}
__device__ __forceinline__ void load_row_bf16(f32x4 (&v)[4], const bf16* row, int lane) {
#pragma unroll
    for (int j = 0; j < 4; ++j) { const u32x2 c = *(const u32x2*)(row + 4 * lane + 256 * j); v[j].x = __uint_as_float(c.x << 16); v[j].y = __uint_as_float(c.x & 0xffff0000u); v[j].z = __uint_as_float(c.y << 16); v[j].w = __uint_as_float(c.y & 0xffff0000u); }
}
__device__ __forceinline__ void unpack_row_bf16(f32x4 (&v)[4], const u32x2 (&c)[4]) {
#pragma unroll
    for (int j = 0; j < 4; ++j) { v[j].x = __uint_as_float(c[j].x << 16); v[j].y = __uint_as_float(c[j].x & 0xffff0000u); v[j].z = __uint_as_float(c[j].y << 16); v[j].w = __uint_as_float(c[j].y & 0xffff0000u); }
}
__device__ __forceinline__ void fox_forget(const f32x4 (&v)[4], const LAS float* WF, const float* fb, float* lf2row, int lane) {
    f32x4 a = {0.f, 0.f, 0.f, 0.f};
#pragma unroll
    for (int j = 0; j < 4; ++j)
#pragma unroll
        for (int i = 0; i < 4; ++i) { const f32x4 w = *(const LAS f32x4*)(WF + (4 * lane + 256 * j + i) * 4); a = a + w * v[j][i]; }
#pragma unroll
    for (int c = 0; c < 4; ++c) a[c] = wave_sum(a[c]);
    if (lane == 0) { f32x4 o;
#pragma unroll
        for (int c = 0; c < 4; ++c) o[c] = log_sigmoidf_(a[c] + fb[c]) * LOG2E;
        *(f32x4*)lf2row = o; }
}
__device__ __forceinline__ void load_wf(const Frame& F, ARGS_T& A, int l, LAS float* WF) {
    const float* w = AIN(I_WIN) + (size_t)l * DM * INW + 768;
    for (int k = F.tid; k < DM; k += NTHR) *(LAS f32x4*)(WF + 4 * k) = *(const f32x4*)(w + (size_t)k * INW);
    __syncthreads();
}

__device__ __forceinline__ void phase_prologue(const Frame& F, ARGS_T& A) {
    convert_weights(F, A, 0);
    __syncthreads();
    LAS float* WF = (LAS float*)(F.lds + XCH_OFF - 16384);
    load_wf(F, A, 0, WF);
    const int gw = F.bid * NWAVES + F.wave, NGW = F.G * NWAVES;
    for (int m = gw; m < NB * 256; m += NGW) { f32x4 v[4];
#pragma unroll
        for (int j = 0; j < 4; ++j) v[j] = *(const f32x4*)(AIN(I_MEM) + (size_t)m * DM + 4 * F.lane + 256 * j);
        store_row(v, nullptr, WSP(bf16, WS_MEMB) + (size_t)m * DM, F.lane); }
    f32x4 nx[4];
#pragma unroll
    for (int j = 0; j < 4; ++j) nx[j] = *(const f32x4*)(AIN(I_X) + (size_t)gw * DM + 4 * F.lane + 256 * j);
    for (int m = gw; m < MTOK; m += NGW) { f32x4 v[4];
#pragma unroll
        for (int j = 0; j < 4; ++j) v[j] = nx[j];
        if (m + NGW < MTOK) {
#pragma unroll
            for (int j = 0; j < 4; ++j) nx[j] = *(const f32x4*)(AIN(I_X) + (size_t)(m + NGW) * DM + 4 * F.lane + 256 * j); }
        ln_regs(v, AIN(I_LNIG), AIN(I_LNIB), F.lane);
        store_row(v, nullptr, WSP(bf16, WS_R1) + (size_t)m * DM, F.lane);
        fox_forget(v, WF, AIN(I_FB), WSP(float, WS_LF2) + (size_t)m * 4, F.lane); }
}
#define PREP(F) ((bf16*)(F).out + (size_t)MTOK * DM)
#define YMIXP(F) ((bf16*)(F).out)
#ifndef LN1_WIDE
#define LN1_WIDE 1
#endif
__device__ __forceinline__ void phase_ln1(const Frame& F, ARGS_T& A, int l) {
    const int gw = F.bid * NWAVES + F.wave, NGW = F.G * NWAVES;
    const float* g = AIN(I_LNG) + (size_t)(l * 3 + 0) * DM; const float* b = AIN(I_LNB) + (size_t)(l * 3 + 0) * DM;
#if LN1_WIDE
    u32x4 nx[2], ny[2];
#pragma unroll
    for (int j = 0; j < 2; ++j) { nx[j] = *(const u32x4*)(PREP(F) + (size_t)gw * DM + 8 * F.lane + 512 * j); ny[j] = *(const u32x4*)(PREP(F) + (size_t)(gw + NGW < MTOK ? gw + NGW : gw) * DM + 8 * F.lane + 512 * j); }
    for (int m = gw; m < MTOK; m += NGW) { f32x4 v[4]; u32x4 cu[2];
#pragma unroll
        for (int j = 0; j < 2; ++j) { cu[j] = nx[j]; nx[j] = ny[j]; }
        if (m + 2 * NGW < MTOK) {
#pragma unroll
            for (int j = 0; j < 2; ++j) ny[j] = *(const u32x4*)(PREP(F) + (size_t)(m + 2 * NGW) * DM + 8 * F.lane + 512 * j); }
#pragma unroll
        for (int j = 0; j < 2; ++j) { v[2 * j].x = __uint_as_float(cu[j].x << 16); v[2 * j].y = __uint_as_float(cu[j].x & 0xffff0000u); v[2 * j].z = __uint_as_float(cu[j].y << 16); v[2 * j].w = __uint_as_float(cu[j].y & 0xffff0000u);
            v[2 * j + 1].x = __uint_as_float(cu[j].z << 16); v[2 * j + 1].y = __uint_as_float(cu[j].z & 0xffff0000u); v[2 * j + 1].z = __uint_as_float(cu[j].w << 16); v[2 * j + 1].w = __uint_as_float(cu[j].w & 0xffff0000u); }
        float s = 0.f;
#pragma unroll
        for (int j = 0; j < 4; ++j) s += (v[j].x + v[j].y) + (v[j].z + v[j].w);
        const float mean = wave_sum(s) * (1.f / DM); float s2 = 0.f;
#pragma unroll
        for (int j = 0; j < 4; ++j) { v[j] = v[j] - mean; s2 += (v[j].x * v[j].x + v[j].y * v[j].y) + (v[j].z * v[j].z + v[j].w * v[j].w); }
        const float rstd = 1.f / sqrtf(wave_sum(s2) * (1.f / DM) + LN_EPS);
        bf16* o16 = WSP(bf16, WS_R1) + (size_t)m * DM;
#pragma unroll
        for (int j = 0; j < 2; ++j) { const int c0 = 8 * F.lane + 512 * j;
            const f32x4 g0 = *(const f32x4*)(g + c0), g1 = *(const f32x4*)(g + c0 + 4), b0 = *(const f32x4*)(b + c0), b1 = *(const f32x4*)(b + c0 + 4);
            const f32x4 y0 = v[2 * j] * rstd * g0 + b0, y1 = v[2 * j + 1] * rstd * g1 + b1;
            u32x4 w; w.x = cvt_pk_bf16(y0.x, y0.y); w.y = cvt_pk_bf16(y0.z, y0.w); w.z = cvt_pk_bf16(y1.x, y1.y); w.w = cvt_pk_bf16(y1.z, y1.w);
            *(u32x4*)(o16 + c0) = w; } }
#else
    u32x2 nx[4];
#pragma unroll
    for (int j = 0; j < 4; ++j) nx[j] = *(const u32x2*)(PREP(F) + (size_t)gw * DM + 4 * F.lane + 256 * j);
    for (int m = gw; m < MTOK; m += NGW) { f32x4 v[4]; u32x2 cu[4];
#pragma unroll
        for (int j = 0; j < 4; ++j) cu[j] = nx[j];
        if (m + NGW < MTOK) {
#pragma unroll
            for (int j = 0; j < 4; ++j) nx[j] = *(const u32x2*)(PREP(F) + (size_t)(m + NGW) * DM + 4 * F.lane + 256 * j); }
        unpack_row_bf16(v, cu);
        ln_regs(v, g, b, F.lane);
        store_row(v, nullptr, WSP(bf16, WS_R1) + (size_t)m * DM, F.lane); }
#endif
}
__device__ __forceinline__ void phase_ln3(const Frame& F, ARGS_T& A, int l) {
    LAS float* WF = (LAS float*)(F.lds + XCH_OFF - 16384);
    if (l == 0) { convert_weights(F, A, 1); __syncthreads(); load_wf(F, A, 1, WF); }
    const int gw = F.bid * NWAVES + F.wave, NGW = F.G * NWAVES;
    const float* g = AIN(I_LNG) + (size_t)(l * 3 + 2) * DM; const float* b = AIN(I_LNB) + (size_t)(l * 3 + 2) * DM;
    const bf16* CB = WSP(bf16, WS_CB);
    u32x2 nh[4], n0[4], n1[4];
#pragma unroll
    for (int j = 0; j < 4; ++j) { nh[j] = *(const u32x2*)(WSP(bf16, WS_R1) + (size_t)gw * DM + 4 * F.lane + 256 * j); n0[j] = *(const u32x2*)(CB + (size_t)(2 * gw) * DM + 4 * F.lane + 256 * j); n1[j] = *(const u32x2*)(CB + (size_t)(2 * gw + 1) * DM + 4 * F.lane + 256 * j); }
    for (int m = gw; m < MTOK; m += NGW) { f32x4 v[4]; u32x2 ch[4], cc0[4], cc1[4];
#pragma unroll
        for (int j = 0; j < 4; ++j) { ch[j] = nh[j]; cc0[j] = n0[j]; cc1[j] = n1[j]; }
        if (m + NGW < MTOK) { const size_t mn = (size_t)(m + NGW);
#pragma unroll
            for (int j = 0; j < 4; ++j) { nh[j] = *(const u32x2*)(WSP(bf16, WS_R1) + mn * DM + 4 * F.lane + 256 * j); n0[j] = *(const u32x2*)(CB + 2 * mn * DM + 4 * F.lane + 256 * j); n1[j] = *(const u32x2*)(CB + (2 * mn + 1) * DM + 4 * F.lane + 256 * j); } }
        unpack_row_bf16(v, ch);
#pragma unroll
        for (int j = 0; j < 4; ++j) {
            const u32x2 c0 = cc0[j], c1 = cc1[j];
            v[j].x = v[j].x * ALPHA + (__uint_as_float(c0.x << 16) + __uint_as_float(c1.x << 16)); v[j].y = v[j].y * ALPHA + (__uint_as_float(c0.x & 0xffff0000u) + __uint_as_float(c1.x & 0xffff0000u));
            v[j].z = v[j].z * ALPHA + (__uint_as_float(c0.y << 16) + __uint_as_float(c1.y << 16)); v[j].w = v[j].w * ALPHA + (__uint_as_float(c0.y & 0xffff0000u) + __uint_as_float(c1.y & 0xffff0000u)); }
        ln_regs(v, g, b, F.lane);
        store_row(v, l == 0 ? nullptr : (float*)F.out + (size_t)m * DM, l == 0 ? WSP(bf16, WS_R1) + (size_t)m * DM : nullptr, F.lane);
        if (l == 0) fox_forget(v, WF, AIN(I_FB) + 4, WSP(float, WS_LF2) + (size_t)m * 4, F.lane); }
}
__device__ __forceinline__ void fox_cumsum(const Frame& F) {
    if (F.bid >= 16) return;
    const int b = F.bid >> 2, h = F.bid & 3; const float* src = WSP(float, WS_LF2) + (size_t)b * SEQ * 4 + h; float* dst = WSP(float, WS_CUMF) + (size_t)F.bid * SEQ;
    LAS float* tot = (LAS float*)(F.lds + XCH_OFF);
    float v[16]; float run = 0.f;
#pragma unroll
    for (int i = 0; i < 16; ++i) { run += src[(size_t)(F.tid * 16 + i) * 4]; v[i] = run; }
    float inc = run;
#pragma unroll
    for (int o = 1; o < 64; o <<= 1) { const float t = __shfl_up(inc, o); if (F.lane >= o) inc += t; }
    if (F.lane == 63) tot[F.wave] = inc;
    __syncthreads();
    float base = inc - run;
    for (int w = 0; w < F.wave; ++w) base += tot[w];
#pragma unroll
    for (int i = 0; i < 16; ++i) dst[F.tid * 16 + i] = v[i] + base;
    __syncthreads();
}
#ifndef ROUTE_TT
#define ROUTE_TT 4
#endif
__device__ __forceinline__ void phase_ln2_route(const Frame& F, ARGS_T& A, int l) {
    constexpr int RW_BYTES = DM * 64 + (DM / 4) * 16;
    LAS unsigned char* RWB = F.lds + RING_OFF;
    LAS int* REC = (LAS int*)(F.lds + RING_OFF + RW_BYTES);
    LAS int* CNT = (LAS int*)(F.lds + RING_OFF + RW_BYTES + 2048);
    LAS int* BASE = CNT + 16; LAS int* NREC = CNT + 32;
    LAS float* LG = (LAS float*)(F.lds + RING_OFF + RW_BYTES + 4096) + F.wave * 64;
    for (int c = F.tid; c < DM * 4; c += NTHR) { const int row = c >> 2, q = c & 3; *(LAS f32x4*)(RWB + row * 64 + (row >> 2) * 16 + q * 16) = *(const f32x4*)(AIN(I_RW) + 4 * c); }
    if (F.tid < 16) CNT[F.tid] = 0;
    __syncthreads();
    const int gw = F.bid * NWAVES + F.wave, NGW = F.G * NWAVES;
    const float* g = AIN(I_LNG) + (size_t)(l * 3 + 1) * DM; const float* b = AIN(I_LNB) + (size_t)(l * 3 + 1) * DM;
    float* GATE = WSP(float, WS_GATE);
    constexpr int TT = ROUTE_TT, NR = TT * 16;
    int nrec = 0;
    u32x2 nx[TT][4];
#pragma unroll
    for (int t = 0; t < TT; ++t) { const int mr = gw + t * NGW < MTOK ? gw + t * NGW : MTOK - 1;
#pragma unroll
        for (int j = 0; j < 4; ++j) nx[t][j] = *(const u32x2*)(PREP(F) + (size_t)mr * DM + 4 * F.lane + 256 * j); }
    for (int m0 = gw; m0 < MTOK; m0 += TT * NGW) { f32x4 v[TT][4]; int ln_ = F.lane; asm volatile("" : "+v"(ln_));
#pragma unroll
        for (int t = 0; t < TT; ++t) unpack_row_bf16(v[t], nx[t]);
        if (m0 + TT * NGW < MTOK) {
#pragma unroll
            for (int t = 0; t < TT; ++t) { const int mr = m0 + (TT + t) * NGW < MTOK ? m0 + (TT + t) * NGW : MTOK - 1;
#pragma unroll
                for (int j = 0; j < 4; ++j) nx[t][j] = *(const u32x2*)(PREP(F) + (size_t)mr * DM + 4 * ln_ + 256 * j); } }
#pragma unroll
        for (int t = 0; t < TT; ++t) { ln_regs(v[t], g, b, ln_); if (m0 + t * NGW < MTOK) store_row(v[t], nullptr, WSP(bf16, WS_R1) + (size_t)(m0 + t * NGW) * DM, ln_); }
        f32x2 R2[NR / 2];
#pragma unroll
        for (int k = 0; k < NR / 2; ++k) R2[k] = (f32x2){0.f, 0.f};
#pragma unroll
        for (int j = 0; j < 4; ++j)
#pragma unroll
            for (int i = 0; i < 4; ++i) { const LAS f32x4* wr = (const LAS f32x4*)(RWB + ln_ * 272 + i * 64 + j * 17408); f32x2 wp[8];
#pragma unroll
                for (int q = 0; q < 4; ++q) { const f32x4 w = wr[q]; wp[2 * q] = (f32x2){w[0], w[1]}; wp[2 * q + 1] = (f32x2){w[2], w[3]}; }
#pragma unroll
                for (int t = 0; t < TT; ++t) { const float x = v[t][j][i]; const f32x2 x2 = {x, x};
#pragma unroll
                    for (int c = 0; c < 8; ++c) R2[t * 8 + c] = __builtin_elementwise_fma(wp[c], x2, R2[t * 8 + c]); } }
        float R[NR];
#pragma unroll
        for (int k = 0; k < NR / 2; ++k) { R[2 * k] = R2[k][0]; R[2 * k + 1] = R2[k][1]; }
#pragma unroll
        for (int P = NR / 2; P >= 1; P >>= 1) { const bool up = (ln_ & P) != 0;
#pragma unroll
            for (int k = 0; k < P; ++k) { const float keep = up ? R[k + P] : R[k], send = up ? R[k] : R[k + P]; R[k] = keep + __shfl_xor(send, P); } }
#pragma unroll
        for (int P = NR; P < 64; P <<= 1) R[0] += __shfl_xor(R[0], P);
        LG[ln_] = 1.f / (1.f + __expf(-R[0]));
        float sc[16], bi[16];
#pragma unroll
        for (int q = 0; q < 4; ++q) { const f32x4 sv = *(const LAS f32x4*)(LG + (ln_ & 48) + 4 * q);
#pragma unroll
            for (int i = 0; i < 4; ++i) { sc[q * 4 + i] = sv[i]; bi[q * 4 + i] = sv[i] + AIN(I_RB)[q * 4 + i]; } }
        int gs = 0; float best = -INFINITY;
#pragma unroll
        for (int q = 0; q < 4; ++q) { float m1 = -INFINITY, m2 = -INFINITY;
#pragma unroll
            for (int i = 0; i < 4; ++i) { const float x = bi[q * 4 + i]; if (x > m1) { m2 = m1; m1 = x; } else if (x > m2) m2 = x; }
            const float s = m1 + m2; if (s > best) { best = s; gs = q; } }
        float bq[4], sq[4];
#pragma unroll
        for (int i = 0; i < 4; ++i) { bq[i] = gs == 0 ? bi[i] : gs == 1 ? bi[4 + i] : gs == 2 ? bi[8 + i] : bi[12 + i]; sq[i] = gs == 0 ? sc[i] : gs == 1 ? sc[4 + i] : gs == 2 ? sc[8 + i] : sc[12 + i]; }
        int i0 = 0; float b0 = bq[0];
#pragma unroll
        for (int i = 1; i < 4; ++i) if (bq[i] > b0) { b0 = bq[i]; i0 = i; }
        int i1 = -1; float b1 = -INFINITY;
#pragma unroll
        for (int i = 0; i < 4; ++i) if (i != i0 && bq[i] > b1) { b1 = bq[i]; i1 = i; }
        const float s0 = i0 == 0 ? sq[0] : i0 == 1 ? sq[1] : i0 == 2 ? sq[2] : sq[3];
        const float s1 = i1 == 0 ? sq[0] : i1 == 1 ? sq[1] : i1 == 2 ? sq[2] : sq[3];
        const int e0 = gs * 4 + i0, e1 = gs * 4 + i1;
        const int m = m0 + ((ln_ >> 4) & (TT - 1)) * NGW;
        if ((ln_ & 15) == 0 && ln_ < NR && m < MTOK) { const float inv = 1.f / (s0 + s1); GATE[2 * m] = s0 * inv; GATE[2 * m + 1] = s1 * inv;
            const int r0 = __hip_atomic_fetch_add(&CNT[e0], 1, __ATOMIC_RELAXED, __HIP_MEMORY_SCOPE_WORKGROUP), r1 = __hip_atomic_fetch_add(&CNT[e1], 1, __ATOMIC_RELAXED, __HIP_MEMORY_SCOPE_WORKGROUP);
            LAS int* rec = REC + (F.wave * 16 + nrec + ((ln_ >> 4) & (TT - 1))) * 4; rec[0] = m; rec[1] = e0; rec[2] = e1; rec[3] = r0 | (r1 << 16); }
#pragma unroll
        for (int t = 0; t < TT; ++t) nrec += (m0 + t * NGW < MTOK) ? 1 : 0;
    }
    if (F.lane == 0) NREC[F.wave] = nrec;
    __syncthreads();
    if (F.tid < 16) BASE[F.tid] = (int)__hip_atomic_fetch_add((unsigned*)(F.ctl + CW_ECNT + (l * 16 + F.tid) * 64), (unsigned)CNT[F.tid], RLX_AGENT);
    __syncthreads();
    int* LIST = WSP(int, WS_LIST);
    if (F.tid < 128) { const int w = F.tid >> 4, i = F.tid & 15; const int cnt_w = NREC[w];
        if (i < cnt_w) { const LAS int* rec = REC + F.tid * 4; const int m = rec[0], e0 = rec[1], e1 = rec[2], rr = rec[3];
            LIST[(size_t)e0 * MTOK + BASE[e0] + (rr & 0xffff)] = 2 * m; LIST[(size_t)e1 * MTOK + BASE[e1] + (rr >> 16)] = 2 * m + 1; } }
    __syncthreads();
}
__device__ __forceinline__ void moe_tables(const Frame& F, int l) {
    LAS int* T = (LAS int*)(F.lds + TAB_OFF);
    if (F.tid == 0) { int cum = 0;
        for (int e = 0; e < 16; ++e) { const int n = (int)__hip_atomic_load((unsigned*)(F.ctl + CW_ECNT + (l * 16 + e) * 64), RLX_AGENT); T[e] = cum; T[32 + e] = n; cum += (n + 255) >> 8; }
        T[16] = cum; }
    __syncthreads();
}
#ifndef ATT_STAGGER
#define ATT_STAGGER 0
#endif
#ifndef DIFF_FAST_BOUND
#define DIFF_FAST_BOUND 60.f
#endif
#ifndef DIFF_LAG
#define DIFF_LAG 0
#endif
#ifndef DIFF_IL
#define DIFF_IL 1
#endif
#ifndef FOX_IL
#define FOX_IL 1
#endif
#ifndef USE_FAST_STEP
#define USE_FAST_STEP 0
#endif
#ifndef ONLY_FAST_TEST
#define ONLY_FAST_TEST 0
#endif
namespace att {
template <int V> struct IC { static constexpr int value = V; };
constexpr int SLOTB = 8192;
constexpr int L_K = 0, L_V = 4 * SLOTB, L_KX = 10 * SLOTB, L_WS = L_KX + 4 * 1024, L_END = L_WS + NWAVES * 256, L_OST = 0;
static_assert(L_END <= RING_BYTES, "attention LDS");
constexpr float THR = 10.f;
__device__ __forceinline__ int crow(int r, int hi) { return (r & 3) + 8 * (r >> 2) + 4 * hi; }
__device__ __forceinline__ void glds16(const void* gsrc, unsigned lds_dst) { unsigned keep;
    asm volatile("s_mov_b32 %0, m0\n\ts_mov_b32 m0, %2\n\ts_nop 0\n\tglobal_load_lds_dwordx4 %1, off\n\ts_mov_b32 m0, %0" : "=&s"(keep) : "v"(gsrc), "s"(lds_dst) : "memory"); }
__device__ __forceinline__ void glds16s(const void* sbase, unsigned voff, unsigned lds_dst) { unsigned keep;
    asm volatile("s_mov_b32 %0, m0\n\ts_mov_b32 m0, %3\n\ts_nop 0\n\tglobal_load_lds_dwordx4 %1, %2\n\ts_mov_b32 m0, %0" : "=&s"(keep) : "v"(voff), "s"(sbase), "s"(lds_dst) : "memory"); }
#ifndef ATT_USE_PRIO
#define ATT_USE_PRIO 1
#endif
#define ATT_PRIO(p) do { if (ATT_USE_PRIO) __builtin_amdgcn_s_setprio(p); } while (0)
#define ATT_WAIT_BAR() asm volatile("s_waitcnt vmcnt(0) lgkmcnt(0)\n\ts_barrier" ::: "memory")
typedef short v4i16_t __attribute__((ext_vector_type(4)));
__device__ __forceinline__ s16x4 vtr(const LAS unsigned char* p) { return __builtin_bit_cast(s16x4, __builtin_amdgcn_ds_read_tr16_b64_v4i16((LAS v4i16_t*)p)); }
__device__ __forceinline__ float rowmax32(const f32x16& p0, const f32x16& p1) {
    float a0 = fmaxf(p0[0], p1[0]), a1 = fmaxf(p0[1], p1[1]), a2 = fmaxf(p0[2], p1[2]), a3 = fmaxf(p0[3], p1[3]);
#pragma unroll
    for (int r = 4; r < 16; r += 4) { a0 = fmaxf(a0, fmaxf(p0[r], p1[r])); a1 = fmaxf(a1, fmaxf(p0[r + 1], p1[r + 1])); a2 = fmaxf(a2, fmaxf(p0[r + 2], p1[r + 2])); a3 = fmaxf(a3, fmaxf(p0[r + 3], p1[r + 3])); }
    const float a = fmaxf(fmaxf(a0, a1), fmaxf(a2, a3));
    auto rr = __builtin_amdgcn_permlane32_swap(__float_as_uint(a), __float_as_uint(a), false, false);
    return fmaxf(__uint_as_float(rr[0]), __uint_as_float(rr[1]));
}
__device__ __forceinline__ float half_sum(float a) { auto rr = __builtin_amdgcn_permlane32_swap(__float_as_uint(a), __float_as_uint(a), false, false); return __uint_as_float(rr[0]) + __uint_as_float(rr[1]); }
__device__ __forceinline__ bf16x8 pack8(const f32x16& p, int b) { u32x4 w; w.x = cvt_pk_bf16(p[b], p[b + 1]); w.y = cvt_pk_bf16(p[b + 2], p[b + 3]); w.z = cvt_pk_bf16(p[b + 4], p[b + 5]); w.w = cvt_pk_bf16(p[b + 6], p[b + 7]); return __builtin_bit_cast(bf16x8, w); }
__device__ __forceinline__ bf16x8 make_qx(float m, int hi) {
    const float a = -m; const unsigned h0 = cvt_pk_bf16(a, 0.f) & 0xffffu; const float r1 = a - __uint_as_float(h0 << 16); const unsigned h1 = cvt_pk_bf16(r1, 0.f) & 0xffffu; const float r2 = r1 - __uint_as_float(h1 << 16); const unsigned h2 = cvt_pk_bf16(r2, 0.f) & 0xffffu;
    u32x4 w; w.x = 0x3F803F80u; w.y = h0 | (h1 << 16); w.z = h2; w.w = 0u; if (hi) { w.x = 0u; w.y = 0u; w.z = 0u; } return __builtin_bit_cast(bf16x8, w);
}
__device__ __forceinline__ void softmax_step(f32x16& p0, f32x16& p1, float& m, float& l, f32x16 (&o)[2], bf16x8 (&pa)[4], LAS float* wsf, int r32, int hi, bool first) {
    const float rm = rowmax32(p0, p1);
    if (first || __any(rm > THR)) {
        const float d = first ? rm : fmaxf(rm, 0.f); m += d; const float sc = fast_exp2(-d); l *= sc;
        if (!first) { if (hi == 0) wsf[r32] = sc; LDS_WAIT();
#pragma unroll
            for (int g = 0; g < 4; ++g) { const f32x4 f = *(const LAS f32x4*)(wsf + 4 * hi + 8 * g);
#pragma unroll
                for (int i = 0; i < 4; ++i) { o[0][4 * g + i] *= f[i]; o[1][4 * g + i] *= f[i]; } } }
#pragma unroll
        for (int r = 0; r < 16; ++r) { p0[r] -= d; p1[r] -= d; }
    }
    float s0 = 0.f, s1 = 0.f, s2 = 0.f, s3 = 0.f;
#pragma unroll
    for (int r = 0; r < 16; r += 2) { p0[r] = fast_exp2(p0[r]); p0[r + 1] = fast_exp2(p0[r + 1]); p1[r] = fast_exp2(p1[r]); p1[r + 1] = fast_exp2(p1[r + 1]); s0 += p0[r]; s1 += p0[r + 1]; s2 += p1[r]; s3 += p1[r + 1]; }
    l += (s0 + s1) + (s2 + s3);
    pa[0] = pack8(p0, 0); pa[1] = pack8(p0, 8); pa[2] = pack8(p1, 0); pa[3] = pack8(p1, 8);
}

template <int ABL = 0>
__device__ __forceinline__ void exp_step(f32x16& p0, f32x16& p1, float& l, bf16x8 (&pa)[4]) {
#define EXPX(x) ((ABL & 1) ? (x) : fast_exp2(x))
    float s0 = 0.f, s1 = 0.f, s2 = 0.f, s3 = 0.f;
#pragma unroll
    for (int r = 0; r < 16; r += 2) { p0[r] = EXPX(p0[r]); p0[r + 1] = EXPX(p0[r + 1]); p1[r] = EXPX(p1[r]); p1[r + 1] = EXPX(p1[r + 1]); s0 += p0[r]; s1 += p0[r + 1]; s2 += p1[r]; s3 += p1[r + 1]; }
    l += (s0 + s1) + (s2 + s3);
    pa[0] = pack8(p0, 0); pa[1] = pack8(p0, 8); pa[2] = pack8(p1, 0); pa[3] = pack8(p1, 8);
}
#undef EXPX
struct St { float m1, l1, m2, l2; f32x16 o1[2], o2[2]; bf16x8 qx; bool first, mnz; };
template <int ABL = 0>
__device__ __forceinline__ void tile_fast_diff(St& S, const LAS unsigned char* kb, const LAS unsigned char* vb, const bf16x8 (&qr)[4]) {
    bf16x8 kf[8];
#pragma unroll
    for (int d0 = 0; d0 < 4; ++d0) { kf[2 * d0] = *(const LAS bf16x8*)(kb + d0 * 2048); kf[2 * d0 + 1] = *(const LAS bf16x8*)(kb + d0 * 2048 + 512); }
    __builtin_amdgcn_sched_barrier(0);
    f32x16 a0 = f32x16{}, a1 = f32x16{}, b0 = f32x16{}, b1 = f32x16{};
    ATT_PRIO(1);
    if (!(ABL & 4)) {
    a0 = __builtin_amdgcn_mfma_f32_32x32x16_bf16(kf[0], qr[0], a0, 0, 0, 0); a1 = __builtin_amdgcn_mfma_f32_32x32x16_bf16(kf[1], qr[0], a1, 0, 0, 0);
    b0 = __builtin_amdgcn_mfma_f32_32x32x16_bf16(kf[4], qr[2], b0, 0, 0, 0); b1 = __builtin_amdgcn_mfma_f32_32x32x16_bf16(kf[5], qr[2], b1, 0, 0, 0);
    a0 = __builtin_amdgcn_mfma_f32_32x32x16_bf16(kf[2], qr[1], a0, 0, 0, 0); a1 = __builtin_amdgcn_mfma_f32_32x32x16_bf16(kf[3], qr[1], a1, 0, 0, 0);
    b0 = __builtin_amdgcn_mfma_f32_32x32x16_bf16(kf[6], qr[3], b0, 0, 0, 0); b1 = __builtin_amdgcn_mfma_f32_32x32x16_bf16(kf[7], qr[3], b1, 0, 0, 0); }
    else { a0[0] = __builtin_bit_cast(float, (int)kf[0][0] + (int)kf[1][1] + (int)kf[2][0] + (int)kf[3][0]); b0[0] = __builtin_bit_cast(float, (int)kf[4][0] + (int)kf[5][0] + (int)kf[6][0] + (int)kf[7][0]); }
    bf16x8 vf0[4], vf1[4];
#pragma unroll
    for (int ks = 0; ks < 4; ++ks) { const s16x4 lo = vtr(vb + ks * 1024), hi4 = vtr(vb + ks * 1024 + 512); vf0[ks] = (bf16x8){lo[0], lo[1], lo[2], lo[3], hi4[0], hi4[1], hi4[2], hi4[3]}; }
    __builtin_amdgcn_sched_barrier(0);
    bf16x8 pa1[4], pa2[4];
    ATT_PRIO(0);
    exp_step<ABL>(a0, a1, S.l1, pa1);
    exp_step<ABL>(b0, b1, S.l2, pa2);
    __builtin_amdgcn_sched_barrier(0);
#pragma unroll
    for (int ks = 0; ks < 4; ++ks) { const s16x4 lo = vtr(vb + 4096 + ks * 1024), hi4 = vtr(vb + 4096 + ks * 1024 + 512); vf1[ks] = (bf16x8){lo[0], lo[1], lo[2], lo[3], hi4[0], hi4[1], hi4[2], hi4[3]}; }
#pragma unroll
    ATT_PRIO(1);
    for (int ks = 0; ks < 4; ++ks) { if (!(ABL & 2)) { S.o1[0] = __builtin_amdgcn_mfma_f32_32x32x16_bf16(pa1[ks], vf0[ks], S.o1[0], 0, 0, 0); S.o2[0] = __builtin_amdgcn_mfma_f32_32x32x16_bf16(pa2[ks], vf0[ks], S.o2[0], 0, 0, 0); } else { S.o1[0][0] += __builtin_bit_cast(float, (int)pa1[ks][0] + (int)vf0[ks][0]); S.o2[0][0] += __builtin_bit_cast(float, (int)pa2[ks][0] + (int)vf0[ks][4]); } }
    __builtin_amdgcn_sched_barrier(0);
#pragma unroll
    for (int ks = 0; ks < 4; ++ks) { if (!(ABL & 2)) { S.o1[1] = __builtin_amdgcn_mfma_f32_32x32x16_bf16(pa1[ks], vf1[ks], S.o1[1], 0, 0, 0); S.o2[1] = __builtin_amdgcn_mfma_f32_32x32x16_bf16(pa2[ks], vf1[ks], S.o2[1], 0, 0, 0); } else { S.o1[1][0] += __builtin_bit_cast(float, (int)pa1[ks][1] + (int)vf1[ks][0]); S.o2[1][0] += __builtin_bit_cast(float, (int)pa2[ks][1] + (int)vf1[ks][4]); } }
    ATT_PRIO(0);
    __builtin_amdgcn_sched_barrier(0);
}


template <int B>
__device__ __forceinline__ void exp4(const f32x16& p, float& l, unsigned& w0, unsigned& w1) {
    const float e0 = fast_exp2(p[B]), e1 = fast_exp2(p[B + 1]), e2 = fast_exp2(p[B + 2]), e3 = fast_exp2(p[B + 3]);
    l += (e0 + e1) + (e2 + e3); w0 = cvt_pk_bf16(e0, e1); w1 = cvt_pk_bf16(e2, e3);
}
#define EXP8(P, B0, L, DST) do { unsigned x0_, x1_, x2_, x3_; exp4<B0>(P, L, x0_, x1_); exp4<B0 + 4>(P, L, x2_, x3_); DST = __builtin_bit_cast(bf16x8, (u32x4){x0_, x1_, x2_, x3_}); } while (0)
__device__ __forceinline__ void tile_fast_diff_il(St& S, const LAS unsigned char* kb, const LAS unsigned char* vb, const bf16x8 (&qr)[4]) {
    bf16x8 kf[8], vf0[4], vf1[4];
#pragma unroll
    for (int d0 = 0; d0 < 4; ++d0) { kf[2 * d0] = *(const LAS bf16x8*)(kb + d0 * 2048); kf[2 * d0 + 1] = *(const LAS bf16x8*)(kb + d0 * 2048 + 512); }
    __builtin_amdgcn_sched_barrier(0);
    f32x16 a0 = f32x16{}, a1 = f32x16{}, b0 = f32x16{}, b1 = f32x16{};
    a0 = __builtin_amdgcn_mfma_f32_32x32x16_bf16(kf[0], qr[0], a0, 0, 0, 0); a1 = __builtin_amdgcn_mfma_f32_32x32x16_bf16(kf[1], qr[0], a1, 0, 0, 0);
    a0 = __builtin_amdgcn_mfma_f32_32x32x16_bf16(kf[2], qr[1], a0, 0, 0, 0); a1 = __builtin_amdgcn_mfma_f32_32x32x16_bf16(kf[3], qr[1], a1, 0, 0, 0);
#pragma unroll
    for (int ks = 0; ks < 4; ++ks) { const s16x4 lo = vtr(vb + ks * 1024), hi4 = vtr(vb + ks * 1024 + 512); vf0[ks] = (bf16x8){lo[0], lo[1], lo[2], lo[3], hi4[0], hi4[1], hi4[2], hi4[3]}; }
#pragma unroll
    for (int ks = 0; ks < 4; ++ks) { const s16x4 lo = vtr(vb + 4096 + ks * 1024), hi4 = vtr(vb + 4096 + ks * 1024 + 512); vf1[ks] = (bf16x8){lo[0], lo[1], lo[2], lo[3], hi4[0], hi4[1], hi4[2], hi4[3]}; }
    __builtin_amdgcn_sched_barrier(0);
    bf16x8 pa1[4], pa2[4]; float la = 0.f, lb = 0.f; unsigned w0, w1, w2, w3;
#define MF(acc, A_, B_) acc = __builtin_amdgcn_mfma_f32_32x32x16_bf16(A_, B_, acc, 0, 0, 0)
#define PK(dst) dst = __builtin_bit_cast(bf16x8, (u32x4){w0, w1, w2, w3})
#define SB() __builtin_amdgcn_sched_barrier(0)
    MF(b0, kf[4], qr[2]); exp4<0>(a0, la, w0, w1); SB();
    MF(b1, kf[5], qr[2]); exp4<4>(a0, lb, w2, w3); PK(pa1[0]); SB();
    MF(b0, kf[6], qr[3]); exp4<8>(a0, la, w0, w1); SB();
    MF(b1, kf[7], qr[3]); exp4<12>(a0, lb, w2, w3); PK(pa1[1]); SB();
    MF(S.o1[0], pa1[0], vf0[0]); exp4<0>(a1, la, w0, w1); SB();
    MF(S.o1[1], pa1[0], vf1[0]); exp4<4>(a1, lb, w2, w3); PK(pa1[2]); SB();
    MF(S.o1[0], pa1[1], vf0[1]); exp4<8>(a1, la, w0, w1); SB();
    MF(S.o1[1], pa1[1], vf1[1]); exp4<12>(a1, lb, w2, w3); PK(pa1[3]); SB();
    S.l1 += la + lb; la = 0.f; lb = 0.f;
    MF(S.o1[0], pa1[2], vf0[2]); exp4<0>(b0, la, w0, w1); SB();
    MF(S.o1[1], pa1[2], vf1[2]); exp4<4>(b0, lb, w2, w3); PK(pa2[0]); SB();
    MF(S.o1[0], pa1[3], vf0[3]); MF(S.o2[0], pa2[0], vf0[0]); exp4<8>(b0, la, w0, w1); SB();
    MF(S.o1[1], pa1[3], vf1[3]); MF(S.o2[1], pa2[0], vf1[0]); exp4<12>(b0, lb, w2, w3); PK(pa2[1]); SB();
    MF(S.o2[0], pa2[1], vf0[1]); exp4<0>(b1, la, w0, w1); SB();
    MF(S.o2[1], pa2[1], vf1[1]); exp4<4>(b1, lb, w2, w3); PK(pa2[2]); SB();
    MF(S.o2[0], pa2[2], vf0[2]); exp4<8>(b1, la, w0, w1); SB();
    MF(S.o2[1], pa2[2], vf1[2]); exp4<12>(b1, lb, w2, w3); PK(pa2[3]); SB();
    S.l2 += la + lb;
    MF(S.o2[0], pa2[3], vf0[3]); MF(S.o2[1], pa2[3], vf1[3]); SB();
#undef MF
#undef PK
#undef SB
}
#undef EXP8

template <int ABL = 0>
__device__ __forceinline__ void diff_front(St& S, const LAS unsigned char* kb, const bf16x8 (&qr)[4], bf16x8 (&pa1)[4], bf16x8 (&pa2)[4]) {
    bf16x8 kf[8];
#pragma unroll
    for (int d0 = 0; d0 < 4; ++d0) { kf[2 * d0] = *(const LAS bf16x8*)(kb + d0 * 2048); kf[2 * d0 + 1] = *(const LAS bf16x8*)(kb + d0 * 2048 + 512); }
    __builtin_amdgcn_sched_barrier(0);
    f32x16 a0 = f32x16{}, a1 = f32x16{}, b0 = f32x16{}, b1 = f32x16{};
    ATT_PRIO(1);
    if (!(ABL & 4)) {
    a0 = __builtin_amdgcn_mfma_f32_32x32x16_bf16(kf[0], qr[0], a0, 0, 0, 0); a1 = __builtin_amdgcn_mfma_f32_32x32x16_bf16(kf[1], qr[0], a1, 0, 0, 0);
    b0 = __builtin_amdgcn_mfma_f32_32x32x16_bf16(kf[4], qr[2], b0, 0, 0, 0); b1 = __builtin_amdgcn_mfma_f32_32x32x16_bf16(kf[5], qr[2], b1, 0, 0, 0);
    a0 = __builtin_amdgcn_mfma_f32_32x32x16_bf16(kf[2], qr[1], a0, 0, 0, 0); a1 = __builtin_amdgcn_mfma_f32_32x32x16_bf16(kf[3], qr[1], a1, 0, 0, 0);
    b0 = __builtin_amdgcn_mfma_f32_32x32x16_bf16(kf[6], qr[3], b0, 0, 0, 0); b1 = __builtin_amdgcn_mfma_f32_32x32x16_bf16(kf[7], qr[3], b1, 0, 0, 0); }
    else { a0[0] = __builtin_bit_cast(float, (int)kf[0][0] + (int)kf[1][1] + (int)kf[2][0] + (int)kf[3][0]); b0[0] = __builtin_bit_cast(float, (int)kf[4][0] + (int)kf[5][0] + (int)kf[6][0] + (int)kf[7][0]); }
    __builtin_amdgcn_sched_barrier(0);
    ATT_PRIO(0);
    exp_step<ABL>(a0, a1, S.l1, pa1);
    exp_step<ABL>(b0, b1, S.l2, pa2);
    __builtin_amdgcn_sched_barrier(0);
}
template <int ABL = 0>
__device__ __forceinline__ void diff_back(St& S, const LAS unsigned char* vb, const bf16x8 (&pa1)[4], const bf16x8 (&pa2)[4]) {
    bf16x8 vf0[4], vf1[4];
#pragma unroll
    for (int ks = 0; ks < 4; ++ks) { const s16x4 lo = vtr(vb + ks * 1024), hi4 = vtr(vb + ks * 1024 + 512); vf0[ks] = (bf16x8){lo[0], lo[1], lo[2], lo[3], hi4[0], hi4[1], hi4[2], hi4[3]}; }
#pragma unroll
    for (int ks = 0; ks < 4; ++ks) { const s16x4 lo = vtr(vb + 4096 + ks * 1024), hi4 = vtr(vb + 4096 + ks * 1024 + 512); vf1[ks] = (bf16x8){lo[0], lo[1], lo[2], lo[3], hi4[0], hi4[1], hi4[2], hi4[3]}; }
    __builtin_amdgcn_sched_barrier(0);
#pragma unroll
    ATT_PRIO(1);
    for (int ks = 0; ks < 4; ++ks) { if (!(ABL & 2)) { S.o1[0] = __builtin_amdgcn_mfma_f32_32x32x16_bf16(pa1[ks], vf0[ks], S.o1[0], 0, 0, 0); S.o2[0] = __builtin_amdgcn_mfma_f32_32x32x16_bf16(pa2[ks], vf0[ks], S.o2[0], 0, 0, 0); } else { S.o1[0][0] += __builtin_bit_cast(float, (int)pa1[ks][0] + (int)vf0[ks][0]); S.o2[0][0] += __builtin_bit_cast(float, (int)pa2[ks][0] + (int)vf0[ks][4]); } }
#pragma unroll
    for (int ks = 0; ks < 4; ++ks) { if (!(ABL & 2)) { S.o1[1] = __builtin_amdgcn_mfma_f32_32x32x16_bf16(pa1[ks], vf1[ks], S.o1[1], 0, 0, 0); S.o2[1] = __builtin_amdgcn_mfma_f32_32x32x16_bf16(pa2[ks], vf1[ks], S.o2[1], 0, 0, 0); } else { S.o1[1][0] += __builtin_bit_cast(float, (int)pa1[ks][1] + (int)vf1[ks][0]); S.o2[1][0] += __builtin_bit_cast(float, (int)pa2[ks][1] + (int)vf1[ks][4]); } }
    ATT_PRIO(0);
    __builtin_amdgcn_sched_barrier(0);
}

__device__ __forceinline__ void tile_fox(St& S, const LAS unsigned char* kb, const LAS unsigned char* vb, const LAS unsigned char* kx, const bf16x8 (&qr)[4], int t, int qmin, int qrow, LAS float* wsf, int r32, int hi) {
    bf16x8 kf[8];
#pragma unroll
    for (int d0 = 0; d0 < 4; ++d0) { kf[2 * d0] = *(const LAS bf16x8*)(kb + d0 * 2048); kf[2 * d0 + 1] = *(const LAS bf16x8*)(kb + d0 * 2048 + 512); }
    const bf16x8 x0 = *(const LAS bf16x8*)kx, x1 = *(const LAS bf16x8*)(kx + 512);
    __builtin_amdgcn_sched_barrier(0);
    f32x16 p0 = f32x16{}, p1 = f32x16{};
#pragma unroll
    for (int d0 = 0; d0 < 4; ++d0) { p0 = __builtin_amdgcn_mfma_f32_32x32x16_bf16(kf[2 * d0], qr[d0], p0, 0, 0, 0); p1 = __builtin_amdgcn_mfma_f32_32x32x16_bf16(kf[2 * d0 + 1], qr[d0], p1, 0, 0, 0); }
    p0 = __builtin_amdgcn_mfma_f32_32x32x16_bf16(x0, S.qx, p0, 0, 0, 0); p1 = __builtin_amdgcn_mfma_f32_32x32x16_bf16(x1, S.qx, p1, 0, 0, 0);
    bf16x8 vf0[4], vf1[4];
#pragma unroll
    for (int ks = 0; ks < 4; ++ks) { const s16x4 lo = vtr(vb + ks * 1024), hi4 = vtr(vb + ks * 1024 + 512); vf0[ks] = (bf16x8){lo[0], lo[1], lo[2], lo[3], hi4[0], hi4[1], hi4[2], hi4[3]}; }
    __builtin_amdgcn_sched_barrier(0);
    if (64 * t + 63 > qmin) {
#pragma unroll
        for (int r = 0; r < 16; ++r) { const int kv = 64 * t + crow(r, hi); if (kv > qrow) p0[r] = -INFINITY; if (kv + 32 > qrow) p1[r] = -INFINITY; } }
    bf16x8 pa1[4];
#if FOX_IL
    {
        const float rm = rowmax32(p0, p1);
        if (S.first || __any(rm > THR)) {
            const float d = S.first ? rm : fmaxf(rm, 0.f); S.m1 += d; const float sc = fast_exp2(-d); S.l1 *= sc;
            if (!S.first) { if (hi == 0) wsf[r32] = sc; LDS_WAIT();
#pragma unroll
                for (int g = 0; g < 4; ++g) { const f32x4 f = *(const LAS f32x4*)(wsf + 4 * hi + 8 * g);
#pragma unroll
                    for (int i = 0; i < 4; ++i) { S.o1[0][4 * g + i] *= f[i]; S.o1[1][4 * g + i] *= f[i]; } } }
#pragma unroll
            for (int r = 0; r < 16; ++r) { p0[r] -= d; p1[r] -= d; }
        }
        S.qx = make_qx(S.m1, hi);
#pragma unroll
        for (int ks = 0; ks < 4; ++ks) { const s16x4 lo = vtr(vb + 4096 + ks * 1024), hi4 = vtr(vb + 4096 + ks * 1024 + 512); vf1[ks] = (bf16x8){lo[0], lo[1], lo[2], lo[3], hi4[0], hi4[1], hi4[2], hi4[3]}; }
        __builtin_amdgcn_sched_barrier(0);
        float la = 0.f, lb = 0.f; unsigned w0, w1, w2, w3;
#define MF(acc, A_, B_) acc = __builtin_amdgcn_mfma_f32_32x32x16_bf16(A_, B_, acc, 0, 0, 0)
#define PK(dst) dst = __builtin_bit_cast(bf16x8, (u32x4){w0, w1, w2, w3})
#define SB() __builtin_amdgcn_sched_barrier(0)
        exp4<0>(p0, la, w0, w1); SB();
        exp4<4>(p0, lb, w2, w3); PK(pa1[0]); SB();
        MF(S.o1[0], pa1[0], vf0[0]); exp4<8>(p0, la, w0, w1); SB();
        MF(S.o1[1], pa1[0], vf1[0]); exp4<12>(p0, lb, w2, w3); PK(pa1[1]); SB();
        MF(S.o1[0], pa1[1], vf0[1]); exp4<0>(p1, la, w0, w1); SB();
        MF(S.o1[1], pa1[1], vf1[1]); exp4<4>(p1, lb, w2, w3); PK(pa1[2]); SB();
        MF(S.o1[0], pa1[2], vf0[2]); exp4<8>(p1, la, w0, w1); SB();
        MF(S.o1[1], pa1[2], vf1[2]); exp4<12>(p1, lb, w2, w3); PK(pa1[3]); SB();
        S.l1 += la + lb;
        MF(S.o1[0], pa1[3], vf0[3]); MF(S.o1[1], pa1[3], vf1[3]); SB();
#undef MF
#undef PK
#undef SB
    }
#else
    softmax_step(p0, p1, S.m1, S.l1, S.o1, pa1, wsf, r32, hi, S.first);
    S.qx = make_qx(S.m1, hi);
    __builtin_amdgcn_sched_barrier(0);
#pragma unroll
    for (int ks = 0; ks < 4; ++ks) { const s16x4 lo = vtr(vb + 4096 + ks * 1024), hi4 = vtr(vb + 4096 + ks * 1024 + 512); vf1[ks] = (bf16x8){lo[0], lo[1], lo[2], lo[3], hi4[0], hi4[1], hi4[2], hi4[3]}; }
#pragma unroll
    for (int ks = 0; ks < 4; ++ks) S.o1[0] = __builtin_amdgcn_mfma_f32_32x32x16_bf16(pa1[ks], vf0[ks], S.o1[0], 0, 0, 0);
    __builtin_amdgcn_sched_barrier(0);
#pragma unroll
    for (int ks = 0; ks < 4; ++ks) S.o1[1] = __builtin_amdgcn_mfma_f32_32x32x16_bf16(pa1[ks], vf1[ks], S.o1[1], 0, 0, 0);
    __builtin_amdgcn_sched_barrier(0);
#endif
    S.first = false;
}
template <int MODE, bool FAST>
__device__ __forceinline__ void tile_compute(St& S, const LAS unsigned char* kb, const LAS unsigned char* vb, const LAS unsigned char* kx, const bf16x8 (&qr)[4], int t, int qmin, int qrow, LAS float* wsf, int r32, int hi) {
    bf16x8 pa1[4], pa2[4];
    {   f32x16 p0 = f32x16{}, p1 = f32x16{};
#pragma unroll
        for (int d0 = 0; d0 < (MODE == 0 ? 4 : 2); ++d0) { const bf16x8 k0 = *(const LAS bf16x8*)(kb + d0 * 2048), k1 = *(const LAS bf16x8*)(kb + d0 * 2048 + 512);
            p0 = __builtin_amdgcn_mfma_f32_32x32x16_bf16(k0, qr[d0], p0, 0, 0, 0); p1 = __builtin_amdgcn_mfma_f32_32x32x16_bf16(k1, qr[d0], p1, 0, 0, 0); }
        if (MODE == 0) {
            const bf16x8 x0 = *(const LAS bf16x8*)kx, x1 = *(const LAS bf16x8*)(kx + 512);
            p0 = __builtin_amdgcn_mfma_f32_32x32x16_bf16(x0, S.qx, p0, 0, 0, 0); p1 = __builtin_amdgcn_mfma_f32_32x32x16_bf16(x1, S.qx, p1, 0, 0, 0);
            if (64 * t + 63 > qmin) {
#pragma unroll
                for (int r = 0; r < 16; ++r) { const int kv = 64 * t + crow(r, hi); if (kv > qrow) p0[r] = -INFINITY; if (kv + 32 > qrow) p1[r] = -INFINITY; } }
        } else if (!FAST && S.mnz) {
#pragma unroll
            for (int r = 0; r < 16; ++r) { p0[r] -= S.m1; p1[r] -= S.m1; } }
        if (FAST) { exp_step(p0, p1, S.l1, pa1); __builtin_amdgcn_sched_barrier(0); } else
        softmax_step(p0, p1, S.m1, S.l1, S.o1, pa1, wsf, r32, hi, MODE == 0 ? S.first : false);
        if (MODE == 0) { if (S.first || __any(S.m1 != 0.f)) S.qx = make_qx(S.m1, hi); }
    }
    if (MODE == 1) {
        f32x16 p0 = f32x16{}, p1 = f32x16{};
#pragma unroll
        for (int d0 = 2; d0 < 4; ++d0) { const bf16x8 k0 = *(const LAS bf16x8*)(kb + d0 * 2048), k1 = *(const LAS bf16x8*)(kb + d0 * 2048 + 512);
            p0 = __builtin_amdgcn_mfma_f32_32x32x16_bf16(k0, qr[d0], p0, 0, 0, 0); p1 = __builtin_amdgcn_mfma_f32_32x32x16_bf16(k1, qr[d0], p1, 0, 0, 0); }
        if (!FAST && S.mnz) {
#pragma unroll
            for (int r = 0; r < 16; ++r) { p0[r] -= S.m2; p1[r] -= S.m2; } }
        if (FAST) { exp_step(p0, p1, S.l2, pa2); __builtin_amdgcn_sched_barrier(0); } else {
        softmax_step(p0, p1, S.m2, S.l2, S.o2, pa2, wsf, r32, hi, false);
        S.mnz = __any(S.m1 != 0.f || S.m2 != 0.f); }
    }
#pragma unroll
    for (int d0 = 0; d0 < 2; ++d0) { bf16x8 vf[4];
#pragma unroll
        for (int ks = 0; ks < 4; ++ks) { const s16x4 lo = vtr(vb + d0 * 4096 + ks * 1024), hi4 = vtr(vb + d0 * 4096 + ks * 1024 + 512); vf[ks] = (bf16x8){lo[0], lo[1], lo[2], lo[3], hi4[0], hi4[1], hi4[2], hi4[3]}; }
        if (MODE == 0) __builtin_amdgcn_sched_barrier(0);
#pragma unroll
        for (int ks = 0; ks < 4; ++ks) { S.o1[d0] = __builtin_amdgcn_mfma_f32_32x32x16_bf16(pa1[ks], vf[ks], S.o1[d0], 0, 0, 0);
            if (MODE == 1) S.o2[d0] = __builtin_amdgcn_mfma_f32_32x32x16_bf16(pa2[ks], vf[ks], S.o2[d0], 0, 0, 0); }
        if (MODE == 0) __builtin_amdgcn_sched_barrier(0);
    }
    S.first = false;
}

#define SBAR() __builtin_amdgcn_sched_barrier(0)
#define DQK(P0, P1, j, d0a) do { const LAS unsigned char* kb_ = kq + (j) * SLOTB; P0 = f32x16{}; P1 = f32x16{}; \
        _Pragma("unroll") for (int d0 = (d0a); d0 < (d0a) + 2; ++d0) { const bf16x8 k0 = *(const LAS bf16x8*)(kb_ + d0 * 2048), k1 = *(const LAS bf16x8*)(kb_ + d0 * 2048 + 512); \
            P0 = __builtin_amdgcn_mfma_f32_32x32x16_bf16(k0, qr[d0], P0, 0, 0, 0); P1 = __builtin_amdgcn_mfma_f32_32x32x16_bf16(k1, qr[d0], P1, 0, 0, 0); } } while (0)
#define DPV(j) do { const LAS unsigned char* vb_ = vq + (j) * SLOTB; \
        _Pragma("unroll") for (int d0 = 0; d0 < 2; ++d0) { _Pragma("unroll") for (int ks = 0; ks < 4; ++ks) { const s16x4 lo = vtr(vb_ + d0 * 4096 + ks * 1024), hi4 = vtr(vb_ + d0 * 4096 + ks * 1024 + 512); \
            const bf16x8 vf = (bf16x8){lo[0], lo[1], lo[2], lo[3], hi4[0], hi4[1], hi4[2], hi4[3]}; \
            S.o1[d0] = __builtin_amdgcn_mfma_f32_32x32x16_bf16(pa1[ks], vf, S.o1[d0], 0, 0, 0); S.o2[d0] = __builtin_amdgcn_mfma_f32_32x32x16_bf16(pa2[ks], vf, S.o2[d0], 0, 0, 0); } SBAR(); } } while (0)
__device__ __forceinline__ void diff_fast_step(St& S, const LAS unsigned char* kq, const LAS unsigned char* vq, const bf16x8 (&qr)[4], int ntl) {
    f32x16 pA0, pA1, pB0, pB1; bf16x8 pa1[4], pa2[4];
    if (ntl == 2) {
        DQK(pA0, pA1, 0, 0); SBAR();
        DQK(pB0, pB1, 0, 2); exp_step(pA0, pA1, S.l1, pa1); SBAR();
        DQK(pA0, pA1, 1, 0); exp_step(pB0, pB1, S.l2, pa2); SBAR();
        DPV(0);
        DQK(pB0, pB1, 1, 2); exp_step(pA0, pA1, S.l1, pa1); SBAR();
        exp_step(pB0, pB1, S.l2, pa2); SBAR();
        DPV(1);
    } else if (ntl == 1) {
        DQK(pA0, pA1, 0, 0); SBAR();
        DQK(pB0, pB1, 0, 2); exp_step(pA0, pA1, S.l1, pa1); SBAR();
        exp_step(pB0, pB1, S.l2, pa2); SBAR();
        DPV(0);
    }
}
#undef DQK
#undef DPV
#undef SBAR

template <int MODE, bool FAST, int ABL = 0>
__device__ __forceinline__ void attn_unit(const Frame& F, ARGS_T& A, int l, int b, int h, int qb) {
    LAS unsigned char* shm = F.lds + RING_OFF;
    int lane = F.lane; asm volatile("" : "+v"(lane));
    const int r32 = lane & 31, hi = lane >> 5, wid = F.wave, tid_ = wid * 64 + lane;
    const bf16* PA = WSP(bf16, WS_PA);
    const size_t rowbase = (size_t)b * SEQ; const int q0 = qb * 256;
    constexpr int QC = MODE == 0 ? 0 : 768, KC = MODE == 0 ? 256 : 1024, VC = MODE == 0 ? 512 : 1280;
    const bf16* Qw = PA + (rowbase + q0 + wid * 32 + r32) * PA_LD + QC + h * 64;
    const bf16* Kh = PA + rowbase * PA_LD + KC + h * 64; const bf16* Vh = PA + rowbase * PA_LD + VC + h * 64;
    const unsigned lds0 = (unsigned)(uintptr_t)shm;
    LAS float* wsf = (LAS float*)(shm + L_WS) + wid * 64;
    unsigned koff = (unsigned)(lane * PA_LD + wid * 8) * 2u, voff = (unsigned)((16 * (wid & 3) + (lane >> 2)) * PA_LD + (wid >> 2) * 32 + (lane & 3) * 8) * 2u;
    asm volatile("" : "+v"(koff), "+v"(voff));
    const unsigned kdst = lds0 + L_K + wid * 1024, vdst = lds0 + L_V + wid * 1024;
#define DMA_KV(t, slot, vslot) do { glds16s(Kh + (size_t)(t) * 64 * PA_LD, koff, (unsigned)__builtin_amdgcn_readfirstlane(kdst + (slot) * SLOTB)); glds16s(Vh + (size_t)(t) * 64 * PA_LD, voff, (unsigned)__builtin_amdgcn_readfirstlane(vdst + (vslot) * SLOTB)); } while (0)
    bf16x8 qr[4];
#pragma unroll
    for (int d0 = 0; d0 < 4; ++d0) qr[d0] = *(const bf16x8*)(Qw + d0 * 16 + hi * 8);
    const int NTF = 4 * qb + 4;
    const float* cum = WSP(float, WS_CUMF) + (size_t)(b * 4 + h) * SEQ;
    float cq0 = 0.f; if (MODE == 0) cq0 = cum[q0];
    int tlo = 0;
    if (MODE == 0) { const unsigned* NRM = (const unsigned*)(F.ctl + CW_NRM + l * 128); const int bh_ = b * 4 + h;
        const float nq = __uint_as_float(__hip_atomic_load(NRM + (0 * 16 + bh_) * 2, RLX_AGENT)) + __uint_as_float(__hip_atomic_load(NRM + (0 * 16 + bh_) * 2 + 1, RLX_AGENT));
        const float nk = __uint_as_float(__hip_atomic_load(NRM + (1 * 16 + bh_) * 2, RLX_AGENT)) + __uint_as_float(__hip_atomic_load(NRM + (1 * 16 + bh_) * 2 + 1, RLX_AGENT));
        const float thr = 2.f * 1.02f * sqrtf(nq * nk) + 37.f;
        LAS int* TL = (LAS int*)(shm + L_WS + NWAVES * 256 - 16);
        if (tid_ == 0) *TL = NTF - 4;
        __syncthreads();
        if (tid_ < NTF - 4) { if (cq0 - cum[tid_ * 64 + 63] >= -thr) __hip_atomic_fetch_min(TL, tid_, __ATOMIC_RELAXED, __HIP_MEMORY_SCOPE_WORKGROUP); }
        __syncthreads();
        tlo = *TL; __syncthreads(); }
    const int NT = NTF - tlo, NT2 = (NT + 1) >> 1;
#define TILE_OF(i) (MODE == 0 ? (NTF - 1 - (i)) : (i))
#define KX_LOAD(i2) ((2 * (i2) + (tid_ >> 6) < NT) ? cq0 - cum[TILE_OF(2 * (i2) + (tid_ >> 6)) * 64 + (tid_ & 63)] : 0.f)
#define KX_STORE(base, bv) do { const float b_ = (bv); const unsigned hb_ = cvt_pk_bf16(b_, 0.f) & 0xffffu; const float lo_ = b_ - __uint_as_float(hb_ << 16); u32x4 w_; w_.x = hb_ | (cvt_pk_bf16(lo_, 0.f) << 16); w_.y = 0x3F803F80u; w_.z = 0x3F80u; w_.w = 0u; \
        *(LAS u32x4*)(shm + L_KX + ((base) + (tid_ >> 6)) * 1024 + (tid_ & 63) * 16) = w_; } while (0)
    float kxv = 0.f;
    DMA_KV(TILE_OF(0), 0, 0); if (NT > 1) DMA_KV(TILE_OF(1), 1, 1);
    if (MODE == 0 && tid_ < 128) { kxv = KX_LOAD(0); KX_STORE(0, kxv); }
    St S; S.m1 = 0.f; S.l1 = 0.f; S.m2 = 0.f; S.l2 = 0.f; S.first = true; S.mnz = false; S.qx = make_qx(0.f, hi);
#pragma unroll
    for (int d = 0; d < 2; ++d) { S.o1[d] = f32x16{}; S.o2[d] = f32x16{}; }
    const int qmin = q0 + wid * 32, qrow = qmin + r32;
    ATT_WAIT_BAR();
    asm volatile("" : "+v"(qr[0]), "+v"(qr[1]), "+v"(qr[2]), "+v"(qr[3]), "+v"(cq0));
    constexpr bool LAGP = (MODE == 1 && FAST && DIFF_LAG);
    auto step_loop = [&](auto role_) { constexpr bool LAGW = decltype(role_)::value != 0;
    int vcur = 0, pend = -1; bf16x8 pp1[4], pp2[4];
    if (LAGW) {
#pragma unroll
        for (int ks = 0; ks < 4; ++ks) { pp1[ks] = bf16x8{}; pp2[ks] = bf16x8{}; } }
    for (int it = 0; it < NT2; ++it) {
        const int base = (it & 1) * 2; const int vnxt = LAGP ? (vcur == 4 ? 0 : vcur + 2) : (base ^ 2);
        if (!LAGP) vcur = base;
        if (it + 1 < NT2) { DMA_KV(TILE_OF(2 * it + 2), base ^ 2, vnxt); if (2 * it + 3 < NT) DMA_KV(TILE_OF(2 * it + 3), (base ^ 2) + 1, vnxt + 1); if (MODE == 0 && tid_ < 128) kxv = KX_LOAD(it + 1); }
        const LAS unsigned char* kq = shm + L_K + base * SLOTB + hi * 1024 + r32 * 16; const LAS unsigned char* vq = shm + L_V + (LAGP ? 0 : base * SLOTB) + ((lane >> 4) & 1) * 32 + (lane & 3) * 8 + (4 * hi + ((lane & 15) >> 2)) * 64;
        const LAS unsigned char* kxq = shm + L_KX + base * 1024 + r32 * 16;
        asm volatile("" : "+v"(kq), "+v"(vq), "+v"(kxq));
        if (MODE == 1 && FAST && ATT_STAGGER > 0) { if (wid >= 4) __builtin_amdgcn_s_sleep(ATT_STAGGER); }
#pragma unroll
        for (int j = 0; j < 2; ++j) { const int i = 2 * it + j;
            if (i < NT) { const int t = TILE_OF(i); const bool active = (MODE == 0 ? (64 * t <= qmin + 31) : (t <= 4 * qb + (wid >> 1))) && !((ABL & 8) && wid >= 4) && !((ABL & 16) && wid < 4);
                if (active) { if constexpr (LAGP) { if constexpr (!LAGW) { if constexpr (DIFF_IL && ABL == 0) tile_fast_diff_il(S, kq + j * SLOTB, vq + (vcur + j) * SLOTB, qr); else tile_fast_diff<ABL>(S, kq + j * SLOTB, vq + (vcur + j) * SLOTB, qr); }
                        else { if (pend >= 0) diff_back<ABL>(S, vq + pend * SLOTB, pp1, pp2); diff_front<ABL>(S, kq + j * SLOTB, qr, pp1, pp2); pend = vcur + j; } }
                    else if constexpr (MODE == 1 && FAST) { if constexpr (DIFF_IL && ABL == 0) tile_fast_diff_il(S, kq + j * SLOTB, vq + j * SLOTB, qr); else tile_fast_diff<ABL>(S, kq + j * SLOTB, vq + j * SLOTB, qr); } else if constexpr (MODE == 0) tile_fox(S, kq + j * SLOTB, vq + j * SLOTB, kxq + j * 1024, qr, t, qmin, qrow, wsf, r32, hi); else tile_compute<MODE, FAST>(S, kq + j * SLOTB, vq + j * SLOTB, kxq + j * 1024, qr, t, qmin, qrow, wsf, r32, hi); } }
            __builtin_amdgcn_sched_barrier(0); }
        if (MODE == 0 && it + 1 < NT2 && tid_ < 128) KX_STORE(base ^ 2, kxv);
        ATT_WAIT_BAR();
        vcur = vnxt;
    }
    if constexpr (LAGW) {
        if (pend >= 0) { const LAS unsigned char* vq = shm + L_V + ((lane >> 4) & 1) * 32 + (lane & 3) * 8 + (4 * hi + ((lane & 15) >> 2)) * 64; diff_back<ABL>(S, vq + pend * SLOTB, pp1, pp2); } }
    };
    if constexpr (LAGP) { if (wid >= 4) step_loop(IC<1>{}); else step_loop(IC<0>{}); ATT_WAIT_BAR(); }
    else step_loop(IC<0>{});
    float l1 = half_sum(S.l1), l2 = 1.f; if (MODE == 1) l2 = half_sum(S.l2);
    float lam = 0.f, post = 1.f;
    if (MODE == 1) { float d1 = 0.f, d2 = 0.f;
        for (int i = 0; i < 32; ++i) { d1 += AIN(I_LQ1)[l * 32 + i] * AIN(I_LK1)[l * 32 + i]; d2 += AIN(I_LQ2)[l * 32 + i] * AIN(I_LK2)[l * 32 + i]; }
        const float lam_init = 0.8f - 0.6f * __expf(-0.3f * (float)l); lam = __expf(d1) - __expf(d2) + lam_init; post = 1.f - lam_init; }
    if (hi == 0) { wsf[r32] = 1.f / l1; if (MODE == 1) wsf[32 + r32] = lam / l2; }
    LDS_WAIT();
    LAS float* stg = (LAS float*)(shm + L_OST) + wid * 2048;
#pragma unroll
    for (int g = 0; g < 4; ++g) { const f32x4 c1 = *(const LAS f32x4*)(wsf + 4 * hi + 8 * g); f32x4 c2 = {0.f, 0.f, 0.f, 0.f}; if (MODE == 1) c2 = *(const LAS f32x4*)(wsf + 32 + 4 * hi + 8 * g);
#pragma unroll
        for (int i = 0; i < 4; ++i) { const int r = 4 * g + i, orow = crow(r, hi);
#pragma unroll
            for (int d0 = 0; d0 < 2; ++d0) { float v = S.o1[d0][r] * c1[i]; if (MODE == 1) v -= S.o2[d0][r] * c2[i]; stg[orow * 64 + d0 * 32 + r32] = v; } } }
    LDS_WAIT();
    bf16* Y = YMIXP(F) + (rowbase + q0 + wid * 32) * DM + (MODE == 0 ? 0 : 256) + h * 64;
    const float* gn = AIN(I_DNG) + l * 64;
    int lane_e = lane; asm volatile("" : "+v"(lane_e));
#pragma unroll
    for (int i = 0; i < 4; ++i) { const int row = i * 8 + (lane_e >> 3), ch = lane_e & 7; f32x4 a = *(const LAS f32x4*)(stg + row * 64 + ch * 8), c = *(const LAS f32x4*)(stg + row * 64 + ch * 8 + 4);
        if (MODE == 1) { float ss = (a[0] * a[0] + a[1] * a[1]) + (a[2] * a[2] + a[3] * a[3]) + (c[0] * c[0] + c[1] * c[1]) + (c[2] * c[2] + c[3] * c[3]);
            ss += __shfl_xor(ss, 1); ss += __shfl_xor(ss, 2); ss += __shfl_xor(ss, 4);
            const float rs = post / sqrtf(ss * (1.f / 64.f) + LN_EPS); const f32x4 g0 = *(const f32x4*)(gn + ch * 8), g1 = *(const f32x4*)(gn + ch * 8 + 4);
            a = a * rs * g0; c = c * rs * g1; }
        u32x4 w; w.x = cvt_pk_bf16(a[0], a[1]); w.y = cvt_pk_bf16(a[2], a[3]); w.z = cvt_pk_bf16(c[0], c[1]); w.w = cvt_pk_bf16(c[2], c[3]);
        *(u32x4*)(Y + (size_t)row * DM + ch * 8) = w; }
    ATT_WAIT_BAR();
#undef DMA_KV
#undef TILE_OF
#undef KX_LOAD
#undef KX_STORE
}
template <int MODE, int ABL = 0>
__device__ __forceinline__ void attn_phase(const Frame& F, ARGS_T& A, int l) {
    for (int c0 = F.bid; c0 < 256; c0 += F.G) { const int c = (F.G == 256) ? (c0 & 7) * 32 + (c0 >> 3) : c0;
        const int bh = c >> 4, s = c & 15;
        bool fast = false;
        if (MODE == 1) {
            const unsigned* NRM = (const unsigned*)(F.ctl + CW_NRM + l * 128); float bmax = 0.f;
            for (int j = 0; j < 2; ++j) { const float nq = __uint_as_float(__hip_atomic_load(NRM + (2 * 16 + bh) * 2 + j, RLX_AGENT)), nk = __uint_as_float(__hip_atomic_load(NRM + (3 * 16 + bh) * 2 + j, RLX_AGENT)); bmax = fmaxf(bmax, 1.02f * sqrtf(nq * nk)); }
            fast = bmax <= DIFF_FAST_BOUND; }
        if (MODE == 1 && fast) { attn_unit<MODE, true, ABL>(F, A, l, bh >> 2, bh & 3, 31 - s); attn_unit<MODE, true, ABL>(F, A, l, bh >> 2, bh & 3, s); }
        else if (MODE == 0 || !ONLY_FAST_TEST) { attn_unit<MODE, false>(F, A, l, bh >> 2, bh & 3, 31 - s); attn_unit<MODE, false>(F, A, l, bh >> 2, bh & 3, s); } }
}
}
namespace hg {
constexpr int PQ = 136, PV = 72;
constexpr int L_QD = 0, L_KD = 17408, L_KO = 34816, L_QS = 43520, L_VT = 60928, L_ST = 79360, L_SEG = 114176, L_END = 116224, L_OST = 0;
static_assert(L_END <= RING_BYTES, "hgrn LDS");
struct Prep { float q[16], k[16], bc[16]; float blast, b31; };
#define HG_BAR() do { asm volatile("s_waitcnt lgkmcnt(0)" ::: "memory"); __builtin_amdgcn_s_barrier(); asm volatile("" ::: "memory"); } while (0)
struct Raw { float x[16]; bf16 q[16], v[16]; u32x4 st[4]; u32x4 g[2]; };
template <bool P3>
__device__ __forceinline__ void load_raw(const Frame& F, int U, Raw& R) {
    const int bh = U >> 7, n = U & 127, b = bh >> 2, h = bh & 3; const int c = F.tid & 127, seg = F.tid >> 7; const size_t tok0 = (size_t)b * SEQ + n * 64 + seg * 16; const int ch = h * 128 + c;
    const float* HF = WSP(float, WS_HF) + tok0 * 512 + ch; const bf16* HQ = WSP(bf16, WS_HQ) + tok0 * 512 + ch; const bf16* HI = WSP(bf16, WS_HI) + tok0 * 512 + ch;
#pragma unroll
    for (int i = 0; i < 16; ++i) { R.x[i] = HF[(size_t)i * 512]; R.v[i] = HI[(size_t)i * 512]; if (P3) R.q[i] = HQ[(size_t)i * 512]; }
    if (P3) { if (n > 0) { const bf16* ST = WSP(bf16, WS_ST) + (size_t)(U - 1) * 16384;
#pragma unroll
            for (int i = 0; i < 4; ++i) { const int idx = F.tid + i * NTHR; R.st[i] = *(const u32x4*)(ST + (idx >> 4) * 128 + (idx & 15) * 8); } }
        const int t = F.tid >> 3, v0 = (F.tid & 7) * 16; const bf16* HG = WSP(bf16, WS_HG) + ((size_t)b * SEQ + n * 64 + t) * 512 + h * 128 + v0; R.g[0] = *(const u32x4*)HG; R.g[1] = *(const u32x4*)(HG + 8); }
}
__device__ __forceinline__ void prep(const Frame& F, ARGS_T& A, int l, int h, const Raw& R, bool need_q, Prep& P) {
    const int c = F.tid & 127, seg = F.tid >> 7; const int ch = h * 128 + c;
    float lb = 0.f; if (l == 1) { const float b0 = AIN(I_HLB)[ch], b1 = AIN(I_HLB)[512 + ch]; lb = 1.f / (1.f + __expf(b0 - b1)); }
    LAS float* SEG = (LAS float*)(F.lds + L_SEG);
    float run = 0.f;
#pragma unroll
    for (int i = 0; i < 16; ++i) { const float x = R.x[i]; const float e = fast_exp2(-fabsf(x) * LOG2E);
        const float s = (x >= 0.f ? 1.f : e) * fast_rcp(1.f + e);
        const float lf2 = (l == 0) ? (fminf(x, 0.f) * LOG2E - __builtin_amdgcn_logf(1.f + e)) : __builtin_amdgcn_logf(lb + (1.f - lb) * s);
        run += lf2; P.bc[i] = run; P.k[i] = (1.f - lb) * (1.f - s); P.q[i] = need_q ? bf2f(R.q[i]) : 0.f; }
    SEG[seg * 128 + c] = run;
    HG_BAR();
    const float s0 = SEG[c], s1 = SEG[128 + c], s2 = SEG[256 + c], s3 = SEG[384 + c];
    const float pre = seg == 0 ? 0.f : seg == 1 ? s0 : seg == 2 ? s0 + s1 : s0 + s1 + s2;
#pragma unroll
    for (int i = 0; i < 16; ++i) P.bc[i] += pre;
    P.b31 = s0 + s1; P.blast = (s0 + s1) + (s2 + s3);
}
__device__ __forceinline__ void store16(LAS unsigned char* dst, const float (&v)[16]) {
    u32x4 a, b; a.x = cvt_pk_bf16(v[0], v[1]); a.y = cvt_pk_bf16(v[2], v[3]); a.z = cvt_pk_bf16(v[4], v[5]); a.w = cvt_pk_bf16(v[6], v[7]);
    b.x = cvt_pk_bf16(v[8], v[9]); b.y = cvt_pk_bf16(v[10], v[11]); b.z = cvt_pk_bf16(v[12], v[13]); b.w = cvt_pk_bf16(v[14], v[15]);
    *(LAS u32x4*)dst = a; *(LAS u32x4*)(dst + 16) = b;
}
__device__ __forceinline__ void store_vt(const Frame& F, const Raw& R) {
    const int c = F.tid & 127, seg = F.tid >> 7; u32x4 a, b;
    a.x = R.v[0] | ((unsigned)R.v[1] << 16); a.y = R.v[2] | ((unsigned)R.v[3] << 16); a.z = R.v[4] | ((unsigned)R.v[5] << 16); a.w = R.v[6] | ((unsigned)R.v[7] << 16);
    b.x = R.v[8] | ((unsigned)R.v[9] << 16); b.y = R.v[10] | ((unsigned)R.v[11] << 16); b.z = R.v[12] | ((unsigned)R.v[13] << 16); b.w = R.v[14] | ((unsigned)R.v[15] << 16);
    LAS unsigned char* dst = F.lds + L_VT + c * (PV * 2) + seg * 32; *(LAS u32x4*)dst = a; *(LAS u32x4*)(dst + 16) = b;
}
__device__ __forceinline__ void pass1_unit(const Frame& F0_, ARGS_T& A, int l, int U, Raw& R, int Unext) {
    Frame F = F0_; { int t_ = F.tid; asm volatile("" : "+v"(t_)); F.tid = t_; F.lane = t_ & 63; }
    const int bh = U >> 7, h = bh & 3; const int c = F.tid & 127, seg = F.tid >> 7;
    Prep P; prep(F, A, l, h, R, false, P);
    { float kd[16];
#pragma unroll
      for (int i = 0; i < 16; ++i) kd[i] = P.k[i] * fast_exp2(P.blast - P.bc[i]);
      store16(F.lds + L_KD + c * (PV * 2) + seg * 32, kd); }
    store_vt(F, R);
    if (seg == 0) WSP(float, WS_HDEC)[(size_t)U * 128 + c] = fast_exp2(P.blast);
    HG_BAR();
    if (Unext < 2048) load_raw<false>(F, Unext, R);
    const int lane = F.lane, r32 = lane & 31, hi = lane >> 5, vb = F.wave >> 1, db0 = (F.wave & 1) * 2;
    f32x16 acc[2]; acc[0] = f32x16{}; acc[1] = f32x16{};
#pragma unroll
    for (int ks = 0; ks < 4; ++ks) { const bf16x8 a = *(const LAS bf16x8*)(F.lds + L_VT + (vb * 32 + r32) * (PV * 2) + ks * 32 + hi * 16);
#pragma unroll
        for (int j = 0; j < 2; ++j) { const bf16x8 bb = *(const LAS bf16x8*)(F.lds + L_KD + ((db0 + j) * 32 + r32) * (PV * 2) + ks * 32 + hi * 16);
            acc[j] = __builtin_amdgcn_mfma_f32_32x32x16_bf16(a, bb, acc[j], 0, 0, 0); } }
    bf16* ST = WSP(bf16, WS_ST) + (size_t)U * 16384;
#pragma unroll
    for (int j = 0; j < 2; ++j)
#pragma unroll
        for (int r = 0; r < 16; ++r) { const int v = vb * 32 + (r & 3) + 8 * (r >> 2) + 4 * hi; ST[v * 128 + (db0 + j) * 32 + r32] = f2bf(acc[j][r]); }
    HG_BAR();
}
__device__ __forceinline__ void phase_pass1(const Frame& F, ARGS_T& A, int l) {
    Raw R; if (F.bid < 2048) load_raw<false>(F, F.bid, R);
    for (int U = F.bid; U < 2048; U += F.G) pass1_unit(F, A, l, U, R, U + F.G);
}

__device__ __forceinline__ void phase_scan(const Frame& F, int skip) {
    u32x2* ST = WSP(u32x2, WS_ST); const float* HD = WSP(float, WS_HDEC);
    if (F.bid < skip) return;
    for (int g = (F.bid - skip) * NTHR + F.tid; g < 16 * 4096; g += (F.G - skip) * NTHR) { const int bh = g >> 12, rem = g & 4095, v = rem >> 5, d4 = rem & 31;
        u32x2* p = ST + ((size_t)bh * 128 * 16384 + v * 128) / 4 + d4; const float* dp = HD + (size_t)bh * 128 * 128 + 4 * d4;
        float s0 = 0.f, s1 = 0.f, s2 = 0.f, s3 = 0.f;
        for (int n0 = 0; n0 < 128; n0 += 8) { u32x2 x[8]; f32x4 dc[8];
#pragma unroll
            for (int j = 0; j < 8; ++j) { x[j] = p[(size_t)(n0 + j) * 4096]; dc[j] = *(const f32x4*)(dp + (size_t)(n0 + j) * 128); }
#pragma unroll
            for (int j = 0; j < 8; ++j) { s0 = s0 * dc[j].x + __uint_as_float(x[j].x << 16); s1 = s1 * dc[j].y + __uint_as_float(x[j].x & 0xffff0000u);
                s2 = s2 * dc[j].z + __uint_as_float(x[j].y << 16); s3 = s3 * dc[j].w + __uint_as_float(x[j].y & 0xffff0000u);
                u32x2 o; o.x = cvt_pk_bf16(s0, s1); o.y = cvt_pk_bf16(s2, s3); p[(size_t)(n0 + j) * 4096] = o; } }
    }
}
__device__ __forceinline__ void pass3_unit(const Frame& F0_, ARGS_T& A, int l, int U, Raw& R, int Unext) {
    Frame F = F0_; { int t_ = F.tid; asm volatile("" : "+v"(t_)); F.tid = t_; F.lane = t_ & 63; }
    const int bh = U >> 7, n = U & 127, b = bh >> 2, h = bh & 3; const int c = F.tid & 127, seg = F.tid >> 7;
    if (n > 0) {
#pragma unroll
        for (int i = 0; i < 4; ++i) { const int idx = F.tid + i * NTHR, v = idx >> 4, ch = idx & 15; *(LAS u32x4*)(F.lds + L_ST + v * (PQ * 2) + ch * 16) = R.st[i]; } }
    Prep P; prep(F, A, l, h, R, true, P);
    { const float ref = seg < 2 ? 0.f : P.b31;
      LAS bf16* QD = (LAS bf16*)(F.lds + L_QD); LAS bf16* KD = (LAS bf16*)(F.lds + L_KD); LAS bf16* KO = (LAS bf16*)(F.lds + L_KO); LAS bf16* QS = (LAS bf16*)(F.lds + L_QS);
#pragma unroll
      for (int i = 0; i < 16; ++i) { const int t = seg * 16 + i;
          QD[t * PQ + c] = f2bf(P.q[i] * fast_exp2(P.bc[i] - ref)); KD[t * PQ + c] = f2bf(P.k[i] * fast_exp2(ref - P.bc[i])); QS[t * PQ + c] = f2bf(P.q[i] * fast_exp2(P.bc[i]));
          if (seg < 2) KO[t * PQ + c] = f2bf(P.k[i] * fast_exp2(P.b31 - P.bc[i])); } }
    store_vt(F, R);
    u32x4 g0 = R.g[0], g1 = R.g[1]; asm volatile("" : "+v"(g0), "+v"(g1));
    HG_BAR();
    if (Unext < 2048) load_raw<true>(F, Unext, R);
    const int lane = F.lane, r32 = lane & 31, hi = lane >> 5, tb = F.wave >> 2, vb = F.wave & 3;
    f32x16 o = f32x16{};
    const LAS unsigned char* qd = F.lds + L_QD + (tb * 32 + r32) * (PQ * 2) + hi * 16;
    const LAS unsigned char* vt = F.lds + L_VT + (vb * 32 + r32) * (PV * 2) + hi * 8;
#pragma unroll
    for (int sb = 0; sb < 2; ++sb) {
        if (sb <= tb) {
            const LAS unsigned char* kk = (sb == tb) ? F.lds + L_KD + (sb * 32 + r32) * (PQ * 2) + hi * 16 : F.lds + L_KO + r32 * (PQ * 2) + hi * 16;
            bf16x8 ka[8], qa[8];
#pragma unroll
            for (int ks = 0; ks < 8; ++ks) { ka[ks] = *(const LAS bf16x8*)(kk + ks * 32); qa[ks] = *(const LAS bf16x8*)(qd + ks * 32); }
            __builtin_amdgcn_sched_barrier(0);
            f32x16 x = f32x16{};
#pragma unroll
            for (int ks = 0; ks < 8; ++ks) x = __builtin_amdgcn_mfma_f32_32x32x16_bf16(ka[ks], qa[ks], x, 0, 0, 0);
            if (sb == tb) {
#pragma unroll
                for (int r = 0; r < 16; ++r) { const int s = (r & 3) + 8 * (r >> 2) + 4 * hi; if (s > r32) x[r] = 0.f; } }
#pragma unroll
            for (int s2 = 0; s2 < 2; ++s2) { const bf16x8 pa = att::pack8(x, 8 * s2);
                const s16x4 lo = *(const LAS s16x4*)(vt + (sb * 32 + s2 * 16) * 2), hh = *(const LAS s16x4*)(vt + (sb * 32 + s2 * 16 + 8) * 2);
                const bf16x8 vf = (bf16x8){lo[0], lo[1], lo[2], lo[3], hh[0], hh[1], hh[2], hh[3]};
                o = __builtin_amdgcn_mfma_f32_32x32x16_bf16(pa, vf, o, 0, 0, 0); }
        }
    }
    if (n > 0) { const LAS unsigned char* qs = F.lds + L_QS + (tb * 32 + r32) * (PQ * 2) + hi * 16; const LAS unsigned char* st = F.lds + L_ST + (vb * 32 + r32) * (PQ * 2) + hi * 16;
        bf16x8 qa[8], sa[8];
#pragma unroll
        for (int ks = 0; ks < 8; ++ks) { qa[ks] = *(const LAS bf16x8*)(qs + ks * 32); sa[ks] = *(const LAS bf16x8*)(st + ks * 32); }
        __builtin_amdgcn_sched_barrier(0);
#pragma unroll
        for (int ks = 0; ks < 8; ++ks) o = __builtin_amdgcn_mfma_f32_32x32x16_bf16(qa[ks], sa[ks], o, 0, 0, 0); }
    HG_BAR();
    LAS float* OST = (LAS float*)(F.lds + L_OST);
#pragma unroll
    for (int r = 0; r < 16; ++r) { const int t = tb * 32 + (r & 3) + 8 * (r >> 2) + 4 * hi; OST[t * 132 + vb * 32 + r32] = o[r]; }
    HG_BAR();
    { const int t = F.tid >> 3, v0 = (F.tid & 7) * 16; const size_t tok = (size_t)b * SEQ + n * 64 + t;
      f32x4 x[4]; float ss = 0.f;
#pragma unroll
      for (int j = 0; j < 4; ++j) { x[j] = *(const LAS f32x4*)(OST + t * 132 + v0 + 4 * j); ss += (x[j][0] * x[j][0] + x[j][1] * x[j][1]) + (x[j][2] * x[j][2] + x[j][3] * x[j][3]); }
      ss += __shfl_xor(ss, 1); ss += __shfl_xor(ss, 2); ss += __shfl_xor(ss, 4);
      const float rs = 1.f / sqrtf(ss * (1.f / 128.f) + LN_EPS);
      const float* gn = AIN(I_HNG) + l * 128 + v0;
      unsigned gw[8] = {g0.x, g0.y, g0.z, g0.w, g1.x, g1.y, g1.z, g1.w};
      unsigned w[8];
#pragma unroll
      for (int j = 0; j < 4; ++j) { const f32x4 gg = *(const f32x4*)(gn + 4 * j);
          const float y0 = x[j][0] * rs * gg[0] * __uint_as_float(gw[2 * j] << 16), y1 = x[j][1] * rs * gg[1] * __uint_as_float(gw[2 * j] & 0xffff0000u);
          const float y2 = x[j][2] * rs * gg[2] * __uint_as_float(gw[2 * j + 1] << 16), y3 = x[j][3] * rs * gg[3] * __uint_as_float(gw[2 * j + 1] & 0xffff0000u);
          w[2 * j] = cvt_pk_bf16(y0, y1); w[2 * j + 1] = cvt_pk_bf16(y2, y3); }
      bf16* Y = YMIXP(F) + tok * DM + 512 + h * 128 + v0;
      *(u32x4*)Y = (u32x4){w[0], w[1], w[2], w[3]}; *(u32x4*)(Y + 8) = (u32x4){w[4], w[5], w[6], w[7]}; }
    HG_BAR();
}
__device__ __forceinline__ void phase_pass3(const Frame& F, ARGS_T& A, int l) {
    Raw R; if (F.bid < 2048) load_raw<true>(F, F.bid, R);
    for (int U = F.bid; U < 2048; U += F.G) pass3_unit(F, A, l, U, R, U + F.G);
}
}
#define DEBUG_AFTER_PHASE(p) do{}while(0)
#define DEBUG_BEFORE_PHASE(p) do{}while(0)
#define DEBUG_FINAL() do{}while(0)
#ifndef DUP_B
#define DUP_B 1
#endif
#ifndef DUP_F
#define DUP_F 1
#endif
#ifndef DUP_G
#define DUP_G 1
#endif
#ifndef DUP_K
#define DUP_K 1
#endif
#ifndef DUP_LN1
#define DUP_LN1 1
#endif
#ifndef DUP_PRO
#define DUP_PRO 1
#endif
#ifndef DUP_BAR
#define DUP_BAR 1
#endif
#ifndef DUP_D
#define DUP_D 1
#endif
#ifndef DUP_HG1
#define DUP_HG1 1
#endif
#ifndef DUP_HG3
#define DUP_HG3 1
#endif
#ifndef DUP_FOX
#define DUP_FOX 1
#endif
#ifndef DUP_BAR
#define DUP_BAR 1
#endif
#ifndef DUP_DIFF
#define DUP_DIFF 1
#endif
#ifndef MK_N_LAUNCHES
#define MK_N_LAUNCHES 1
#endif

__global__ void __launch_bounds__(NTHR, 2) mk_fwd(Args args) {
    extern __shared__ __attribute__((aligned(16))) unsigned char lds_raw[];
    Frame F;
    F.lds = (LAS unsigned char*)lds_raw; F.ws = args.ws; F.ctl = (gu32*)(args.ws + WS_CTL); F.out = args.out;
    F.tid = threadIdx.x; F.lane = F.tid & 63; F.wave = __builtin_amdgcn_readfirstlane(F.tid >> 6); F.G = gridDim.x; F.bid = blockIdx.x;
    volatile LAS unsigned* MISC = (volatile LAS unsigned*)(F.lds + MISC_OFF);
    if (F.tid < 32) MISC[F.tid] = 0u;
    __syncthreads();
    const int lo = args.ph_lo, hi = args.ph_hi;
    XcdBarrier bar; bar.bar = (unsigned*)(F.ctl + CW_BAR); bar.x = 0; bar.st = nullptr;
    if (hi - lo > 1) bar = xcd_barrier_post((unsigned*)(F.ctl + CW_BAR), MISC + 8);
#ifdef ONLY_PH
#define IN(k) (((k) == 0 ? 0 : ((k) - 1) % NPH_L + 1) == ONLY_PH && lo <= (k) && (k) < hi)
#else
#define IN(k) (lo <= (k) && (k) < hi)
#endif
#if defined(TS_REPORT) || defined(TS_DELAY)
#define TS_STAMP(k) do { if (F0.bid == 0 && threadIdx.x == 0) __hip_atomic_store((unsigned*)(F0.ctl + 20000 + (k)), (unsigned)__builtin_amdgcn_s_memrealtime(), RLX_AGENT); } while (0)
#define SEAM(k) do { if ((k) + 1 < hi) { XcdBarrier b2_ = bar; asm volatile("" : "+s"(b2_.bar)); xcd_barrier(b2_); } TS_STAMP((k) + 1); } while (0)
#else
#define TS_STAMP(k) do {} while (0)
#define SEAM(k) do { if ((k) + 1 < hi) { XcdBarrier b2_ = bar; asm volatile("" : "+s"(b2_.bar)); for (int rb_ = 0; rb_ < DUP_BAR; ++rb_) xcd_barrier(b2_); } } while (0)
#endif
    ARGS_T* Ap = (ARGS_T*)__builtin_amdgcn_kernarg_segment_ptr();
#define A (*Ap)
    const Frame F0 = F;
#define FRESH() do { F = F0; int t_ = threadIdx.x; asm volatile("" : "+v"(t_)); F.tid = t_; F.lane = t_ & 63; Ap = (ARGS_T*)__builtin_amdgcn_kernarg_segment_ptr(); asm volatile("" : "+s"(Ap)); GAS unsigned char* w_ = Ap->ws; asm volatile("" : "+s"(w_)); F.ws = w_; F.ctl = (gu32*)(w_ + WS_CTL); GAS float* o_ = Ap->out; asm volatile("" : "+s"(o_)); F.out = o_; } while (0)
    TS_STAMP(0);
    if (IN(0)) { FRESH(); for (int rep_ = 0; rep_ < DUP_PRO; ++rep_) phase_prologue(F, A); SEAM(0); }
#pragma clang loop unroll(full)
    for (int l = 0; l < 2; ++l) {
        const int pb = 1 + NPH_L * l;
        if (IN(pb + 0)) { FRESH();
            fox_cumsum(F);
            pg8::ProjOrder S{(const char*)WSP(bf16, WS_R1), (const char*)WSP(bf16, WS_WIN), F.G, F.bid};
            pg8::EpiProj E{WSP(bf16, WS_PA), WSP(bf16, WS_HQ), WSP(bf16, WS_HI), WSP(bf16, WS_HG), WSP(bf16, WS_KMEM), WSP(bf16, WS_VT), WSP(float, WS_HF), (unsigned*)(F.ctl + CW_NRM + l * 128)};
#ifdef PROBE_PART_B
            { pg8::EpiPart<PROBE_PART_B> EN{WSP(bf16, WS_PA)}; pg8::gemm_phase<pg8::EpiPart<PROBE_PART_B>, pg8::ProjOrder, false, true>(F.lds + RING_OFF, DM, DM, DM, S, EN); }
#endif
#ifdef PROBE_NULL_B
            { pg8::EpiNull EN{WSP(float, WS_ST)}; pg8::gemm_phase<pg8::EpiNull, pg8::ProjOrder, false, true>(F.lds + RING_OFF, DM, DM, DM, S, EN); }
#endif
#ifdef PROBE_CLK
            const unsigned long long pc0_ = __builtin_readcyclecounter(), pr0_ = __builtin_amdgcn_s_memrealtime();
#endif
#ifdef PROBE_IMB
            const unsigned long long q0_ = __builtin_amdgcn_s_memrealtime();
            pg8::gemm_phase<pg8::EpiProj, pg8::ProjOrder, false, true>(F.lds + RING_OFF, DM, DM, DM, S, E);
            if (l == 0 && threadIdx.x == 0) { const unsigned d_ = (unsigned)(__builtin_amdgcn_s_memrealtime() - q0_);
                atomicMax((unsigned*)(F.ctl + CW_DBG), d_); atomicMax((unsigned*)(F.ctl + CW_DBG + 1), 1000000u - d_); atomicMax((unsigned*)(F.ctl + CW_DBG + 2), (d_ << 8) | (unsigned)F.bid); atomicMax((unsigned*)(F.ctl + CW_DBG + 3), ((1000000u - d_) << 8) | (unsigned)F.bid); }
            SEAM(pb + 0);
            if (l == 0 && F.bid == 0 && threadIdx.x == 0) {
                const unsigned mx_ = __hip_atomic_load((unsigned*)(F.ctl + CW_DBG), RLX_AGENT), mn_ = 1000000u - __hip_atomic_load((unsigned*)(F.ctl + CW_DBG + 1), RLX_AGENT);
                const unsigned bmx_ = __hip_atomic_load((unsigned*)(F.ctl + CW_DBG + 2), RLX_AGENT) & 255u, bmn_ = __hip_atomic_load((unsigned*)(F.ctl + CW_DBG + 3), RLX_AGENT) & 255u;
                const unsigned long long v_ = PROBE_IMB == 1 ? (unsigned long long)(mx_ - mn_) * 10ull : PROBE_IMB == 2 ? (unsigned long long)mx_ * 5ull : PROBE_IMB == 3 ? (unsigned long long)bmx_ * 1000ull : PROBE_IMB == 4 ? (unsigned long long)mn_ * 5ull : (unsigned long long)bmn_ * 1000ull;
                const unsigned long long until = __builtin_amdgcn_s_memrealtime() + v_;
                while (__builtin_amdgcn_s_memrealtime() < until) __builtin_amdgcn_s_sleep(32); }
            if (0) {
#elif defined(PROBE_GT) && !defined(PROBE_GD)
            unsigned long long pt_[6] = {0ull, 0ull, 0ull, 0ull, 0ull, 0ull}; unsigned long long pt3_[3] = {0ull, 0ull, 0ull};
            pg8::gemm_phase<pg8::EpiProj, pg8::ProjOrder, false, true>(F.lds + RING_OFF, DM, DM, DM, S, E, pt_);
            if (l == 0 && F.bid == PROBE_BID && threadIdx.x == 0) { const unsigned long long v_ = PROBE_GT == 1 ? pt_[0] : (PROBE_GT == 2 ? pt_[1] : pt_[2]);
                const unsigned long long until = __builtin_amdgcn_s_memrealtime() + v_ * (unsigned long long)PROBE_SCALE;
                while (__builtin_amdgcn_s_memrealtime() < until) __builtin_amdgcn_s_sleep(32); }
#else
            for (int rep_ = 0; rep_ < DUP_B; ++rep_) { pg8::gemm_phase<pg8::EpiProj, pg8::ProjOrder, false, true>(F.lds + RING_OFF, DM, DM, DM, S, E); }
#endif
#ifdef PROBE_IMB
            }
#endif
#ifdef PROBE_CLK
            if (l == 0) { const unsigned long long pc1_ = __builtin_readcyclecounter(), pr1_ = __builtin_amdgcn_s_memrealtime();
                if (F.bid == 0 && threadIdx.x == 0) { const float cpt = (float)(pc1_ - pc0_) / (float)(pr1_ - pr0_);
                    const unsigned steps = (unsigned)(cpt + 0.5f); const unsigned long long until = pr1_ + (unsigned long long)steps * 10000ull;
                    while (__builtin_amdgcn_s_memrealtime() < until) __builtin_amdgcn_s_sleep(32); } }
#endif
            SEAM(pb + 0);
        }
        if (IN(pb + 1)) { FRESH(); for (int rep_ = 0; rep_ < DUP_HG1; ++rep_) hg::phase_pass1(F, A, l); TS_STAMP(100 + l); for (int rep_ = 0; rep_ < DUP_FOX; ++rep_) att::attn_phase<0>(F, A, l); SEAM(pb + 1); }
        if (IN(pb + 2)) { FRESH();
            const int skip = F.G >= 64 ? 32 : 0;
            if (F.bid < 32) { pg8::MemKVOrder S{(const char*)WSP(bf16, WS_MEMB), (const char*)WSP(bf16, WS_WK), (const char*)WSP(bf16, WS_WV), F.bid};
                pg8::EpiProj E{WSP(bf16, WS_PA), WSP(bf16, WS_HQ), WSP(bf16, WS_HI), WSP(bf16, WS_HG), WSP(bf16, WS_KMEM), WSP(bf16, WS_VT), WSP(float, WS_HF), (unsigned*)(F.ctl + CW_NRM + l * 128)};
                pg8::gemm_phase<pg8::EpiProj, pg8::MemKVOrder, false, true>(F.lds + RING_OFF, DM, DM, DM, S, E); }
            hg::phase_scan(F, skip); SEAM(pb + 2); }
        if (IN(pb + 3)) { FRESH(); for (int rep_ = 0; rep_ < DUP_HG3; ++rep_) hg::phase_pass3(F, A, l); TS_STAMP(110 + l);
#ifdef ABL_DIFF
            att::attn_phase<1, ABL_DIFF>(F, A, l);
#endif
            for (int rep_ = 0; rep_ < DUP_DIFF; ++rep_) att::attn_phase<1>(F, A, l); SEAM(pb + 3); }
        if (IN(pb + 4)) { FRESH();
            pg8::DenseOrder S{(const char*)YMIXP(F), (const char*)WSP(bf16, WS_WOUT), DM, DM, MTOK / 256, 4, F.G, F.bid};
            pg8::EpiRes E{WSP(bf16, WS_R1), PREP(F)};
#ifdef PROBE_GD
            unsigned long long pt_[6] = {0ull, 0ull, 0ull, 0ull, 0ull, 0ull}; const unsigned long long qd0_ = __builtin_amdgcn_s_memrealtime();
            pg8::gemm_phase<pg8::EpiRes, pg8::DenseOrder, false, true>(F.lds + RING_OFF, DM, DM, DM, S, E, pt_);
            const unsigned long long qd1_ = __builtin_amdgcn_s_memrealtime();
            SEAM(pb + 4);
            if (l == 0 && F.bid == PROBE_BID && threadIdx.x == 0) { const unsigned long long qd2_ = __builtin_amdgcn_s_memrealtime();
                const unsigned long long v_ = PROBE_GD == 1 ? pt_[0] : PROBE_GD == 2 ? pt_[1] : PROBE_GD == 4 ? pt_[3] : PROBE_GD == 5 ? pt_[4] : PROBE_GD == 6 ? qd1_ - qd0_ : qd2_ - qd1_;
                const unsigned long long until = __builtin_amdgcn_s_memrealtime() + v_ * (unsigned long long)PROBE_SCALE;
                while (__builtin_amdgcn_s_memrealtime() < until) __builtin_amdgcn_s_sleep(32); }
#else
            for (int rep_ = 0; rep_ < DUP_D; ++rep_) { pg8::gemm_phase<pg8::EpiRes, pg8::DenseOrder, false, true>(F.lds + RING_OFF, DM, DM, DM, S, E); }
            SEAM(pb + 4);
#endif
        }
        if (IN(pb + 5)) { FRESH(); for (int rep_ = 0; rep_ < DUP_LN1; ++rep_) phase_ln1(F, A, l); SEAM(pb + 5); }
        if (IN(pb + 6)) { FRESH();
            { pg8::DenseOrder S{(const char*)WSP(bf16, WS_R1), (const char*)WSP(bf16, WS_WQ), DM, DM, MTOK / 256, 4, F.G, F.bid};
              pg8::EpiBf16 E{WSP(bf16, WS_Q), DM, pg8::C2_MEM};
              for (int rep_ = 0; rep_ < DUP_F; ++rep_) { pg8::gemm_phase<pg8::EpiBf16, pg8::DenseOrder, false, true>(F.lds + RING_OFF, DM, DM, DM, S, E); } }
            VM_WAIT(); __syncthreads();
            { pg8::XattnOrder S{(const char*)WSP(bf16, WS_Q), (const char*)WSP(bf16, WS_KMEM), 0, F.G, F.bid};
              pg8::EpiSoftmax E{WSP(bf16, WS_PATT), F.lds + XCH_OFF};
              for (int rep_ = 0; rep_ < DUP_G; ++rep_) { pg8::gemm_phase<pg8::EpiSoftmax, pg8::XattnOrder, false, true>(F.lds + RING_OFF, DM, DM, 256, S, E); } }
            VM_WAIT(); __syncthreads();
            { pg8::XattnOrder S{(const char*)WSP(bf16, WS_PATT), (const char*)WSP(bf16, WS_VT), 1, F.G, F.bid};
              pg8::EpiBf16 E{WSP(bf16, WS_OATT), DM, 1.f};
              for (int rep_ = 0; rep_ < DUP_G; ++rep_) { pg8::gemm_phase<pg8::EpiBf16, pg8::XattnOrder, false, true>(F.lds + RING_OFF, DM, DM, 256, S, E); } }
            SEAM(pb + 6);
        }
        if (IN(pb + 9)) { FRESH();
            pg8::DenseOrder S{(const char*)WSP(bf16, WS_OATT), (const char*)WSP(bf16, WS_WO), DM, DM, MTOK / 256, 4, F.G, F.bid};
            pg8::EpiRes E{WSP(bf16, WS_R1), PREP(F)};
            for (int rep_ = 0; rep_ < DUP_D; ++rep_) { pg8::gemm_phase<pg8::EpiRes, pg8::DenseOrder, false, true>(F.lds + RING_OFF, DM, DM, DM, S, E); }
            SEAM(pb + 9);
        }
        if (IN(pb + 10)) { FRESH(); phase_ln2_route(F, A, l); SEAM(pb + 10); }
        if (IN(pb + 11)) { FRESH();
            moe_tables(F, l);
            pg8::MoeOrder S{(const char*)WSP(bf16, WS_R1), (const char*)WSP(bf16, WS_W13), WSP(int, WS_LIST), (const LAS int*)(F.lds + TAB_OFF), 0, F.G, F.bid};
            pg8::EpiSwiGLU E{WSP(bf16, WS_HID)};
            for (int rep_ = 0; rep_ < DUP_K; ++rep_) { pg8::gemm_phase<pg8::EpiSwiGLU, pg8::MoeOrder, true, true>(F.lds + RING_OFF, DM, DM, DM, S, E); }
            SEAM(pb + 11);
        }
        if (IN(pb + 12)) { FRESH();
            moe_tables(F, l);
            pg8::MoeOrder S{(const char*)WSP(bf16, WS_HID), (const char*)WSP(bf16, WS_W2), WSP(int, WS_LIST), (const LAS int*)(F.lds + TAB_OFF), 1, F.G, F.bid};
            pg8::EpiMoeOut E{WSP(bf16, WS_CB), WSP(float, WS_GATE)};
            for (int rep_ = 0; rep_ < DUP_K; ++rep_) { pg8::gemm_phase<pg8::EpiMoeOut, pg8::MoeOrder, false, true>(F.lds + RING_OFF, EFF, EFF, EFF, S, E); }
            SEAM(pb + 12);
        }
        if (IN(pb + 13)) { FRESH(); phase_ln3(F, A, l); SEAM(pb + 13); }
    }
#ifdef TS_DELAY
    if (F0.bid == 0 && threadIdx.x == 0) { constexpr int ka = TS_DELAY; unsigned tot = 0;
        for (int l = 0; l < 2 && ka < 20; ++l) { const int pa = ka == 0 ? 0 : 1 + NPH_L * l + ka - 1; if (ka != 0 || l == 0) tot += __hip_atomic_load((unsigned*)(F0.ctl + 20000 + pa + 1), RLX_AGENT) - __hip_atomic_load((unsigned*)(F0.ctl + 20000 + (ka == 10 ? pa - 2 : pa)), RLX_AGENT); }
        if (ka == 20) tot = (__hip_atomic_load((unsigned*)(F0.ctl + 20100), RLX_AGENT) - __hip_atomic_load((unsigned*)(F0.ctl + 20000 + 2), RLX_AGENT)) + (__hip_atomic_load((unsigned*)(F0.ctl + 20101), RLX_AGENT) - __hip_atomic_load((unsigned*)(F0.ctl + 20000 + 2 + NPH_L), RLX_AGENT));
        if (ka == 21) tot = (__hip_atomic_load((unsigned*)(F0.ctl + 20110), RLX_AGENT) - __hip_atomic_load((unsigned*)(F0.ctl + 20000 + 4), RLX_AGENT)) + (__hip_atomic_load((unsigned*)(F0.ctl + 20111), RLX_AGENT) - __hip_atomic_load((unsigned*)(F0.ctl + 20000 + 4 + NPH_L), RLX_AGENT));
        if (ka >= 30 && ka < 30 + NPHASE) tot = __hip_atomic_load((unsigned*)(F0.ctl + 20000 + (ka - 30) + 1), RLX_AGENT) - __hip_atomic_load((unsigned*)(F0.ctl + 20000 + (ka - 30)), RLX_AGENT);
        if (ka == 99) tot = __hip_atomic_load((unsigned*)(F0.ctl + 20000 + NPHASE), RLX_AGENT) - __hip_atomic_load((unsigned*)(F0.ctl + 20000), RLX_AGENT);
        const unsigned long long until = __builtin_amdgcn_s_memrealtime() + (unsigned long long)tot * (unsigned long long)TS_SCALE;
        while (__builtin_amdgcn_s_memrealtime() < until) __builtin_amdgcn_s_sleep(32); }
#endif
#undef IN
#undef SEAM
#undef A
}

#ifdef TS_REPORT
__global__ void ts_encode(float* out, unsigned char* ws) {
    const unsigned* T = (const unsigned*)(ws + WS_CTL) + 20000; constexpr int ka = TS_REPORT; float ta = 0.f;
    for (int l = 0; l < 2; ++l) { const int pa = ka == 0 ? 0 : 1 + NPH_L * l + ka - 1; if (ka != 0 || l == 0) ta += 0.01f * (float)(T[pa + 1] - T[pa]); }
    const float c = sqrtf(ta * 0.1f);
    for (size_t i = (size_t)blockIdx.x * 256 + threadIdx.x; i < (size_t)MTOK * DM; i += (size_t)gridDim.x * 256) out[i] = c;
}
#endif
extern "C" void kernel_launch(void* const* d_in, const int* in_sizes, int n_in, void* d_out, int out_size, void* d_ws, size_t ws_size, hipStream_t stream) {
    static int grid = 0;
    if (grid == 0) {
        if (n_in != 25 || out_size != MTOK * DM || ws_size < WS_END) { fprintf(stderr, "kernel_launch: unexpected problem (n_in %d, out %d, ws %zu)\n", n_in, out_size, ws_size); grid = -1; return; }
        int dev = 0, cus = 0, per_cu = 0;
        if (hipGetDevice(&dev) != hipSuccess || hipDeviceGetAttribute(&cus, hipDeviceAttributeMultiprocessorCount, dev) != hipSuccess) { grid = -1; return; }
        if (hipFuncSetAttribute((const void*)mk_fwd, hipFuncAttributeMaxDynamicSharedMemorySize, LDS_BYTES) != hipSuccess) { fprintf(stderr, "kernel_launch: hipFuncSetAttribute failed\n"); grid = -1; return; }
        if (hipOccupancyMaxActiveBlocksPerMultiprocessor(&per_cu, (const void*)mk_fwd, NTHR, LDS_BYTES) != hipSuccess || per_cu < 1) fprintf(stderr, "kernel_launch: occupancy query says %d\n", per_cu);
        (void)hipGetLastError();
        grid = cus < 256 ? cus : 256;
    }
    if (grid < 0) return;
    (void)hipMemsetAsync((char*)d_ws + WS_CTL, 0, CTL_ZERO_BYTES, stream);
    Args a{};
    for (int i = 0; i < 25; ++i) a.in[i] = (const GAS float*)d_in[i];
    a.out = (GAS float*)d_out; a.ws = (GAS unsigned char*)d_ws;
#if MK_N_LAUNCHES == 1
    a.ph_lo = 0; a.ph_hi = NPHASE;
    hipLaunchKernelGGL(mk_fwd, dim3(grid), dim3(NTHR), LDS_BYTES, stream, a);
#ifdef TS_REPORT
    hipLaunchKernelGGL(ts_encode, dim3(1024), dim3(256), 0, stream, (float*)d_out, (unsigned char*)d_ws);
#endif
#else
    for (int p = 0; p < NPHASE; ++p) { DEBUG_BEFORE_PHASE(p); a.ph_lo = p; a.ph_hi = p + 1; hipLaunchKernelGGL(mk_fwd, dim3(grid), dim3(NTHR), LDS_BYTES, stream, a);
        DEBUG_AFTER_PHASE(p); }
    DEBUG_FINAL();
#endif
}
```

```cpp
#include <hip/hip_runtime.h>
#include <cstdio>
#include <cstdint>

#define GAS __attribute__((address_space(1)))
#define LAS __attribute__((address_space(3)))
typedef unsigned short bf16;
typedef short bf16x8 __attribute__((ext_vector_type(8)));
typedef short s16x4 __attribute__((ext_vector_type(4)));
typedef float f32x4 __attribute__((ext_vector_type(4)));
typedef float f32x2 __attribute__((ext_vector_type(2)));
typedef float f32x16 __attribute__((ext_vector_type(16)));
typedef unsigned u32x4 __attribute__((ext_vector_type(4)));
typedef unsigned u32x2 __attribute__((ext_vector_type(2)));
typedef GAS unsigned gu32;
#define RLX_AGENT __ATOMIC_RELAXED, __HIP_MEMORY_SCOPE_AGENT
#define LDS_WAIT() asm volatile("s_waitcnt lgkmcnt(0)" ::: "memory")
#define VM_WAIT() asm volatile("s_waitcnt vmcnt(0)" ::: "memory")

constexpr int DM = 1024, NB = 4, SEQ = 8192, MTOK = NB * SEQ;
constexpr int NIN = 3584;
constexpr int INW = 3588;
constexpr int NEXP = 16, EFF = 512;
constexpr float LN_EPS = 1e-5f;
constexpr float ALPHA = 1.4142135623730951f;
constexpr float LOG2E = 1.4426950408889634f;
constexpr int PA_LD = 1536;
constexpr int NWAVES = 8, NTHR = 512;

constexpr size_t MiB = 1u << 20;
constexpr size_t WS_CTL = 0, CTL_ZERO_BYTES = 128 * 1024;
constexpr size_t WS_CUMF = 1 * MiB;
constexpr size_t WS_LF2 = 1 * MiB + 512 * 1024;
constexpr size_t WS_LIST = 2 * MiB;
constexpr size_t WS_GATE = 4 * MiB;
constexpr size_t WS_HDEC = 4 * MiB + 512 * 1024;
constexpr size_t WS_MEMB = 6 * MiB;
constexpr size_t WS_KMEM = 8 * MiB;
constexpr size_t WS_VT = 10 * MiB;
constexpr size_t WS_WIN = 16 * MiB, WS_WOUT = 23 * MiB, WS_WQ = 25 * MiB, WS_WK = 27 * MiB, WS_WV = 29 * MiB, WS_WO = 31 * MiB, WS_W13 = 33 * MiB, WS_W2 = 65 * MiB;
constexpr size_t WS_R1 = 81 * MiB;
constexpr size_t WS_BIG = 145 * MiB;
constexpr size_t WS_PA = WS_BIG, WS_HQ = WS_BIG + 96 * MiB, WS_HI = WS_BIG + 128 * MiB, WS_HG = WS_BIG + 160 * MiB, WS_HF = WS_BIG + 192 * MiB, WS_ST = WS_BIG + 256 * MiB;
constexpr size_t WS_Q = WS_BIG, WS_PATT = WS_BIG + 64 * MiB, WS_OATT = WS_BIG + 128 * MiB;
constexpr size_t WS_HID = WS_BIG, WS_CB = WS_BIG + 68 * MiB;
constexpr size_t WS_END = WS_BIG + 320 * MiB;
static_assert(WS_CB + (size_t)MTOK * 2 * DM * 2 <= WS_END, "ws map");
constexpr int CW_TMO = 0, CW_CODE = 1, CW_BAR = 4096, CW_ECNT = 8192  , CW_DBG = 16384, CW_NRM = 12288  ;

__device__ __forceinline__ unsigned cvt_pk_bf16(float lo, float hi) { typedef __bf16 bf2 __attribute__((ext_vector_type(2))); f32x2 v = {lo, hi}; bf2 b = __builtin_convertvector(v, bf2); return __builtin_bit_cast(unsigned, b); }
__device__ __forceinline__ bf16 f2bf(float f) { return (bf16)(cvt_pk_bf16(f, 0.f) & 0xffffu); }
__device__ __forceinline__ float bf2f(bf16 b) { return __uint_as_float(((unsigned)b) << 16); }
__device__ __forceinline__ float wave_sum(float v) {
#pragma unroll
    for (int o = 1; o < 64; o <<= 1) v += __shfl_xor(v, o);
    return v;
}
__device__ __forceinline__ float fast_exp2(float x) { return __builtin_amdgcn_exp2f(x); }
__device__ __forceinline__ float fast_rcp(float x) { return __builtin_amdgcn_rcpf(x); }
__device__ __forceinline__ float sigmoidf_(float x) { return fast_rcp(1.f + fast_exp2(-x * LOG2E)); }
__device__ __forceinline__ float siluf_(float x) { return x * sigmoidf_(x); }
__device__ __forceinline__ float log_sigmoidf_(float x) { return fminf(x, 0.f) - log1pf(__expf(-fabsf(x))); }
constexpr int NPH_L = 14, NPHASE = 1 + 2 * NPH_L;
namespace pg8 {
constexpr int BM = 256, BK = 64, HALF = 128, HTB = HALF * BK * 2, STAGE_BYTES = 8 * HTB, NXCD = 8, WGM = 8;
__host__ __device__ __forceinline__ int lds_byte(int r, int c) { const int st = (r >> 4) * 2 + (c >> 5), rr = r & 15, cc = c & 31, ob = rr * 64 + cc * 2; return st * 1024 + (ob ^ (((ob >> 9) & 1) << 5)); }
__host__ __device__ __forceinline__ void stage_rc(int b, int& R, int& C) { const int st = b / 1024, sb = b % 1024, swz = sb ^ (((sb >> 9) & 1) << 5); R = (st >> 1) * 16 + swz / 64; C = (st & 1) * 32 + (swz % 64) / 2; }
__host__ __device__ __forceinline__ int perm32(int rho) { const int n = rho >> 4, i = rho & 15; return 8 * (i >> 2) + 4 * n + (i & 3); }

struct Unit { const char* a; const char* b; const int* rl; int pm, pn, nv, e; };

__device__ __forceinline__ void tile_of(int L, int nM, int nN, int& pm, int& pn) {
    const int nwg = nM * nN; int wgid = L; { const int q = nwg / NXCD, r = nwg % NXCD, xcd = wgid % NXCD, off = wgid / NXCD; wgid = (xcd < r ? xcd * (q + 1) : r * (q + 1) + (xcd - r) * q) + off; }
    const int nig = WGM * nN, gid = wgid / nig, fm = gid * WGM, gsz = (nM - fm) < WGM ? (nM - fm) : WGM;
    pm = fm + ((wgid % nig) % gsz); pn = (wgid % nig) / gsz;
}

template <class Epi, class Sched, bool GATHER, bool ALIGN_EPI>
__device__ __forceinline__ void gemm_phase(LAS unsigned char* lds, const int lda, const int ldb, const int K, const Sched& S, const Epi& E, unsigned long long* PT = nullptr) {
#ifdef PROBE_GT
#define PG8_RT(x) do { x = __builtin_amdgcn_s_memrealtime(); asm volatile("s_waitcnt lgkmcnt(0)" ::: "memory"); } while (0)
    unsigned long long ps0_ = 0, ps1_ = 0, ps2_ = 0, ps3_ = 0, pe_ = 0; bool pfirst_ = true;
    PG8_RT(pe_);
#endif
    int tid = threadIdx.x; asm volatile("" : "+v"(tid));
    const int wid = __builtin_amdgcn_readfirstlane(tid >> 6), lane = tid & 63, wr = wid >> 2, wc = wid & 3, fr = lane & 15, fq = lane >> 4;
    const int nt = K / BK;
    unsigned vB[2];
#pragma unroll
    for (int i = 0; i < 2; ++i) { int R, C; stage_rc(tid * 16 + i * 8192, R, C); const int Rb = Epi::PERM ? ((R & ~31) + perm32(R & 31)) : R; vB[i] = (unsigned)(Rb * ldb + C) * 2u; }
    const size_t kstep = (size_t)(BK * 2);
    const size_t hstepB = (size_t)HALF * ldb * 2;
    const unsigned ldsw = (unsigned)wid * 1024u;
    const int aoff = lds_byte(wr * 64 + fr, fq * 8), boff = lds_byte(wc * 32 + fr, fq * 8);
#define PG8_SA(b, h) (((b) * 2 + (h)) * HTB)
#define PG8_SB(b, h) ((4 + (b) * 2 + (h)) * HTB)
#define PG8_STAGE2(bufoff, gbase, v0, v1) do { \
        __builtin_amdgcn_global_load_lds((const unsigned*)((const char*)(gbase) + (v0)), (LAS unsigned*)(lds + (bufoff) + ldsw), 16, 0, 0); \
        __builtin_amdgcn_global_load_lds((const unsigned*)((const char*)(gbase) + (v1)), (LAS unsigned*)(lds + (bufoff) + ldsw + 8192), 16, 0, 0); } while (0)
#define PG8_STAGEB(bufoff, gbase) PG8_STAGE2(bufoff, gbase, vB[0], vB[1])
#define PG8_LDA(dst, b, h) do { _Pragma("unroll") for (int m = 0; m < 4; ++m) _Pragma("unroll") for (int k = 0; k < 2; ++k) dst[m][k] = *(const LAS bf16x8*)(lds + PG8_SA(b, h) + aoff + m * 2048 + k * 1024); } while (0)
#define PG8_LDB(dst, b, h) do { _Pragma("unroll") for (int n = 0; n < 2; ++n) _Pragma("unroll") for (int k = 0; k < 2; ++k) dst[n][k] = *(const LAS bf16x8*)(lds + PG8_SB(b, h) + boff + n * 2048 + k * 1024); } while (0)
#define PG8_MMA(ai, bj, At, Bt) do { __builtin_amdgcn_s_setprio(1); _Pragma("unroll") for (int m = 0; m < 4; ++m) _Pragma("unroll") for (int n = 0; n < 2; ++n) _Pragma("unroll") for (int k = 0; k < 2; ++k) \
        acc[ai][bj][m][n] = __builtin_amdgcn_mfma_f32_16x16x32_bf16(Bt[n][k], At[m][k], acc[ai][bj][m][n], 0, 0, 0); __builtin_amdgcn_s_setprio(0); } while (0)
#define PG8_WAIT_V(n) asm volatile("s_waitcnt vmcnt(" #n ")" ::: "memory")
#define PG8_WAIT_L(n) asm volatile("s_waitcnt lgkmcnt(" #n ")" ::: "memory")
#define PG8_BAR __builtin_amdgcn_s_barrier()
#define PG8_SCHED __builtin_amdgcn_sched_barrier(0)
    Unit cur, nxt; int ui = 0;
    if (!S.next(0, cur)) return;
    unsigned vA[2][2], nvA[2][2];
#define PG8_AOFFS(dst, u) do { int t2_ = tid; if constexpr (GATHER) asm volatile("" : "+v"(t2_)); int tk_[2][2]; \
        if constexpr (GATHER) { _Pragma("unroll") for (int i_ = 0; i_ < 2; ++i_) { int R_, C_; stage_rc(t2_ * 16 + i_ * 8192, R_, C_); \
            _Pragma("unroll") for (int h_ = 0; h_ < 2; ++h_) { int rr_ = h_ * HALF + R_; rr_ = rr_ < (u).nv ? rr_ : (u).nv - 1; tk_[h_][i_] = (u).rl[rr_]; } } \
            asm volatile("" : "+v"(tk_[0][0]), "+v"(tk_[0][1]), "+v"(tk_[1][0]), "+v"(tk_[1][1])); }      \
        _Pragma("unroll") for (int i_ = 0; i_ < 2; ++i_) { int R_, C_; stage_rc(t2_ * 16 + i_ * 8192, R_, C_); \
        _Pragma("unroll") for (int h_ = 0; h_ < 2; ++h_) { \
        if constexpr (GATHER) { const int tok_ = tk_[h_][i_] >> 1; dst[h_][i_] = (unsigned)(tok_ * lda + C_) * 2u; } \
        else dst[h_][i_] = (unsigned)((h_ * HALF + R_) * lda + C_) * 2u; } } } while (0)
    PG8_AOFFS(vA, cur);
    f32x4 acc[2][2][4][2];
#pragma unroll
    for (int a = 0; a < 2; ++a)
#pragma unroll
        for (int b = 0; b < 2; ++b)
#pragma unroll
            for (int m = 0; m < 4; ++m)
#pragma unroll
                for (int n = 0; n < 2; ++n) acc[a][b][m][n] = (f32x4){0.f, 0.f, 0.f, 0.f};
    bf16x8 At[4][2], B0[2][2], B1[2][2];
    const char* cA = cur.a; const char* cB = cur.b;
    PG8_STAGEB(PG8_SB(0, 0), cB); PG8_STAGEB(PG8_SB(0, 1), cB + hstepB); PG8_STAGE2(PG8_SA(0, 0), cA, vA[0][0], vA[0][1]); PG8_STAGE2(PG8_SA(0, 1), cA, vA[1][0], vA[1][1]);
    if (wr == 1) PG8_BAR;
    PG8_WAIT_V(2); PG8_BAR;
    PG8_STAGEB(PG8_SB(1, 0), cB + kstep); PG8_STAGE2(PG8_SA(1, 0), cA + kstep, vA[0][0], vA[0][1]); PG8_STAGEB(PG8_SB(1, 1), cB + hstepB + kstep);
    PG8_WAIT_V(6); PG8_BAR;
    for (;;) {
        const bool has_next = S.next(ui + 1, nxt);
        const char* nA = has_next ? nxt.a : cA; const char* nB = has_next ? nxt.b : cB;
        if constexpr (GATHER) { if (has_next) { PG8_AOFFS(nvA, nxt); } else {
#pragma unroll
            for (int h_ = 0; h_ < 2; ++h_)
#pragma unroll
                for (int i_ = 0; i_ < 2; ++i_) nvA[h_][i_] = vA[h_][i_]; } }
#ifdef PROBE_GT
        PG8_RT(ps0_);
        if (pfirst_ && PT) { PT[3] += ps0_ - pe_; pfirst_ = false; }
#endif
#pragma nounroll
        for (int t = 0; t < nt; t += 2) {
            const bool last = (t == nt - 2);
            const char* a1 = cA + (size_t)(t + 1) * kstep;
            const char* a2 = last ? nA : cA + (size_t)(t + 2) * kstep; const char* b2 = last ? nB : cB + (size_t)(t + 2) * kstep;
            const char* a3 = a2 + kstep; const char* b3 = b2 + kstep;
            unsigned x00, x01, x10, x11;
            if constexpr (GATHER) { x00 = last ? nvA[0][0] : vA[0][0]; x01 = last ? nvA[0][1] : vA[0][1]; x10 = last ? nvA[1][0] : vA[1][0]; x11 = last ? nvA[1][1] : vA[1][1]; }
            else { x00 = vA[0][0]; x01 = vA[0][1]; x10 = vA[1][0]; x11 = vA[1][1]; }
            PG8_LDB(B0, 0, 0); PG8_LDB(B1, 0, 1); PG8_SCHED; PG8_LDA(At, 0, 0); PG8_STAGE2(PG8_SA(1, 1), a1, vA[1][0], vA[1][1]);
            PG8_WAIT_V(8); PG8_WAIT_L(0); PG8_BAR; PG8_MMA(0, 0, At, B0); PG8_MMA(0, 1, At, B1); PG8_BAR; PG8_SCHED;
            PG8_LDA(At, 0, 1); PG8_STAGEB(PG8_SB(0, 0), b2); PG8_STAGEB(PG8_SB(0, 1), b2 + hstepB); PG8_STAGE2(PG8_SA(0, 0), a2, x00, x01);
            PG8_WAIT_V(8); PG8_WAIT_L(0); PG8_BAR; PG8_MMA(1, 0, At, B0); PG8_MMA(1, 1, At, B1); PG8_BAR; PG8_SCHED;
            PG8_LDB(B0, 1, 0); PG8_LDB(B1, 1, 1); PG8_SCHED; PG8_LDA(At, 1, 0); PG8_STAGE2(PG8_SA(0, 1), a2, x10, x11);
            PG8_WAIT_V(8); PG8_WAIT_L(0); PG8_BAR; PG8_MMA(0, 0, At, B0); PG8_MMA(0, 1, At, B1); PG8_BAR; PG8_SCHED;
            PG8_LDA(At, 1, 1); PG8_STAGEB(PG8_SB(1, 0), b3); PG8_STAGEB(PG8_SB(1, 1), b3 + hstepB); PG8_STAGE2(PG8_SA(1, 0), a3, x00, x01);
            PG8_WAIT_V(8); PG8_WAIT_L(0); PG8_BAR; PG8_MMA(1, 0, At, B0); PG8_MMA(1, 1, At, B1); PG8_BAR; PG8_SCHED;
        }
#ifdef PROBE_GT
        PG8_RT(ps1_);
#endif
        if constexpr (ALIGN_EPI) { if (wr == 0) PG8_BAR; }
        if constexpr (!Epi::AFTER_DRAIN) { int fr_ = fr, fq_ = fq; asm volatile("" : "+v"(fr_), "+v"(fq_)); E(acc, cur, wr, wc, fr_, fq_); }
#ifdef PROBE_GT
        PG8_RT(ps2_);
        if (PROBE_GT == 3 && PT) { asm volatile("s_waitcnt vmcnt(0)" ::: "memory"); PG8_RT(ps3_); }
        if (PT) { PT[0] += ps1_ - ps0_; PT[1] += ps2_ - ps1_; if (PROBE_GT == 3) PT[2] += ps3_ - ps2_; }
#endif
        if (!has_next) break;
#pragma unroll
        for (int a = 0; a < 2; ++a)
#pragma unroll
            for (int b = 0; b < 2; ++b)
#pragma unroll
                for (int m = 0; m < 4; ++m)
#pragma unroll
                    for (int n = 0; n < 2; ++n) acc[a][b][m][n] = (f32x4){0.f, 0.f, 0.f, 0.f};
        cur = nxt; cA = nA; cB = nB; ++ui;
        if constexpr (GATHER) {
#pragma unroll
            for (int h_ = 0; h_ < 2; ++h_)
#pragma unroll
                for (int i_ = 0; i_ < 2; ++i_) vA[h_][i_] = nvA[h_][i_]; }
        if constexpr (ALIGN_EPI) { if (wr == 1) PG8_BAR; }
    }
    PG8_WAIT_V(0);
    if constexpr (!ALIGN_EPI) { if (wr == 0) PG8_BAR; }
    PG8_BAR;
    if constexpr (Epi::AFTER_DRAIN) { E.fused(acc, cur, wr, wc, fr, fq, lds, wid, lane); }
#ifdef PROBE_GT
    PG8_RT(ps3_); if (PT) PT[4] += ps3_ - ps2_;
#endif
#undef PG8_AOFFS
#undef PG8_SA
#undef PG8_SB
#undef PG8_STAGE2
#undef PG8_STAGEB
#undef PG8_LDA
#undef PG8_LDB
#undef PG8_MMA
#undef PG8_WAIT_V
#undef PG8_WAIT_L
#undef PG8_BAR
#undef PG8_SCHED
}
}
constexpr int RING_OFF = 0, RING_BYTES = 131072;
constexpr int XCH_OFF = RING_BYTES;
constexpr int TAB_OFF = XCH_OFF + 8192;
constexpr int MISC_OFF = TAB_OFF + 512;
constexpr int LDS_BYTES = 147456;
static_assert(MISC_OFF + 128 <= LDS_BYTES, "LDS map");

#ifdef NT_STORES
#define ST_U4(p, v) __builtin_nontemporal_store((v), (u32x4*)(p))
#define ST_F4(p, v) __builtin_nontemporal_store((v), (f32x4*)(p))
#else
#define ST_U4(p, v) (*(u32x4*)(p) = (v))
#define ST_F4(p, v) (*(f32x4*)(p) = (v))
#endif
namespace pg8 {
template <int ACT>
__device__ __forceinline__ void tile_store_bf16(const f32x4 (&acc)[2][2][4][2], bf16* dst, int ld, float sc, int wr, int wc, int fr, int fq) {
    bf16* p0 = dst + (size_t)(wr * 64 + fr) * ld + wc * 32 + 8 * fq;
#pragma unroll
    for (int ai = 0; ai < 2; ++ai)
#pragma unroll
        for (int m = 0; m < 4; ++m) { bf16* rowp = p0 + (size_t)(ai * HALF + m * 16) * ld;
#pragma unroll
            for (int bj = 0; bj < 2; ++bj) { f32x4 v0 = acc[ai][bj][m][0], v1 = acc[ai][bj][m][1];
                if (ACT == 1) {
#pragma unroll
                    for (int i = 0; i < 4; ++i) { v0[i] = siluf_(v0[i]); v1[i] = siluf_(v1[i]); } }
                v0 = v0 * sc; v1 = v1 * sc; u32x4 w; w.x = cvt_pk_bf16(v0[0], v0[1]); w.y = cvt_pk_bf16(v0[2], v0[3]); w.z = cvt_pk_bf16(v1[0], v1[1]); w.w = cvt_pk_bf16(v1[2], v1[3]);
                ST_U4(rowp + bj * HALF, w); } }
}
__device__ __forceinline__ void tile_store_f32(const f32x4 (&acc)[2][2][4][2], float* dst, int ld, int wr, int wc, int fr, int fq) {
    float* p0 = dst + (size_t)(wr * 64 + fr) * ld + wc * 32 + 8 * fq;
#pragma unroll
    for (int ai = 0; ai < 2; ++ai)
#pragma unroll
        for (int m = 0; m < 4; ++m) { float* rowp = p0 + (size_t)(ai * HALF + m * 16) * ld;
#pragma unroll
            for (int bj = 0; bj < 2; ++bj) { ST_F4(rowp + bj * HALF, acc[ai][bj][m][0]); ST_F4(rowp + bj * HALF + 4, acc[ai][bj][m][1]); } }
}

constexpr float C2_FOX = 0.125f * LOG2E, C2_DIFF = 0.17677669529663687f * LOG2E, C2_MEM = 0.0625f * LOG2E;

struct EpiProj {
    static constexpr bool PERM = true, AFTER_DRAIN = false;
    bf16 *PA, *HQ, *HI, *HG, *KMEM, *VT; float* HF; unsigned* NRM;
    __device__ __forceinline__ void operator()(f32x4 (&acc)[2][2][4][2], const Unit& u, int wr, int wc, int fr, int fq) const {
        const size_t row0 = (size_t)u.pm * BM; const int pn = u.pn;
        if (u.e == 0) {
            if (pn < 6) { const float sc = pn == 0 ? C2_FOX : (pn == 3 ? C2_DIFF : 1.f); tile_store_bf16<0>(acc, PA + row0 * PA_LD + pn * 256, PA_LD, sc, wr, wc, fr, fq);
                if (pn != 2 && pn != 5) {
#pragma unroll
                    for (int bj = 0; bj < 2; ++bj) { float mx = 0.f;
#pragma unroll
                        for (int ai = 0; ai < 2; ++ai)
#pragma unroll
                            for (int m = 0; m < 4; ++m) { const f32x4 a = acc[ai][bj][m][0] * sc, b = acc[ai][bj][m][1] * sc; float ss = (a[0] * a[0] + a[1] * a[1]) + (a[2] * a[2] + a[3] * a[3]) + (b[0] * b[0] + b[1] * b[1]) + (b[2] * b[2] + b[3] * b[3]);
                                ss += __shfl_xor(ss, 16); ss += __shfl_xor(ss, 32); mx = fmaxf(mx, ss); }
#pragma unroll
                        for (int o = 1; o < 16; o <<= 1) mx = fmaxf(mx, __shfl_xor(mx, o));
                        if (fr == 0 && fq == 0) { const int bh = (u.pm / (SEQ / 256)) * 4 + 2 * bj + (wc >> 1); atomicMax(NRM + (((pn < 2 ? pn : pn - 1) * 16 + bh) * 2 + (wc & 1)), __float_as_uint(mx)); } } } }
            else if (pn < 8) tile_store_bf16<1>(acc, HQ + row0 * 512 + (pn - 6) * 256, 512, 1.f, wr, wc, fr, fq);
            else if (pn < 10) tile_store_bf16<0>(acc, (bf16*)HF + row0 * 512 + (pn - 8) * 256, 512, 1.f, wr, wc, fr, fq);
            else if (pn < 12) tile_store_bf16<0>(acc, HI + row0 * 512 + (pn - 10) * 256, 512, 1.f, wr, wc, fr, fq);
            else tile_store_bf16<1>(acc, HG + row0 * 512 + (pn - 12) * 256, 512, 1.f, wr, wc, fr, fq);
        } else if (u.e == 1) tile_store_bf16<0>(acc, KMEM + row0 * 1024 + pn * 256, 1024, 1.f, wr, wc, fr, fq);
        else tile_store_bf16<0>(acc, VT + row0 * 1024 + pn * 256, 1024, 1.f, wr, wc, fr, fq);
    }
};
struct EpiNull {
    static constexpr bool PERM = true, AFTER_DRAIN = false;
    float* sink;
    __device__ __forceinline__ void operator()(f32x4 (&acc)[2][2][4][2], const Unit& u, int wr, int wc, int fr, int fq) const {
        f32x4 s = {0.f, 0.f, 0.f, 0.f};
#pragma unroll
        for (int ai = 0; ai < 2; ++ai)
#pragma unroll
            for (int bj = 0; bj < 2; ++bj)
#pragma unroll
                for (int m = 0; m < 4; ++m) { s += acc[ai][bj][m][0]; s += acc[ai][bj][m][1]; }
        if ((s[0] + s[1]) + (s[2] + s[3]) == 1234567.125f) sink[fr] = s[0];
    }
};
template <int AIS> struct EpiPart {
    static constexpr bool PERM = true, AFTER_DRAIN = false;
    bf16* O;
    __device__ __forceinline__ void operator()(f32x4 (&acc)[2][2][4][2], const Unit& u, int wr, int wc, int fr, int fq) const {
        bf16* p0 = O + ((size_t)u.pm * BM + wr * 64 + fr) * NIN + u.pn * BM + wc * 32 + 8 * fq;
#pragma unroll
        for (int ai = 0; ai < AIS; ++ai)
#pragma unroll
            for (int m = 0; m < 4; ++m) { bf16* rowp = p0 + (size_t)(ai * HALF + m * 16) * NIN;
#pragma unroll
                for (int bj = 0; bj < 2; ++bj) { const f32x4 v0 = acc[ai][bj][m][0], v1 = acc[ai][bj][m][1]; u32x4 w; w.x = cvt_pk_bf16(v0[0], v0[1]); w.y = cvt_pk_bf16(v0[2], v0[3]); w.z = cvt_pk_bf16(v1[0], v1[1]); w.w = cvt_pk_bf16(v1[2], v1[3]);
                    ST_U4(rowp + bj * HALF, w); } }
        if (AIS < 2) { f32x4 s = {0.f, 0.f, 0.f, 0.f};
#pragma unroll
            for (int bj = 0; bj < 2; ++bj)
#pragma unroll
                for (int m = 0; m < 4; ++m) { s += acc[1][bj][m][0]; s += acc[1][bj][m][1]; }
            if ((s[0] + s[1]) + (s[2] + s[3]) == 1234567.125f) O[fr] = 0; }
    }
};
struct EpiBf16 {
    static constexpr bool PERM = true, AFTER_DRAIN = false;
    bf16* O; int ld; float sc;
    __device__ __forceinline__ void operator()(f32x4 (&acc)[2][2][4][2], const Unit& u, int wr, int wc, int fr, int fq) const {
        tile_store_bf16<0>(acc, O + (size_t)u.pm * BM * ld + u.pn * BM, ld, sc, wr, wc, fr, fq);
    }
};
struct EpiRes {
    static constexpr bool PERM = true, AFTER_DRAIN = false;
    const bf16* H; bf16* PRE;
    __device__ __forceinline__ void operator()(f32x4 (&acc)[2][2][4][2], const Unit& u, int wr, int wc, int fr, int fq) const {
        const size_t o0 = ((size_t)u.pm * BM + wr * 64 + fr) * DM + u.pn * BM + wc * 32 + 8 * fq;
        u32x4 hv[2][4][2];
#pragma unroll
        for (int ai = 0; ai < 2; ++ai)
#pragma unroll
            for (int m = 0; m < 4; ++m)
#pragma unroll
                for (int bj = 0; bj < 2; ++bj) hv[ai][m][bj] = *(const u32x4*)(H + o0 + (size_t)(ai * HALF + m * 16) * DM + bj * HALF);
        __builtin_amdgcn_sched_barrier(0);
#pragma unroll
        for (int ai = 0; ai < 2; ++ai)
#pragma unroll
            for (int m = 0; m < 4; ++m) { const size_t o1 = o0 + (size_t)(ai * HALF + m * 16) * DM;
#pragma unroll
                for (int bj = 0; bj < 2; ++bj) { const u32x4 h4 = hv[ai][m][bj]; const f32x4 a = acc[ai][bj][m][0], b = acc[ai][bj][m][1]; u32x4 w;
                    w.x = cvt_pk_bf16(__uint_as_float(h4.x << 16) * ALPHA + a[0], __uint_as_float(h4.x & 0xffff0000u) * ALPHA + a[1]); w.y = cvt_pk_bf16(__uint_as_float(h4.y << 16) * ALPHA + a[2], __uint_as_float(h4.y & 0xffff0000u) * ALPHA + a[3]);
                    w.z = cvt_pk_bf16(__uint_as_float(h4.z << 16) * ALPHA + b[0], __uint_as_float(h4.z & 0xffff0000u) * ALPHA + b[1]); w.w = cvt_pk_bf16(__uint_as_float(h4.w << 16) * ALPHA + b[2], __uint_as_float(h4.w & 0xffff0000u) * ALPHA + b[3]);
                    ST_U4(PRE + o1 + bj * HALF, w); } }
    }
};
struct EpiSoftmax {
    static constexpr bool PERM = true, AFTER_DRAIN = false;
    bf16* P; LAS unsigned char* xch;
    __device__ __forceinline__ void operator()(f32x4 (&acc)[2][2][4][2], const Unit& u, int wr, int wc, int fr, int fq) const {
        LAS float* X1 = (LAS float*)xch; LAS float* X2 = X1 + 1024;
        float mx[2][4];
#pragma unroll
        for (int ai = 0; ai < 2; ++ai)
#pragma unroll
            for (int m = 0; m < 4; ++m) { float v = -INFINITY;
#pragma unroll
                for (int bj = 0; bj < 2; ++bj)
#pragma unroll
                    for (int n = 0; n < 2; ++n) { const f32x4 x = acc[ai][bj][m][n]; v = fmaxf(v, fmaxf(fmaxf(x[0], x[1]), fmaxf(x[2], x[3]))); }
                v = fmaxf(v, __shfl_xor(v, 16)); v = fmaxf(v, __shfl_xor(v, 32)); mx[ai][m] = v;
                if (fq == 0) X1[(ai * HALF + wr * 64 + m * 16 + fr) * 4 + wc] = v; }
        asm volatile("s_waitcnt lgkmcnt(0)" ::: "memory"); __builtin_amdgcn_s_barrier(); asm volatile("" ::: "memory");
        float sm[2][4];
#pragma unroll
        for (int ai = 0; ai < 2; ++ai)
#pragma unroll
            for (int m = 0; m < 4; ++m) { const f32x4 q = *(const LAS f32x4*)(X1 + (ai * HALF + wr * 64 + m * 16 + fr) * 4); const float M_ = fmaxf(fmaxf(q[0], q[1]), fmaxf(q[2], q[3])); float s = 0.f;
#pragma unroll
                for (int bj = 0; bj < 2; ++bj)
#pragma unroll
                    for (int n = 0; n < 2; ++n) { f32x4 x = acc[ai][bj][m][n];
#pragma unroll
                        for (int i = 0; i < 4; ++i) { x[i] = fast_exp2(x[i] - M_); s += x[i]; } acc[ai][bj][m][n] = x; }
                s += __shfl_xor(s, 16); s += __shfl_xor(s, 32); sm[ai][m] = s;
                if (fq == 0) X2[(ai * HALF + wr * 64 + m * 16 + fr) * 4 + wc] = s; }
        asm volatile("s_waitcnt lgkmcnt(0)" ::: "memory"); __builtin_amdgcn_s_barrier(); asm volatile("" ::: "memory");
        bf16* p0 = P + ((size_t)u.pm * BM + wr * 64 + fr) * DM + u.pn * BM + wc * 32 + 8 * fq;
#pragma unroll
        for (int ai = 0; ai < 2; ++ai)
#pragma unroll
            for (int m = 0; m < 4; ++m) { const f32x4 q = *(const LAS f32x4*)(X2 + (ai * HALF + wr * 64 + m * 16 + fr) * 4); const float inv = fast_rcp((q[0] + q[1]) + (q[2] + q[3]));
                bf16* rowp = p0 + (size_t)(ai * HALF + m * 16) * DM;
#pragma unroll
                for (int bj = 0; bj < 2; ++bj) { const f32x4 v0 = acc[ai][bj][m][0] * inv, v1 = acc[ai][bj][m][1] * inv; u32x4 w; w.x = cvt_pk_bf16(v0[0], v0[1]); w.y = cvt_pk_bf16(v0[2], v0[3]); w.z = cvt_pk_bf16(v1[0], v1[1]); w.w = cvt_pk_bf16(v1[2], v1[3]);
                    ST_U4(rowp + bj * HALF, w); } }
        (void)mx; (void)sm;
    }
};
struct EpiSwiGLU {
    static constexpr bool PERM = true, AFTER_DRAIN = false;
    bf16* HID;
    __device__ __forceinline__ void operator()(f32x4 (&acc)[2][2][4][2], const Unit& u, int wr, int wc, int fr, int fq) const {
        bf16* p0 = HID + ((size_t)u.pm * BM + wr * 64 + fr) * EFF + u.pn * 128 + wc * 32 + 8 * fq;
#pragma unroll
        for (int ai = 0; ai < 2; ++ai)
#pragma unroll
            for (int m = 0; m < 4; ++m) { f32x4 v0 = acc[ai][0][m][0], v1 = acc[ai][0][m][1]; const f32x4 g0 = acc[ai][1][m][0], g1 = acc[ai][1][m][1];
#pragma unroll
                for (int i = 0; i < 4; ++i) { v0[i] = siluf_(v0[i]) * g0[i]; v1[i] = siluf_(v1[i]) * g1[i]; }
                u32x4 w; w.x = cvt_pk_bf16(v0[0], v0[1]); w.y = cvt_pk_bf16(v0[2], v0[3]); w.z = cvt_pk_bf16(v1[0], v1[1]); w.w = cvt_pk_bf16(v1[2], v1[3]);
                ST_U4(p0 + (size_t)(ai * HALF + m * 16) * EFF, w); }
    }
};
struct EpiMoeOut {
    static constexpr bool PERM = true, AFTER_DRAIN = false;
    bf16* CB; const float* GATE;
    __device__ __forceinline__ void operator()(f32x4 (&acc)[2][2][4][2], const Unit& u, int wr, int wc, int fr, int fq) const {
        const int colb = u.pn * BM + wc * 32 + 8 * fq;
        int dst[2][4]; float gt[2][4];
#pragma unroll
        for (int ai = 0; ai < 2; ++ai)
#pragma unroll
            for (int m = 0; m < 4; ++m) { const int r = ai * HALF + wr * 64 + m * 16 + fr; dst[ai][m] = u.rl[r < u.nv ? r : u.nv - 1]; }
#pragma unroll
        for (int ai = 0; ai < 2; ++ai)
#pragma unroll
            for (int m = 0; m < 4; ++m) gt[ai][m] = GATE[dst[ai][m]];
        __builtin_amdgcn_sched_barrier(0);
#pragma unroll
        for (int ai = 0; ai < 2; ++ai)
#pragma unroll
            for (int m = 0; m < 4; ++m) { const int r = ai * HALF + wr * 64 + m * 16 + fr;
                if (r < u.nv) { const float g = gt[ai][m]; bf16* rowp = CB + (size_t)dst[ai][m] * DM + colb;
#pragma unroll
                    for (int bj = 0; bj < 2; ++bj) { const f32x4 v0 = acc[ai][bj][m][0] * g, v1 = acc[ai][bj][m][1] * g; u32x4 w; w.x = cvt_pk_bf16(v0[0], v0[1]); w.y = cvt_pk_bf16(v0[2], v0[3]); w.z = cvt_pk_bf16(v1[0], v1[1]); w.w = cvt_pk_bf16(v1[2], v1[3]);
                        ST_U4(rowp + bj * HALF, w); } } }
    }
};

struct DenseOrder {
    const char* A; const char* Bt; int lda, ldb, nM, nN, G, c;
    __device__ __forceinline__ bool next(int i, Unit& u) const {
        const int L = i * G + c; if (L >= nM * nN) return false;
        tile_of(L, nM, nN, u.pm, u.pn); u.a = A + (size_t)u.pm * BM * lda * 2; u.b = Bt + (size_t)u.pn * BM * ldb * 2; u.rl = nullptr; u.nv = 256; u.e = 0; return true;
    }
};
struct ProjOrder {
    const char* HB; const char* WIN; int G, c;
    __device__ __forceinline__ bool next(int i, Unit& u) const {
        const int L = i * G + c; constexpr int NP = (MTOK / 256) * (NIN / 256);
        if (L >= NP) return false;
        u.rl = nullptr; u.nv = 256; tile_of(L, MTOK / 256, NIN / 256, u.pm, u.pn); u.a = HB + (size_t)u.pm * BM * DM * 2; u.b = WIN + (size_t)u.pn * BM * DM * 2; u.e = 0;
        return true;
    }
};
struct MemKVOrder {
    const char* MEMB; const char* WK; const char* WV; int c;
    __device__ __forceinline__ bool next(int i, Unit& u) const {
        if (i > 0 || c >= 32) return false;
        const int j = c; u.rl = nullptr; u.nv = 256; u.pm = (j & 15) >> 2; u.pn = j & 3;
        if (j < 16) { u.a = MEMB + (size_t)u.pm * BM * DM * 2; u.b = WK + (size_t)u.pn * BM * DM * 2; u.e = 1; }
        else { u.a = WV + (size_t)u.pm * BM * DM * 2; u.b = MEMB + (size_t)u.pn * BM * DM * 2; u.e = 2; }
        return true;
    }
};
struct XattnOrder {
    const char* A; const char* B; int mode, G, c;
    __device__ __forceinline__ bool next(int i, Unit& u) const {
        const int L = i * G + c; if (L >= (MTOK / 256) * 4) return false;
        tile_of(L, MTOK / 256, 4, u.pm, u.pn); const int bt = u.pm / (SEQ / 256);
        u.a = A + ((size_t)u.pm * BM * DM + u.pn * 256) * 2;
        u.b = mode == 0 ? B + ((size_t)bt * 256 * DM + u.pn * 256) * 2 : B + ((size_t)u.pn * 256 * DM + bt * 256) * 2;
        u.rl = nullptr; u.nv = 256; u.e = 0; return true;
    }
};
#ifndef MOE_XCD
#define MOE_XCD 1
#endif
struct MoeOrder {
    const char* A; const char* W; const int* LIST; const LAS int* T; int mode  , G, c;
    __device__ __forceinline__ bool next(int i, Unit& u) const {
        const int ntile = T[16]; int mt, pn_;
        if (MOE_XCD && G == 256) { const int x = c & 7, k = c >> 3; mt = (i * 8 + (k >> 2)) * 8 + x; pn_ = k & 3; if (mt >= ntile) return false; }
        else { const int L = i * G + c; if (L >= ntile * 4) return false; mt = L >> 2; pn_ = L & 3; }
        u.pn = pn_; int e = 0;
#pragma unroll
        for (int j = 1; j < 16; ++j) e += (T[j] <= mt) ? 1 : 0;
        const int r0 = (mt - T[e]) * 256, ne = T[32 + e];
        u.e = e; u.pm = mt; u.nv = (ne - r0) < 256 ? (ne - r0) : 256; u.rl = LIST + (size_t)e * MTOK + r0;
        if (mode == 0) { u.a = A; u.b = W + ((size_t)e * 1024 + u.pn * 256) * DM * 2; }
        else { u.a = A + (size_t)mt * BM * EFF * 2; u.b = W + ((size_t)e * 1024 + u.pn * 256) * EFF * 2; }
        return true;
    }
};
struct EpiXattn {
    static constexpr bool HOOKS = false;
    static constexpr bool PERM = true, AFTER_DRAIN = false;
    EpiSoftmax SM; EpiBf16 OB;
    __device__ __forceinline__ void operator()(f32x4 (&acc)[2][2][4][2], const Unit& u, int wr, int wc, int fr, int fq) const { if (u.e == 0) SM(acc, u, wr, wc, fr, fq); else OB(acc, u, wr, wc, fr, fq); }
};
struct XattnOrder2 {
    const char* Q; const char* KM; const char* PATT; const char* VT; int G, c;
    __device__ __forceinline__ bool next(int i, Unit& u) const {
        constexpr int NU = (MTOK / 256) * 4; const int nu = (NU - c + G - 1) / G; if (i >= 2 * nu) return false;
        const int mode = i >= nu ? 1 : 0, L = (mode ? i - nu : i) * G + c;
        tile_of(L, MTOK / 256, 4, u.pm, u.pn); const int bt = u.pm / (SEQ / 256);
        u.a = (mode == 0 ? Q : PATT) + ((size_t)u.pm * BM * DM + u.pn * 256) * 2;
        u.b = mode == 0 ? KM + ((size_t)bt * 256 * DM + u.pn * 256) * 2 : VT + ((size_t)u.pn * 256 * DM + bt * 256) * 2;
        u.rl = nullptr; u.nv = 256; u.e = mode; return true;
    }
};
}
#define XB_TMO      128
#define XB_XCNT(j)  (256  + 64 * (j))
#define XB_XSUB(j)  (1280 + 64 * (j))
#define XB_XGEN(j)  (2304 + 64 * (j))
#define XB_TOP      3328
#define XB_TOPGEN   3392
#define XCD_BAR_WORDS 3456
#define XB_SPIN_CAP (1u << 18)
__device__ __forceinline__ unsigned xb_ld(unsigned* p)              { return __hip_atomic_load(p, __ATOMIC_RELAXED, __HIP_MEMORY_SCOPE_AGENT); }
__device__ __forceinline__ unsigned xb_add(unsigned* p, unsigned v) { return __hip_atomic_fetch_add(p, v, __ATOMIC_RELAXED, __HIP_MEMORY_SCOPE_AGENT); }
__device__ __forceinline__ unsigned xb_xcc_id() { return (unsigned)__builtin_amdgcn_s_getreg((3 << 11) | 20) & 0xFu; }
#define XB_SPIN(cond, bar) do { unsigned _sp = 0; while (cond) { __builtin_amdgcn_s_sleep(1); \
    if ((++_sp & 255u) == 0u) { if (xb_ld(&(bar)[XB_TMO])) break; if (_sp > XB_SPIN_CAP) { atomicAdd(&(bar)[XB_TMO], 1u); break; } } } } while (0)
struct XcdBarrier { unsigned* bar; unsigned x; volatile LAS unsigned* st; };
__device__ __forceinline__ XcdBarrier xcd_barrier_post(unsigned* bar, volatile LAS unsigned* st) {
    XcdBarrier b; b.bar = bar; b.x = xb_xcc_id(); b.st = st;
    if (threadIdx.x == 0) (void)xb_add(&bar[XB_XCNT(b.x)], 1u);
    return b;
}
__device__ __forceinline__ void xcd_barrier_complete(unsigned* bar, unsigned x, unsigned& nloc, unsigned& nx) {
    const unsigned G = gridDim.x * gridDim.y * gridDim.z;
    unsigned sum, cnt, mine, sp = 0u;
    for (;;) {
        sum = 0u; cnt = 0u; mine = 0u;
#pragma unroll
        for (unsigned j = 0; j < 16; ++j) { const unsigned c = xb_ld(&bar[XB_XCNT(j)]); sum += c; cnt += (c > 0u) ? 1u : 0u; mine = (j == x) ? c : mine; }
        if (sum == G) break;
        __builtin_amdgcn_s_sleep(1);
        if ((++sp & 255u) == 0u) { if (xb_ld(&bar[XB_TMO])) break; if (sp > XB_SPIN_CAP) { atomicAdd(&bar[XB_TMO], 1u); break; } }
    }
    nloc = mine > 0u ? mine : 1u; nx = cnt > 0u ? cnt : 1u;
}
__device__ __forceinline__ void xcd_barrier(const XcdBarrier& b) {
    asm volatile("s_waitcnt vmcnt(0)" ::: "memory");
    __syncthreads();
    if (threadIdx.x == 0) {
        unsigned* bar = b.bar;
        __builtin_amdgcn_s_waitcnt(0);
        unsigned nloc = b.st[0], nx = b.st[1];
        if (nloc == 0u) { xcd_barrier_complete(bar, b.x, nloc, nx); b.st[0] = nloc; b.st[1] = nx; }
        const unsigned old = xb_add(&bar[XB_XSUB(b.x)], 1u);
        const unsigned gen = old / nloc;
        if (old + 1u == (gen + 1u) * nloc) {
            __builtin_amdgcn_fence(__ATOMIC_RELEASE, "agent");
            asm volatile("s_waitcnt vmcnt(0)" ::: "memory");
            const unsigned og = xb_add(&bar[XB_TOP], 1u);
            const unsigned tg = og / nx;
            if (og + 1u == (tg + 1u) * nx) xb_add(&bar[XB_TOPGEN], 1u);
            else XB_SPIN(xb_ld(&bar[XB_TOPGEN]) == tg, bar);
            __builtin_amdgcn_fence(__ATOMIC_ACQUIRE, "agent");
            xb_add(&bar[XB_XGEN(b.x)], 1u);
            asm volatile("s_waitcnt vmcnt(0)" ::: "memory");
        } else {
            XB_SPIN(xb_ld(&bar[XB_XGEN(b.x)]) == gen, bar);
            __builtin_amdgcn_fence(__ATOMIC_ACQUIRE, "agent");
            asm volatile("s_waitcnt vmcnt(0)" ::: "memory");
        }
    }
    __syncthreads();
}

struct Args { const GAS float* in[25]; GAS float* out; GAS unsigned char* ws; int ph_lo, ph_hi; };
enum { I_X = 0, I_MEM, I_LNIG, I_LNIB, I_WIN, I_FB, I_LQ1, I_LK1, I_LQ2, I_LK2, I_DNG, I_HLB, I_HNG, I_WOUT, I_WQ, I_WK, I_WV, I_WO, I_RW, I_RB, I_W1, I_W3, I_W2, I_LNG, I_LNB };

#define ARGS_T const __attribute__((address_space(4))) Args
struct Frame {
    LAS unsigned char* lds; GAS unsigned char* ws; gu32* ctl; GAS float* out;
    int tid, lane, wave, G, bid;
};
#define WSP(T, off) ((T*)(F.ws + (off)))
#define AIN(i) ((const float*)A.in[i])

__device__ __forceinline__ void tr_item(const float* W, int ldsrc, int nsrc0, bf16* WT, int ldd, int ndst0, int k0, LAS float* scr, int lane) {
    float t[32];
    const float* src = W + (size_t)(k0 + (lane >> 5)) * ldsrc + nsrc0 + (lane & 31);
#pragma unroll
    for (int i = 0; i < 32; ++i) t[i] = src[(size_t)(2 * i) * ldsrc];
#pragma unroll
    for (int i = 0; i < 32; ++i) scr[(2 * i + (lane >> 5)) * 33 + (lane & 31)] = t[i];
    LDS_WAIT(); asm volatile("" ::: "memory");
    const int c = lane & 7;
#pragma unroll
    for (int j = 0; j < 4; ++j) { const int n = (lane >> 3) + 8 * j; const LAS float* s = scr + (8 * c) * 33 + n;
        u32x4 o; o.x = cvt_pk_bf16(s[0 * 33], s[1 * 33]); o.y = cvt_pk_bf16(s[2 * 33], s[3 * 33]); o.z = cvt_pk_bf16(s[4 * 33], s[5 * 33]); o.w = cvt_pk_bf16(s[6 * 33], s[7 * 33]);
        *(u32x4*)(WT + (size_t)(ndst0 + n) * ldd + k0 + 8 * c) = o; }
    LDS_WAIT(); asm volatile("" ::: "memory");
}
__device__ __forceinline__ void convert_weights(const Frame& F, ARGS_T& A, int l) {
    LAS float* scr = (LAS float*)(F.lds + RING_OFF + F.wave * 16384);
    const int gw = F.bid * NWAVES + F.wave, NGW = F.G * NWAVES;
    constexpr int I_IN = 16 * 112, I_SQ = 16 * 32, I_13 = 16 * 2 * 16 * 16, I_2 = 16 * 8 * 32;
    constexpr int NITEMS = I_IN + 5 * I_SQ + I_13 + I_2;
    for (int it = gw; it < NITEMS; it += NGW) {
        int r = it;
        if (r < I_IN) { const int kb = r / 112, nb = r % 112; const int nd = nb * 32, ns = nd < 768 ? nd : nd + 4;
            tr_item(AIN(I_WIN) + (size_t)l * DM * INW, INW, ns, WSP(bf16, WS_WIN), DM, nd, kb * 64, scr, F.lane); continue; }
        r -= I_IN;
        if (r < 5 * I_SQ) { const int w = r / I_SQ, rr = r % I_SQ, kb = rr / 32, nb = rr % 32;
            const float* src = (w == 0 ? AIN(I_WOUT) : w == 1 ? AIN(I_WQ) : w == 2 ? AIN(I_WK) : w == 3 ? AIN(I_WV) : AIN(I_WO)) + (size_t)l * DM * DM;
            bf16* dst = (bf16*)(F.ws + (w == 0 ? WS_WOUT : w == 1 ? WS_WQ : w == 2 ? WS_WK : w == 3 ? WS_WV : WS_WO));
            tr_item(src, DM, nb * 32, dst, DM, nb * 32, kb * 64, scr, F.lane); continue; }
        r -= 5 * I_SQ;
        if (r < I_13) { const int e = r / 512, rr = r % 512, which = rr / 256, r2 = rr % 256, kb = r2 / 16, nb = r2 % 16;
            const float* src = (which == 0 ? AIN(I_W1) : AIN(I_W3)) + ((size_t)l * NEXP + e) * DM * EFF;
            const int j0 = nb * 32, nd = (j0 / 128) * 256 + which * 128 + (j0 % 128);
            tr_item(src, EFF, j0, WSP(bf16, WS_W13) + (size_t)e * 1024 * DM, DM, nd, kb * 64, scr, F.lane); continue; }
        r -= I_13;
        { const int e = r / 256, rr = r % 256, kb = rr / 32, nb = rr % 32;
            const float* src = AIN(I_W2) + ((size_t)l * NEXP + e) * EFF * DM;
            tr_item(src, DM, nb * 32, WSP(bf16, WS_W2) + (size_t)e * 1024 * EFF, EFF, nb * 32, kb * 64, scr, F.lane); }
    }
}

__device__ __forceinline__ void ln_regs(f32x4 (&v)[4], const float* g, const float* b, int lane) {
    float s = 0.f;
#pragma unroll
    for (int j = 0; j < 4; ++j) s += (v[j].x + v[j].y) + (v[j].z + v[j].w);
    const float mean = wave_sum(s) * (1.f / DM); float s2 = 0.f;
#pragma unroll
    for (int j = 0; j < 4; ++j) { v[j] = v[j] - mean; s2 += (v[j].x * v[j].x + v[j].y * v[j].y) + (v[j].z * v[j].z + v[j].w * v[j].w); }
    const float rstd = 1.f / sqrtf(wave_sum(s2) * (1.f / DM) + LN_EPS);
#pragma unroll
    for (int j = 0; j < 4; ++j) { const f32x4 gg = *(const f32x4*)(g + 4 * lane + 256 * j), bb = *(const f32x4*)(b + 4 * lane + 256 * j); v[j] = v[j] * rstd * gg + bb; }
}
__device__ __forceinline__ void ln_regs_pre(f32x4 (&v)[4], const f32x4 (&gg)[4], const f32x4 (&bb)[4]) {
    float s = 0.f;
#pragma unroll
    for (int j = 0; j < 4; ++j) s += (v[j].x + v[j].y) + (v[j].z + v[j].w);
    const float mean = wave_sum(s) * (1.f / DM); float s2 = 0.f;
#pragma unroll
    for (int j = 0; j < 4; ++j) { v[j] = v[j] - mean; s2 += (v[j].x * v[j].x + v[j].y * v[j].y) + (v[j].z * v[j].z + v[j].w * v[j].w); }
    const float rstd = 1.f / sqrtf(wave_sum(s2) * (1.f / DM) + LN_EPS);
#pragma unroll
    for (int j = 0; j < 4; ++j) v[j] = v[j] * rstd * gg[j] + bb[j];
}
__device__ __forceinline__ void store_row(const f32x4 (&v)[4], float* o32, bf16* o16, int lane) {
#pragma unroll
    for (int j = 0; j < 4; ++j) { if (o32) *(f32x4*)(o32 + 4 * lane + 256 * j) = v[j];
        if (o16) { u32x2 w; w.x = cvt_pk_bf16(v[j].x, v[j].y); w.y = cvt_pk_bf16(v[j].z, v[j].w); *(u32x2*)(o16 + 4 * lane + 256 * j) = w; } }
}
__device__ __forceinline__ void load_row_bf16(f32x4 (&v)[4], const bf16* row, int lane) {
#pragma unroll
    for (int j = 0; j < 4; ++j) { const u32x2 c = *(const u32x2*)(row + 4 * lane + 256 * j); v[j].x = __uint_as_float(c.x << 16); v[j].y = __uint_as_float(c.x & 0xffff0000u); v[j].z = __uint_as_float(c.y << 16); v[j].w = __uint_as_float(c.y & 0xffff0000u); }
}
__device__ __forceinline__ void unpack_row_bf16(f32x4 (&v)[4], const u32x2 (&c)[4]) {
#pragma unroll
    for (int j = 0; j < 4; ++j) { v[j].x = __uint_as_float(c[j].x << 16); v[j].y = __uint_as_float(c[j].x & 0xffff0000u); v[j].z = __uint_as_float(c[j].y << 16); v[j].w = __uint_as_float(c[j].y & 0xffff0000u); }
}
__device__ __forceinline__ void fox_forget(const f32x4 (&v)[4], const LAS float* WF, const float* fb, float* lf2row, int lane) {
    f32x4 a = {0.f, 0.f, 0.f, 0.f};
#pragma unroll
    for (int j = 0; j < 4; ++j)
#pragma unroll
        for (int i = 0; i < 4; ++i) { const f32x4 w = *(const LAS f32x4*)(WF + (4 * lane + 256 * j + i) * 4); a = a + w * v[j][i]; }
#pragma unroll
    for (int c = 0; c < 4; ++c) a[c] = wave_sum(a[c]);
    if (lane == 0) { f32x4 o;
#pragma unroll
        for (int c = 0; c < 4; ++c) o[c] = log_sigmoidf_(a[c] + fb[c]) * LOG2E;
        *(f32x4*)lf2row = o; }
}
__device__ __forceinline__ void load_wf(const Frame& F, ARGS_T& A, int l, LAS float* WF) {
    const float* w = AIN(I_WIN) + (size_t)l * DM * INW + 768;
    for (int k = F.tid; k < DM; k += NTHR) *(LAS f32x4*)(WF + 4 * k) = *(const f32x4*)(w + (size_t)k * INW);
    __syncthreads();
}

__device__ __forceinline__ void phase_prologue(const Frame& F, ARGS_T& A) {
    convert_weights(F, A, 0);
    __syncthreads();
    LAS float* WF = (LAS float*)(F.lds + XCH_OFF - 16384);
    load_wf(F, A, 0, WF);
    const int gw = F.bid * NWAVES + F.wave, NGW = F.G * NWAVES;
    for (int m = gw; m < NB * 256; m += NGW) { f32x4 v[4];
#pragma unroll
        for (int j = 0; j < 4; ++j) v[j] = *(const f32x4*)(AIN(I_MEM) + (size_t)m * DM + 4 * F.lane + 256 * j);
        store_row(v, nullptr, WSP(bf16, WS_MEMB) + (size_t)m * DM, F.lane); }
    f32x4 gg[4], bb[4];
#pragma unroll
    for (int j = 0; j < 4; ++j) { gg[j] = *(const f32x4*)(AIN(I_LNIG) + 4 * F.lane + 256 * j); bb[j] = *(const f32x4*)(AIN(I_LNIB) + 4 * F.lane + 256 * j); }
    const int nit = (MTOK - gw + NGW - 1) / NGW;
    f32x4 xb[3][4];
#pragma unroll
    for (int q = 0; q < 3; ++q) { const int mq = gw + (q < nit ? q : 0) * NGW;
#pragma unroll
        for (int j = 0; j < 4; ++j) xb[q][j] = *(const f32x4*)(AIN(I_X) + (size_t)mq * DM + 4 * F.lane + 256 * j); }
    for (int it = 0; it < nit; it += 3) {
#pragma unroll
        for (int q = 0; q < 3; ++q) { if (it + q < nit) { const int m = gw + (it + q) * NGW; f32x4 v[4];
#pragma unroll
            for (int j = 0; j < 4; ++j) v[j] = xb[q][j];
            if (it + q + 3 < nit) {
#pragma unroll
                for (int j = 0; j < 4; ++j) xb[q][j] = *(const f32x4*)(AIN(I_X) + (size_t)(m + 3 * NGW) * DM + 4 * F.lane + 256 * j); }
            ln_regs_pre(v, gg, bb);
            store_row(v, nullptr, WSP(bf16, WS_R1) + (size_t)m * DM, F.lane);
            fox_forget(v, WF, AIN(I_FB), WSP(float, WS_LF2) + (size_t)m * 4, F.lane); } } }
}
#define PREP(F) ((bf16*)(F).out + (size_t)MTOK * DM)
#define YMIXP(F) ((bf16*)(F).out)
#ifndef LN3_L0_FAST
#define LN3_L0_FAST 0
#endif
#ifndef LN3_NB
#define LN3_NB 2
#endif
#ifndef LN1_WIDE
#define LN1_WIDE 1
#endif
__device__ __forceinline__ void phase_ln1(const Frame& F, ARGS_T& A, int l) {
    const int gw = F.bid * NWAVES + F.wave, NGW = F.G * NWAVES;
    const float* g = AIN(I_LNG) + (size_t)(l * 3 + 0) * DM; const float* b = AIN(I_LNB) + (size_t)(l * 3 + 0) * DM;
#if LN1_WIDE
    f32x4 gg[4], bb[4];
#pragma unroll
    for (int j = 0; j < 2; ++j) { const int c0 = 8 * F.lane + 512 * j; gg[2 * j] = *(const f32x4*)(g + c0); gg[2 * j + 1] = *(const f32x4*)(g + c0 + 4); bb[2 * j] = *(const f32x4*)(b + c0); bb[2 * j + 1] = *(const f32x4*)(b + c0 + 4); }
    const int nit = (MTOK - gw + NGW - 1) / NGW;
    u32x4 buf[4][2];
#pragma unroll
    for (int q = 0; q < 4; ++q) { const int mq = gw + (q < nit ? q : 0) * NGW;
#pragma unroll
        for (int j = 0; j < 2; ++j) buf[q][j] = *(const u32x4*)(PREP(F) + (size_t)mq * DM + 8 * F.lane + 512 * j); }
#define LN1_ROW(q, m, RELOAD) do { f32x4 v[4]; const u32x4 c0_ = buf[q][0], c1_ = buf[q][1]; \
            v[0].x = __uint_as_float(c0_.x << 16); v[0].y = __uint_as_float(c0_.x & 0xffff0000u); v[0].z = __uint_as_float(c0_.y << 16); v[0].w = __uint_as_float(c0_.y & 0xffff0000u); \
            v[1].x = __uint_as_float(c0_.z << 16); v[1].y = __uint_as_float(c0_.z & 0xffff0000u); v[1].z = __uint_as_float(c0_.w << 16); v[1].w = __uint_as_float(c0_.w & 0xffff0000u); \
            v[2].x = __uint_as_float(c1_.x << 16); v[2].y = __uint_as_float(c1_.x & 0xffff0000u); v[2].z = __uint_as_float(c1_.y << 16); v[2].w = __uint_as_float(c1_.y & 0xffff0000u); \
            v[3].x = __uint_as_float(c1_.z << 16); v[3].y = __uint_as_float(c1_.z & 0xffff0000u); v[3].z = __uint_as_float(c1_.w << 16); v[3].w = __uint_as_float(c1_.w & 0xffff0000u); \
            if (RELOAD) { _Pragma("unroll") for (int j = 0; j < 2; ++j) buf[q][j] = *(const u32x4*)(PREP(F) + (size_t)((m) + 4 * NGW) * DM + 8 * F.lane + 512 * j); } \
            float s = 0.f; \
            _Pragma("unroll") for (int j = 0; j < 4; ++j) s += (v[j].x + v[j].y) + (v[j].z + v[j].w); \
            const float mean = wave_sum(s) * (1.f / DM); float s2 = 0.f; \
            _Pragma("unroll") for (int j = 0; j < 4; ++j) { v[j] = v[j] - mean; s2 += (v[j].x * v[j].x + v[j].y * v[j].y) + (v[j].z * v[j].z + v[j].w * v[j].w); } \
            const float rstd = 1.f / sqrtf(wave_sum(s2) * (1.f / DM) + LN_EPS); \
            bf16* o16 = WSP(bf16, WS_R1) + (size_t)(m) * DM; \
            _Pragma("unroll") for (int j = 0; j < 2; ++j) { const f32x4 y0 = v[2 * j] * rstd * gg[2 * j] + bb[2 * j], y1 = v[2 * j + 1] * rstd * gg[2 * j + 1] + bb[2 * j + 1]; \
                u32x4 w; w.x = cvt_pk_bf16(y0.x, y0.y); w.y = cvt_pk_bf16(y0.z, y0.w); w.z = cvt_pk_bf16(y1.x, y1.y); w.w = cvt_pk_bf16(y1.z, y1.w); \
                *(u32x4*)(o16 + 8 * F.lane + 512 * j) = w; } } while (0)
    if (nit == 16) {
#pragma nounroll
        for (int it = 0; it < 12; it += 4) {
#pragma unroll
            for (int q = 0; q < 4; ++q) LN1_ROW(q, gw + (it + q) * NGW, true); }
#pragma unroll
        for (int q = 0; q < 4; ++q) LN1_ROW(q, gw + (12 + q) * NGW, false);
    } else {
        for (int it = 0; it < nit; it += 4) {
#pragma unroll
            for (int q = 0; q < 4; ++q) { if (it + q < nit) LN1_ROW(q, gw + (it + q) * NGW, it + q + 4 < nit); } } }
#undef LN1_ROW
#else
    u32x2 nx[4];
#pragma unroll
    for (int j = 0; j < 4; ++j) nx[j] = *(const u32x2*)(PREP(F) + (size_t)gw * DM + 4 * F.lane + 256 * j);
    for (int m = gw; m < MTOK; m += NGW) { f32x4 v[4]; u32x2 cu[4];
#pragma unroll
        for (int j = 0; j < 4; ++j) cu[j] = nx[j];
        if (m + NGW < MTOK) {
#pragma unroll
            for (int j = 0; j < 4; ++j) nx[j] = *(const u32x2*)(PREP(F) + (size_t)(m + NGW) * DM + 4 * F.lane + 256 * j); }
        unpack_row_bf16(v, cu);
        ln_regs(v, g, b, F.lane);
        store_row(v, nullptr, WSP(bf16, WS_R1) + (size_t)m * DM, F.lane); }
#endif
}
__device__ __forceinline__ void phase_ln3(const Frame& F, ARGS_T& A, int l) {
    LAS float* WF = (LAS float*)(F.lds + XCH_OFF - 16384);
    if (l == 0) { convert_weights(F, A, 1); __syncthreads(); load_wf(F, A, 1, WF); }
    const int gw = F.bid * NWAVES + F.wave, NGW = F.G * NWAVES;
    const float* g = AIN(I_LNG) + (size_t)(l * 3 + 2) * DM; const float* b = AIN(I_LNB) + (size_t)(l * 3 + 2) * DM;
    const bf16* CB = WSP(bf16, WS_CB);
    f32x4 gg[4], bb[4];
#pragma unroll
    for (int j = 0; j < 4; ++j) { gg[j] = *(const f32x4*)(g + 4 * F.lane + 256 * j); bb[j] = *(const f32x4*)(b + 4 * F.lane + 256 * j); }
    const int nit = (MTOK - gw + NGW - 1) / NGW;
    u32x2 bh_[4][4], b0_[4][4], b1_[4][4];
#define LN3_LOAD(q, m) do { const size_t mm_ = (size_t)(m); _Pragma("unroll") for (int j = 0; j < 4; ++j) { bh_[q][j] = *(const u32x2*)(WSP(bf16, WS_R1) + mm_ * DM + 4 * F.lane + 256 * j); \
        b0_[q][j] = *(const u32x2*)(CB + 2 * mm_ * DM + 4 * F.lane + 256 * j); b1_[q][j] = *(const u32x2*)(CB + (2 * mm_ + 1) * DM + 4 * F.lane + 256 * j); } } while (0)
#define LN3_ROW(q, m, RELOAD, DIST) do { f32x4 v[4]; \
        _Pragma("unroll") for (int j = 0; j < 4; ++j) { const u32x2 h_ = bh_[q][j], c0 = b0_[q][j], c1 = b1_[q][j]; \
            v[j].x = __uint_as_float(h_.x << 16) * ALPHA + (__uint_as_float(c0.x << 16) + __uint_as_float(c1.x << 16)); v[j].y = __uint_as_float(h_.x & 0xffff0000u) * ALPHA + (__uint_as_float(c0.x & 0xffff0000u) + __uint_as_float(c1.x & 0xffff0000u)); \
            v[j].z = __uint_as_float(h_.y << 16) * ALPHA + (__uint_as_float(c0.y << 16) + __uint_as_float(c1.y << 16)); v[j].w = __uint_as_float(h_.y & 0xffff0000u) * ALPHA + (__uint_as_float(c0.y & 0xffff0000u) + __uint_as_float(c1.y & 0xffff0000u)); } \
        if (RELOAD) LN3_LOAD(q, (m) + (DIST) * NGW); \
        ln_regs_pre(v, gg, bb); \
        store_row(v, l == 0 ? nullptr : (float*)F.out + (size_t)(m) * DM, l == 0 ? WSP(bf16, WS_R1) + (size_t)(m) * DM : nullptr, F.lane); \
        if (l == 0) fox_forget(v, WF, AIN(I_FB) + 4, WSP(float, WS_LF2) + (size_t)(m) * 4, F.lane); } while (0)
    if ((l == 1 || LN3_L0_FAST) && nit == 16) {
#pragma unroll
        for (int q = 0; q < 4; ++q) LN3_LOAD(q, gw + q * NGW);
#pragma nounroll
        for (int it = 0; it < 12; it += 4) {
#pragma unroll
            for (int q = 0; q < 4; ++q) LN3_ROW(q, gw + (it + q) * NGW, true, 4); }
#pragma unroll
        for (int q = 0; q < 4; ++q) LN3_ROW(q, gw + (12 + q) * NGW, false, 4);
    } else {
#pragma unroll
        for (int q = 0; q < LN3_NB; ++q) LN3_LOAD(q, gw + (q < nit ? q : 0) * NGW);
        for (int it = 0; it < nit; it += LN3_NB) {
#pragma unroll
            for (int q = 0; q < LN3_NB; ++q) { if (it + q < nit) LN3_ROW(q, gw + (it + q) * NGW, it + q + LN3_NB < nit, LN3_NB); } } }
#undef LN3_ROW
#undef LN3_LOAD
}
__device__ __forceinline__ void fox_cumsum(const Frame& F) {
    if (F.bid >= 16) return;
    const int b = F.bid >> 2, h = F.bid & 3; const float* src = WSP(float, WS_LF2) + (size_t)b * SEQ * 4 + h; float* dst = WSP(float, WS_CUMF) + (size_t)F.bid * SEQ;
    LAS float* tot = (LAS float*)(F.lds + XCH_OFF);
    float v[16]; float run = 0.f;
#pragma unroll
    for (int i = 0; i < 16; ++i) { run += src[(size_t)(F.tid * 16 + i) * 4]; v[i] = run; }
    float inc = run;
#pragma unroll
    for (int o = 1; o < 64; o <<= 1) { const float t = __shfl_up(inc, o); if (F.lane >= o) inc += t; }
    if (F.lane == 63) tot[F.wave] = inc;
    __syncthreads();
    float base = inc - run;
    for (int w = 0; w < F.wave; ++w) base += tot[w];
#pragma unroll
    for (int i = 0; i < 16; ++i) dst[F.tid * 16 + i] = v[i] + base;
    __syncthreads();
}
#ifndef ROUTE_MFMA
#define ROUTE_MFMA 1
#endif
#if ROUTE_MFMA
__device__ __forceinline__ void phase_ln2_route(const Frame& F, ARGS_T& A, int l) {
    LAS unsigned char* WB = F.lds + RING_OFF;
#ifdef PROBE_RT
    const unsigned long long rp0_ = __builtin_amdgcn_s_memrealtime(); unsigned long long rp1_ = 0, rp2_ = 0;
#endif
    LAS float* CD = (LAS float*)(F.lds + RING_OFF + 65536);
    LAS float* PART = CD + 32;
    LAS float* STAT = PART + 1024;
    LAS int* REC = (LAS int*)(STAT + 256);
    LAS int* CNT = REC + 512; LAS int* BASE = CNT + 16; LAS int* NREC = CNT + 32;
    LAS float* LG = (LAS float*)(CNT + 64) + F.wave * 256;
    const int gw = F.bid * NWAVES + F.wave, NGW = F.G * NWAVES;
    const float* g = AIN(I_LNG) + (size_t)(l * 3 + 1) * DM; const float* b = AIN(I_LNB) + (size_t)(l * 3 + 1) * DM;
    const float* RWg = AIN(I_RW);
    float* GATE = WSP(float, WS_GATE);
    LAS float* GB = (LAS float*)(F.lds + RING_OFF + 65536 + 32768);
    { const f32x4 gv = *(const f32x4*)(g + 4 * (F.tid & 255)), bv = *(const f32x4*)(b + 4 * (F.tid & 255)); if (F.tid < 256) *(LAS f32x4*)(GB + 4 * F.tid) = gv; else *(LAS f32x4*)(GB + 1024 + 4 * (F.tid - 256)) = bv; }
    float wv[4][8];
#pragma unroll
    for (int it = 0; it < 4; ++it) { const int idx = F.tid + it * NTHR, s_ = idx >> 6, ln = idx & 63, n = ln & 15, q = ln >> 4;
#pragma unroll
        for (int j = 0; j < 8; ++j) wv[it][j] = RWg[(32 * s_ + 8 * q + j) * 16 + n]; }
    float pv[32]; { const int e = F.tid & 15, r = F.tid >> 4;
#pragma unroll
        for (int kk = 0; kk < 32; ++kk) pv[kk] = RWg[(32 * r + kk) * 16 + e]; }
    __syncthreads();
#pragma unroll
    for (int it = 0; it < 4; ++it) { const int idx = F.tid + it * NTHR, s_ = idx >> 6, ln = idx & 63, q = ln >> 4; float w[8]; unsigned hb[8];
#pragma unroll
        for (int j = 0; j < 8; ++j) w[j] = wv[it][j] * GB[32 * s_ + 8 * q + j];
        u32x4 hi, lo;
#pragma unroll
        for (int j = 0; j < 8; ++j) { hb[j] = cvt_pk_bf16(w[j], 0.f) & 0xffffu; w[j] -= __uint_as_float(hb[j] << 16); }
        hi.x = hb[0] | (hb[1] << 16); hi.y = hb[2] | (hb[3] << 16); hi.z = hb[4] | (hb[5] << 16); hi.w = hb[6] | (hb[7] << 16);
        lo.x = cvt_pk_bf16(w[0], w[1]); lo.y = cvt_pk_bf16(w[2], w[3]); lo.z = cvt_pk_bf16(w[4], w[5]); lo.w = cvt_pk_bf16(w[6], w[7]);
        *(LAS u32x4*)(WB + idx * 16) = hi; *(LAS u32x4*)(WB + 32768 + idx * 16) = lo; }
    { const int e = F.tid & 15, r = F.tid >> 4; float cs = 0.f, ds = 0.f;
#pragma unroll
        for (int kk = 0; kk < 32; ++kk) { cs += pv[kk] * GB[32 * r + kk]; ds += pv[kk] * GB[1024 + 32 * r + kk]; }
        PART[r * 32 + e] = cs; PART[r * 32 + 16 + e] = ds; }
    if (F.tid < 16) CNT[F.tid] = 0;
    __syncthreads();
    if (F.tid < 32) { float a = 0.f; for (int r = 0; r < 32; ++r) a += PART[r * 32 + F.tid]; CD[F.tid] = a; }
    __syncthreads();
#ifdef PROBE_RT
    rp1_ = __builtin_amdgcn_s_memrealtime();
#endif
    f32x4 gg[4], bb[4];
#pragma unroll
    for (int j = 0; j < 2; ++j) { const int c0 = 8 * F.lane + 512 * j; gg[2 * j] = *(const f32x4*)(g + c0); gg[2 * j + 1] = *(const f32x4*)(g + c0 + 4); bb[2 * j] = *(const f32x4*)(b + c0); bb[2 * j + 1] = *(const f32x4*)(b + c0 + 4); }
    int nrec = 0;
    for (int grp = gw; grp < MTOK / 16; grp += NGW) { const int row0 = grp * 16; int ln_ = F.lane; asm volatile("" : "+v"(ln_));
        u32x4 buf[4][2];
#pragma unroll
        for (int q = 0; q < 4; ++q) {
#pragma unroll
            for (int j = 0; j < 2; ++j) buf[q][j] = *(const u32x4*)(PREP(F) + (size_t)(row0 + q) * DM + 8 * ln_ + 512 * j); }
#pragma nounroll
        for (int i4 = 0; i4 < 16; i4 += 4) {
#pragma unroll
            for (int q = 0; q < 4; ++q) { const int i = i4 + q; f32x4 v[4]; const u32x4 c0_ = buf[q][0], c1_ = buf[q][1];
                v[0].x = __uint_as_float(c0_.x << 16); v[0].y = __uint_as_float(c0_.x & 0xffff0000u); v[0].z = __uint_as_float(c0_.y << 16); v[0].w = __uint_as_float(c0_.y & 0xffff0000u);
                v[1].x = __uint_as_float(c0_.z << 16); v[1].y = __uint_as_float(c0_.z & 0xffff0000u); v[1].z = __uint_as_float(c0_.w << 16); v[1].w = __uint_as_float(c0_.w & 0xffff0000u);
                v[2].x = __uint_as_float(c1_.x << 16); v[2].y = __uint_as_float(c1_.x & 0xffff0000u); v[2].z = __uint_as_float(c1_.y << 16); v[2].w = __uint_as_float(c1_.y & 0xffff0000u);
                v[3].x = __uint_as_float(c1_.z << 16); v[3].y = __uint_as_float(c1_.z & 0xffff0000u); v[3].z = __uint_as_float(c1_.w << 16); v[3].w = __uint_as_float(c1_.w & 0xffff0000u);
                if (i4 < 12) {
#pragma unroll
                    for (int j = 0; j < 2; ++j) buf[q][j] = *(const u32x4*)(PREP(F) + (size_t)(row0 + i + 4) * DM + 8 * ln_ + 512 * j); }
                float sm = 0.f;
#pragma unroll
                for (int j = 0; j < 4; ++j) sm += (v[j].x + v[j].y) + (v[j].z + v[j].w);
                const float mean = wave_sum(sm) * (1.f / DM); float s2 = 0.f;
#pragma unroll
                for (int j = 0; j < 4; ++j) { v[j] = v[j] - mean; s2 += (v[j].x * v[j].x + v[j].y * v[j].y) + (v[j].z * v[j].z + v[j].w * v[j].w); }
                const float rstd = 1.f / sqrtf(wave_sum(s2) * (1.f / DM) + LN_EPS);
                if (ln_ == 0) { STAT[(F.wave * 16 + i) * 2] = mean; STAT[(F.wave * 16 + i) * 2 + 1] = rstd; }
                bf16* o16 = WSP(bf16, WS_R1) + (size_t)(row0 + i) * DM;
#pragma unroll
                for (int j = 0; j < 2; ++j) { const f32x4 y0 = v[2 * j] * rstd * gg[2 * j] + bb[2 * j], y1 = v[2 * j + 1] * rstd * gg[2 * j + 1] + bb[2 * j + 1];
                    u32x4 w; w.x = cvt_pk_bf16(y0.x, y0.y); w.y = cvt_pk_bf16(y0.z, y0.w); w.z = cvt_pk_bf16(y1.x, y1.y); w.w = cvt_pk_bf16(y1.z, y1.w);
                    *(u32x4*)(o16 + 8 * ln_ + 512 * j) = w; } } }
        f32x4 ah = {0.f, 0.f, 0.f, 0.f}, al = {0.f, 0.f, 0.f, 0.f};
        const bf16* ap = PREP(F) + (size_t)(row0 + (ln_ & 15)) * DM + 8 * (ln_ >> 4);
        const LAS unsigned char* wl = WB + ln_ * 16;
        bf16x8 av[32];
#pragma unroll
        for (int s_ = 0; s_ < 32; ++s_) av[s_] = *(const bf16x8*)(ap + 32 * s_);
        __builtin_amdgcn_sched_barrier(0);
#pragma unroll
        for (int s_ = 0; s_ < 32; ++s_) { const bf16x8 bh = *(const LAS bf16x8*)(wl + s_ * 1024), bl = *(const LAS bf16x8*)(wl + 32768 + s_ * 1024);
            ah = __builtin_amdgcn_mfma_f32_16x16x32_bf16(av[s_], bh, ah, 0, 0, 0); al = __builtin_amdgcn_mfma_f32_16x16x32_bf16(av[s_], bl, al, 0, 0, 0); }
        { const int e = ln_ & 15, q = ln_ >> 4; const float ce = CD[e], de = CD[16 + e];
#pragma unroll
            for (int i = 0; i < 4; ++i) { const int t = 4 * q + i; const float mean = STAT[(F.wave * 16 + t) * 2], rstd = STAT[(F.wave * 16 + t) * 2 + 1];
                const float lg = rstd * ((ah[i] + al[i]) - mean * ce) + de; LG[t * 16 + e] = 1.f / (1.f + __expf(-lg)); } }
        float sc[16], bi[16];
#pragma unroll
        for (int q = 0; q < 4; ++q) { const f32x4 sv = *(const LAS f32x4*)(LG + (ln_ & 15) * 16 + 4 * q);
#pragma unroll
            for (int i = 0; i < 4; ++i) { sc[q * 4 + i] = sv[i]; bi[q * 4 + i] = sv[i] + AIN(I_RB)[q * 4 + i]; } }
        int gs = 0; float best = -INFINITY;
#pragma unroll
        for (int q = 0; q < 4; ++q) { float m1 = -INFINITY, m2 = -INFINITY;
#pragma unroll
            for (int i = 0; i < 4; ++i) { const float x = bi[q * 4 + i]; if (x > m1) { m2 = m1; m1 = x; } else if (x > m2) m2 = x; }
            const float s = m1 + m2; if (s > best) { best = s; gs = q; } }
        float bq[4], sq[4];
#pragma unroll
        for (int i = 0; i < 4; ++i) { bq[i] = gs == 0 ? bi[i] : gs == 1 ? bi[4 + i] : gs == 2 ? bi[8 + i] : bi[12 + i]; sq[i] = gs == 0 ? sc[i] : gs == 1 ? sc[4 + i] : gs == 2 ? sc[8 + i] : sc[12 + i]; }
        int i0 = 0; float b0_ = bq[0];
#pragma unroll
        for (int i = 1; i < 4; ++i) if (bq[i] > b0_) { b0_ = bq[i]; i0 = i; }
        int i1 = -1; float b1_ = -INFINITY;
#pragma unroll
        for (int i = 0; i < 4; ++i) if (i != i0 && bq[i] > b1_) { b1_ = bq[i]; i1 = i; }
        const float s0 = i0 == 0 ? sq[0] : i0 == 1 ? sq[1] : i0 == 2 ? sq[2] : sq[3];
        const float s1 = i1 == 0 ? sq[0] : i1 == 1 ? sq[1] : i1 == 2 ? sq[2] : sq[3];
        const int e0 = gs * 4 + i0, e1 = gs * 4 + i1;
        if (ln_ < 16) { const int m = row0 + ln_; const float inv = 1.f / (s0 + s1); GATE[2 * m] = s0 * inv; GATE[2 * m + 1] = s1 * inv;
            const int r0 = __hip_atomic_fetch_add(&CNT[e0], 1, __ATOMIC_RELAXED, __HIP_MEMORY_SCOPE_WORKGROUP), r1 = __hip_atomic_fetch_add(&CNT[e1], 1, __ATOMIC_RELAXED, __HIP_MEMORY_SCOPE_WORKGROUP);
            LAS int* rec = REC + (F.wave * 16 + nrec + ln_) * 4; rec[0] = m; rec[1] = e0; rec[2] = e1; rec[3] = r0 | (r1 << 16); }
        nrec += 16;
    }
#ifdef PROBE_RT
    rp2_ = __builtin_amdgcn_s_memrealtime();
#endif
    if (F.lane == 0) NREC[F.wave] = nrec;
    __syncthreads();
    if (F.tid < 16) BASE[F.tid] = (int)__hip_atomic_fetch_add((unsigned*)(F.ctl + CW_ECNT + (l * 16 + F.tid) * 64), (unsigned)CNT[F.tid], RLX_AGENT);
    __syncthreads();
    int* LIST = WSP(int, WS_LIST);
    if (F.tid < 128) { const int w = F.tid >> 4, i = F.tid & 15; const int cnt_w = NREC[w];
        if (i < cnt_w) { const LAS int* rec = REC + F.tid * 4; const int m = rec[0], e0 = rec[1], e1 = rec[2], rr = rec[3];
            LIST[(size_t)e0 * MTOK + BASE[e0] + (rr & 0xffff)] = 2 * m; LIST[(size_t)e1 * MTOK + BASE[e1] + (rr >> 16)] = 2 * m + 1; } }
    __syncthreads();
#ifdef PROBE_RT
    if (l == 0 && F.bid == 0 && threadIdx.x == 0) { const unsigned long long e_ = __builtin_amdgcn_s_memrealtime(); const unsigned long long v_ = PROBE_RT == 1 ? rp1_ - rp0_ : PROBE_RT == 2 ? rp2_ - rp1_ : e_ - rp2_;
        const unsigned long long until = __builtin_amdgcn_s_memrealtime() + v_ * 20ull; while (__builtin_amdgcn_s_memrealtime() < until) __builtin_amdgcn_s_sleep(32); }
#endif
}
#else
#ifndef ROUTE_TT
#define ROUTE_TT 4
#endif
__device__ __forceinline__ void phase_ln2_route(const Frame& F, ARGS_T& A, int l) {
    constexpr int RW_BYTES = DM * 64 + (DM / 4) * 16;
    LAS unsigned char* RWB = F.lds + RING_OFF;
    LAS int* REC = (LAS int*)(F.lds + RING_OFF + RW_BYTES);
    LAS int* CNT = (LAS int*)(F.lds + RING_OFF + RW_BYTES + 2048);
    LAS int* BASE = CNT + 16; LAS int* NREC = CNT + 32;
    LAS float* LG = (LAS float*)(F.lds + RING_OFF + RW_BYTES + 4096) + F.wave * 64;
    for (int c = F.tid; c < DM * 4; c += NTHR) { const int row = c >> 2, q = c & 3; *(LAS f32x4*)(RWB + row * 64 + (row >> 2) * 16 + q * 16) = *(const f32x4*)(AIN(I_RW) + 4 * c); }
    if (F.tid < 16) CNT[F.tid] = 0;
    __syncthreads();
    const int gw = F.bid * NWAVES + F.wave, NGW = F.G * NWAVES;
    const float* g = AIN(I_LNG) + (size_t)(l * 3 + 1) * DM; const float* b = AIN(I_LNB) + (size_t)(l * 3 + 1) * DM;
    float* GATE = WSP(float, WS_GATE);
    constexpr int TT = ROUTE_TT, NR = TT * 16;
    int nrec = 0;
    u32x2 nx[TT][4];
#pragma unroll
    for (int t = 0; t < TT; ++t) { const int mr = gw + t * NGW < MTOK ? gw + t * NGW : MTOK - 1;
#pragma unroll
        for (int j = 0; j < 4; ++j) nx[t][j] = *(const u32x2*)(PREP(F) + (size_t)mr * DM + 4 * F.lane + 256 * j); }
    for (int m0 = gw; m0 < MTOK; m0 += TT * NGW) { f32x4 v[TT][4]; int ln_ = F.lane; asm volatile("" : "+v"(ln_));
#pragma unroll
        for (int t = 0; t < TT; ++t) unpack_row_bf16(v[t], nx[t]);
        if (m0 + TT * NGW < MTOK) {
#pragma unroll
            for (int t = 0; t < TT; ++t) { const int mr = m0 + (TT + t) * NGW < MTOK ? m0 + (TT + t) * NGW : MTOK - 1;
#pragma unroll
                for (int j = 0; j < 4; ++j) nx[t][j] = *(const u32x2*)(PREP(F) + (size_t)mr * DM + 4 * ln_ + 256 * j); } }
#pragma unroll
        for (int t = 0; t < TT; ++t) { ln_regs(v[t], g, b, ln_); if (m0 + t * NGW < MTOK) store_row(v[t], nullptr, WSP(bf16, WS_R1) + (size_t)(m0 + t * NGW) * DM, ln_); }
        f32x2 R2[NR / 2];
#pragma unroll
        for (int k = 0; k < NR / 2; ++k) R2[k] = (f32x2){0.f, 0.f};
#pragma unroll
        for (int j = 0; j < 4; ++j)
#pragma unroll
            for (int i = 0; i < 4; ++i) { const LAS f32x4* wr = (const LAS f32x4*)(RWB + ln_ * 272 + i * 64 + j * 17408); f32x2 wp[8];
#pragma unroll
                for (int q = 0; q < 4; ++q) { const f32x4 w = wr[q]; wp[2 * q] = (f32x2){w[0], w[1]}; wp[2 * q + 1] = (f32x2){w[2], w[3]}; }
#pragma unroll
                for (int t = 0; t < TT; ++t) { const float x = v[t][j][i]; const f32x2 x2 = {x, x};
#pragma unroll
                    for (int c = 0; c < 8; ++c) R2[t * 8 + c] = __builtin_elementwise_fma(wp[c], x2, R2[t * 8 + c]); } }
        float R[NR];
#pragma unroll
        for (int k = 0; k < NR / 2; ++k) { R[2 * k] = R2[k][0]; R[2 * k + 1] = R2[k][1]; }
#pragma unroll
        for (int P = NR / 2; P >= 1; P >>= 1) { const bool up = (ln_ & P) != 0;
#pragma unroll
            for (int k = 0; k < P; ++k) { const float keep = up ? R[k + P] : R[k], send = up ? R[k] : R[k + P]; R[k] = keep + __shfl_xor(send, P); } }
#pragma unroll
        for (int P = NR; P < 64; P <<= 1) R[0] += __shfl_xor(R[0], P);
        LG[ln_] = 1.f / (1.f + __expf(-R[0]));
        float sc[16], bi[16];
#pragma unroll
        for (int q = 0; q < 4; ++q) { const f32x4 sv = *(const LAS f32x4*)(LG + (ln_ & 48) + 4 * q);
#pragma unroll
            for (int i = 0; i < 4; ++i) { sc[q * 4 + i] = sv[i]; bi[q * 4 + i] = sv[i] + AIN(I_RB)[q * 4 + i]; } }
        int gs = 0; float best = -INFINITY;
#pragma unroll
        for (int q = 0; q < 4; ++q) { float m1 = -INFINITY, m2 = -INFINITY;
#pragma unroll
            for (int i = 0; i < 4; ++i) { const float x = bi[q * 4 + i]; if (x > m1) { m2 = m1; m1 = x; } else if (x > m2) m2 = x; }
            const float s = m1 + m2; if (s > best) { best = s; gs = q; } }
        float bq[4], sq[4];
#pragma unroll
        for (int i = 0; i < 4; ++i) { bq[i] = gs == 0 ? bi[i] : gs == 1 ? bi[4 + i] : gs == 2 ? bi[8 + i] : bi[12 + i]; sq[i] = gs == 0 ? sc[i] : gs == 1 ? sc[4 + i] : gs == 2 ? sc[8 + i] : sc[12 + i]; }
        int i0 = 0; float b0 = bq[0];
#pragma unroll
        for (int i = 1; i < 4; ++i) if (bq[i] > b0) { b0 = bq[i]; i0 = i; }
        int i1 = -1; float b1 = -INFINITY;
#pragma unroll
        for (int i = 0; i < 4; ++i) if (i != i0 && bq[i] > b1) { b1 = bq[i]; i1 = i; }
        const float s0 = i0 == 0 ? sq[0] : i0 == 1 ? sq[1] : i0 == 2 ? sq[2] : sq[3];
        const float s1 = i1 == 0 ? sq[0] : i1 == 1 ? sq[1] : i1 == 2 ? sq[2] : sq[3];
        const int e0 = gs * 4 + i0, e1 = gs * 4 + i1;
        const int m = m0 + ((ln_ >> 4) & (TT - 1)) * NGW;
        if ((ln_ & 15) == 0 && ln_ < NR && m < MTOK) { const float inv = 1.f / (s0 + s1); GATE[2 * m] = s0 * inv; GATE[2 * m + 1] = s1 * inv;
            const int r0 = __hip_atomic_fetch_add(&CNT[e0], 1, __ATOMIC_RELAXED, __HIP_MEMORY_SCOPE_WORKGROUP), r1 = __hip_atomic_fetch_add(&CNT[e1], 1, __ATOMIC_RELAXED, __HIP_MEMORY_SCOPE_WORKGROUP);
            LAS int* rec = REC + (F.wave * 16 + nrec + ((ln_ >> 4) & (TT - 1))) * 4; rec[0] = m; rec[1] = e0; rec[2] = e1; rec[3] = r0 | (r1 << 16); }
#pragma unroll
        for (int t = 0; t < TT; ++t) nrec += (m0 + t * NGW < MTOK) ? 1 : 0;
    }
    if (F.lane == 0) NREC[F.wave] = nrec;
    __syncthreads();
    if (F.tid < 16) BASE[F.tid] = (int)__hip_atomic_fetch_add((unsigned*)(F.ctl + CW_ECNT + (l * 16 + F.tid) * 64), (unsigned)CNT[F.tid], RLX_AGENT);
    __syncthreads();
    int* LIST = WSP(int, WS_LIST);
    if (F.tid < 128) { const int w = F.tid >> 4, i = F.tid & 15; const int cnt_w = NREC[w];
        if (i < cnt_w) { const LAS int* rec = REC + F.tid * 4; const int m = rec[0], e0 = rec[1], e1 = rec[2], rr = rec[3];
            LIST[(size_t)e0 * MTOK + BASE[e0] + (rr & 0xffff)] = 2 * m; LIST[(size_t)e1 * MTOK + BASE[e1] + (rr >> 16)] = 2 * m + 1; } }
    __syncthreads();
}
#endif
__device__ __forceinline__ void moe_tables(const Frame& F, int l) {
    LAS int* T = (LAS int*)(F.lds + TAB_OFF);
    if (F.tid < 16) T[32 + F.tid] = (int)__hip_atomic_load((unsigned*)(F.ctl + CW_ECNT + (l * 16 + F.tid) * 64), RLX_AGENT);
    __syncthreads();
    if (F.tid == 0) { int cum = 0;
        for (int e = 0; e < 16; ++e) { const int n = T[32 + e]; T[e] = cum; cum += (n + 255) >> 8; }
        T[16] = cum; }
    __syncthreads();
}
#ifndef ATT_STAGGER
#define ATT_STAGGER 0
#endif
#ifndef DIFF_FAST_BOUND
#define DIFF_FAST_BOUND 60.f
#endif
#ifndef DIFF_LAG
#define DIFF_LAG 0
#endif
#ifndef DIFF_IL
#define DIFF_IL 1
#endif
#ifndef FOX_IL
#define FOX_IL 1
#endif
#ifndef USE_FAST_STEP
#define USE_FAST_STEP 0
#endif
#ifndef ONLY_FAST_TEST
#define ONLY_FAST_TEST 0
#endif
namespace att {
template <int V> struct IC { static constexpr int value = V; };
constexpr int SLOTB = 8192;
constexpr int L_K = 0, L_V = 4 * SLOTB, L_KX = 10 * SLOTB, L_WS = L_KX + 4 * 1024, L_END = L_WS + NWAVES * 256, L_OST = 0;
static_assert(L_END <= RING_BYTES, "attention LDS");
constexpr float THR = 10.f;
__device__ __forceinline__ int crow(int r, int hi) { return (r & 3) + 8 * (r >> 2) + 4 * hi; }
__device__ __forceinline__ void glds16(const void* gsrc, unsigned lds_dst) { unsigned keep;
    asm volatile("s_mov_b32 %0, m0\n\ts_mov_b32 m0, %2\n\ts_nop 0\n\tglobal_load_lds_dwordx4 %1, off\n\ts_mov_b32 m0, %0" : "=&s"(keep) : "v"(gsrc), "s"(lds_dst) : "memory"); }
__device__ __forceinline__ void glds16s(const void* sbase, unsigned voff, unsigned lds_dst) { unsigned keep;
    asm volatile("s_mov_b32 %0, m0\n\ts_mov_b32 m0, %3\n\ts_nop 0\n\tglobal_load_lds_dwordx4 %1, %2\n\ts_mov_b32 m0, %0" : "=&s"(keep) : "v"(voff), "s"(sbase), "s"(lds_dst) : "memory"); }
#ifndef ATT_USE_PRIO
#define ATT_USE_PRIO 1
#endif
#define ATT_PRIO(p) do { if (ATT_USE_PRIO) __builtin_amdgcn_s_setprio(p); } while (0)
#define ATT_WAIT_BAR() asm volatile("s_waitcnt vmcnt(0) lgkmcnt(0)\n\ts_barrier" ::: "memory")
typedef short v4i16_t __attribute__((ext_vector_type(4)));
__device__ __forceinline__ s16x4 vtr(const LAS unsigned char* p) { return __builtin_bit_cast(s16x4, __builtin_amdgcn_ds_read_tr16_b64_v4i16((LAS v4i16_t*)p)); }
__device__ __forceinline__ float rowmax32(const f32x16& p0, const f32x16& p1) {
    float a0 = fmaxf(p0[0], p1[0]), a1 = fmaxf(p0[1], p1[1]), a2 = fmaxf(p0[2], p1[2]), a3 = fmaxf(p0[3], p1[3]);
#pragma unroll
    for (int r = 4; r < 16; r += 4) { a0 = fmaxf(a0, fmaxf(p0[r], p1[r])); a1 = fmaxf(a1, fmaxf(p0[r + 1], p1[r + 1])); a2 = fmaxf(a2, fmaxf(p0[r + 2], p1[r + 2])); a3 = fmaxf(a3, fmaxf(p0[r + 3], p1[r + 3])); }
    const float a = fmaxf(fmaxf(a0, a1), fmaxf(a2, a3));
    auto rr = __builtin_amdgcn_permlane32_swap(__float_as_uint(a), __float_as_uint(a), false, false);
    return fmaxf(__uint_as_float(rr[0]), __uint_as_float(rr[1]));
}
__device__ __forceinline__ float half_sum(float a) { auto rr = __builtin_amdgcn_permlane32_swap(__float_as_uint(a), __float_as_uint(a), false, false); return __uint_as_float(rr[0]) + __uint_as_float(rr[1]); }
__device__ __forceinline__ bf16x8 pack8(const f32x16& p, int b) { u32x4 w; w.x = cvt_pk_bf16(p[b], p[b + 1]); w.y = cvt_pk_bf16(p[b + 2], p[b + 3]); w.z = cvt_pk_bf16(p[b + 4], p[b + 5]); w.w = cvt_pk_bf16(p[b + 6], p[b + 7]); return __builtin_bit_cast(bf16x8, w); }
__device__ __forceinline__ bf16x8 make_qx(float m, int hi) {
    const float a = -m; const unsigned h0 = cvt_pk_bf16(a, 0.f) & 0xffffu; const float r1 = a - __uint_as_float(h0 << 16); const unsigned h1 = cvt_pk_bf16(r1, 0.f) & 0xffffu; const float r2 = r1 - __uint_as_float(h1 << 16); const unsigned h2 = cvt_pk_bf16(r2, 0.f) & 0xffffu;
    u32x4 w; w.x = 0x3F803F80u; w.y = h0 | (h1 << 16); w.z = h2; w.w = 0u; if (hi) { w.x = 0u; w.y = 0u; w.z = 0u; } return __builtin_bit_cast(bf16x8, w);
}
__device__ __forceinline__ void softmax_step(f32x16& p0, f32x16& p1, float& m, float& l, f32x16 (&o)[2], bf16x8 (&pa)[4], LAS float* wsf, int r32, int hi, bool first) {
    const float rm = rowmax32(p0, p1);
    if (first || __any(rm > THR)) {
        const float d = first ? rm : fmaxf(rm, 0.f); m += d; const float sc = fast_exp2(-d); l *= sc;
        if (!first) { if (hi == 0) wsf[r32] = sc; LDS_WAIT();
#pragma unroll
            for (int g = 0; g < 4; ++g) { const f32x4 f = *(const LAS f32x4*)(wsf + 4 * hi + 8 * g);
#pragma unroll
                for (int i = 0; i < 4; ++i) { o[0][4 * g + i] *= f[i]; o[1][4 * g + i] *= f[i]; } } }
#pragma unroll
        for (int r = 0; r < 16; ++r) { p0[r] -= d; p1[r] -= d; }
    }
    float s0 = 0.f, s1 = 0.f, s2 = 0.f, s3 = 0.f;
#pragma unroll
    for (int r = 0; r < 16; r += 2) { p0[r] = fast_exp2(p0[r]); p0[r + 1] = fast_exp2(p0[r + 1]); p1[r] = fast_exp2(p1[r]); p1[r + 1] = fast_exp2(p1[r + 1]); s0 += p0[r]; s1 += p0[r + 1]; s2 += p1[r]; s3 += p1[r + 1]; }
    l += (s0 + s1) + (s2 + s3);
    pa[0] = pack8(p0, 0); pa[1] = pack8(p0, 8); pa[2] = pack8(p1, 0); pa[3] = pack8(p1, 8);
}

template <int ABL = 0>
__device__ __forceinline__ void exp_step(f32x16& p0, f32x16& p1, float& l, bf16x8 (&pa)[4]) {
#define EXPX(x) ((ABL & 1) ? (x) : fast_exp2(x))
    float s0 = 0.f, s1 = 0.f, s2 = 0.f, s3 = 0.f;
#pragma unroll
    for (int r = 0; r < 16; r += 2) { p0[r] = EXPX(p0[r]); p0[r + 1] = EXPX(p0[r + 1]); p1[r] = EXPX(p1[r]); p1[r + 1] = EXPX(p1[r + 1]); s0 += p0[r]; s1 += p0[r + 1]; s2 += p1[r]; s3 += p1[r + 1]; }
    l += (s0 + s1) + (s2 + s3);
    pa[0] = pack8(p0, 0); pa[1] = pack8(p0, 8); pa[2] = pack8(p1, 0); pa[3] = pack8(p1, 8);
}
#undef EXPX
struct St { float m1, l1, m2, l2; f32x16 o1[2], o2[2]; bf16x8 qx; bool first, mnz; };
template <int ABL = 0>
__device__ __forceinline__ void tile_fast_diff(St& S, const LAS unsigned char* kb, const LAS unsigned char* vb, const bf16x8 (&qr)[4]) {
    bf16x8 kf[8];
#pragma unroll
    for (int d0 = 0; d0 < 4; ++d0) { kf[2 * d0] = *(const LAS bf16x8*)(kb + d0 * 2048); kf[2 * d0 + 1] = *(const LAS bf16x8*)(kb + d0 * 2048 + 512); }
    __builtin_amdgcn_sched_barrier(0);
    f32x16 a0 = f32x16{}, a1 = f32x16{}, b0 = f32x16{}, b1 = f32x16{};
    ATT_PRIO(1);
    if (!(ABL & 4)) {
    a0 = __builtin_amdgcn_mfma_f32_32x32x16_bf16(kf[0], qr[0], a0, 0, 0, 0); a1 = __builtin_amdgcn_mfma_f32_32x32x16_bf16(kf[1], qr[0], a1, 0, 0, 0);
    b0 = __builtin_amdgcn_mfma_f32_32x32x16_bf16(kf[4], qr[2], b0, 0, 0, 0); b1 = __builtin_amdgcn_mfma_f32_32x32x16_bf16(kf[5], qr[2], b1, 0, 0, 0);
    a0 = __builtin_amdgcn_mfma_f32_32x32x16_bf16(kf[2], qr[1], a0, 0, 0, 0); a1 = __builtin_amdgcn_mfma_f32_32x32x16_bf16(kf[3], qr[1], a1, 0, 0, 0);
    b0 = __builtin_amdgcn_mfma_f32_32x32x16_bf16(kf[6], qr[3], b0, 0, 0, 0); b1 = __builtin_amdgcn_mfma_f32_32x32x16_bf16(kf[7], qr[3], b1, 0, 0, 0); }
    else { a0[0] = __builtin_bit_cast(float, (int)kf[0][0] + (int)kf[1][1] + (int)kf[2][0] + (int)kf[3][0]); b0[0] = __builtin_bit_cast(float, (int)kf[4][0] + (int)kf[5][0] + (int)kf[6][0] + (int)kf[7][0]); }
    bf16x8 vf0[4], vf1[4];
#pragma unroll
    for (int ks = 0; ks < 4; ++ks) { const s16x4 lo = vtr(vb + ks * 1024), hi4 = vtr(vb + ks * 1024 + 512); vf0[ks] = (bf16x8){lo[0], lo[1], lo[2], lo[3], hi4[0], hi4[1], hi4[2], hi4[3]}; }
    __builtin_amdgcn_sched_barrier(0);
    bf16x8 pa1[4], pa2[4];
    ATT_PRIO(0);
    exp_step<ABL>(a0, a1, S.l1, pa1);
    exp_step<ABL>(b0, b1, S.l2, pa2);
    __builtin_amdgcn_sched_barrier(0);
#pragma unroll
    for (int ks = 0; ks < 4; ++ks) { const s16x4 lo = vtr(vb + 4096 + ks * 1024), hi4 = vtr(vb + 4096 + ks * 1024 + 512); vf1[ks] = (bf16x8){lo[0], lo[1], lo[2], lo[3], hi4[0], hi4[1], hi4[2], hi4[3]}; }
#pragma unroll
    ATT_PRIO(1);
    for (int ks = 0; ks < 4; ++ks) { if (!(ABL & 2)) { S.o1[0] = __builtin_amdgcn_mfma_f32_32x32x16_bf16(pa1[ks], vf0[ks], S.o1[0], 0, 0, 0); S.o2[0] = __builtin_amdgcn_mfma_f32_32x32x16_bf16(pa2[ks], vf0[ks], S.o2[0], 0, 0, 0); } else { S.o1[0][0] += __builtin_bit_cast(float, (int)pa1[ks][0] + (int)vf0[ks][0]); S.o2[0][0] += __builtin_bit_cast(float, (int)pa2[ks][0] + (int)vf0[ks][4]); } }
    __builtin_amdgcn_sched_barrier(0);
#pragma unroll
    for (int ks = 0; ks < 4; ++ks) { if (!(ABL & 2)) { S.o1[1] = __builtin_amdgcn_mfma_f32_32x32x16_bf16(pa1[ks], vf1[ks], S.o1[1], 0, 0, 0); S.o2[1] = __builtin_amdgcn_mfma_f32_32x32x16_bf16(pa2[ks], vf1[ks], S.o2[1], 0, 0, 0); } else { S.o1[1][0] += __builtin_bit_cast(float, (int)pa1[ks][1] + (int)vf1[ks][0]); S.o2[1][0] += __builtin_bit_cast(float, (int)pa2[ks][1] + (int)vf1[ks][4]); } }
    ATT_PRIO(0);
    __builtin_amdgcn_sched_barrier(0);
}


template <int B>
__device__ __forceinline__ void exp4(const f32x16& p, float& l, unsigned& w0, unsigned& w1) {
    const float e0 = fast_exp2(p[B]), e1 = fast_exp2(p[B + 1]), e2 = fast_exp2(p[B + 2]), e3 = fast_exp2(p[B + 3]);
    l += (e0 + e1) + (e2 + e3); w0 = cvt_pk_bf16(e0, e1); w1 = cvt_pk_bf16(e2, e3);
}
#define EXP8(P, B0, L, DST) do { unsigned x0_, x1_, x2_, x3_; exp4<B0>(P, L, x0_, x1_); exp4<B0 + 4>(P, L, x2_, x3_); DST = __builtin_bit_cast(bf16x8, (u32x4){x0_, x1_, x2_, x3_}); } while (0)
__device__ __forceinline__ void tile_fast_diff_il(St& S, const LAS unsigned char* kb, const LAS unsigned char* vb, const bf16x8 (&qr)[4]) {
    bf16x8 kf[8], vf0[4], vf1[4];
#pragma unroll
    for (int d0 = 0; d0 < 4; ++d0) { kf[2 * d0] = *(const LAS bf16x8*)(kb + d0 * 2048); kf[2 * d0 + 1] = *(const LAS bf16x8*)(kb + d0 * 2048 + 512); }
    __builtin_amdgcn_sched_barrier(0);
    f32x16 a0 = f32x16{}, a1 = f32x16{}, b0 = f32x16{}, b1 = f32x16{};
    a0 = __builtin_amdgcn_mfma_f32_32x32x16_bf16(kf[0], qr[0], a0, 0, 0, 0); a1 = __builtin_amdgcn_mfma_f32_32x32x16_bf16(kf[1], qr[0], a1, 0, 0, 0);
    a0 = __builtin_amdgcn_mfma_f32_32x32x16_bf16(kf[2], qr[1], a0, 0, 0, 0); a1 = __builtin_amdgcn_mfma_f32_32x32x16_bf16(kf[3], qr[1], a1, 0, 0, 0);
#pragma unroll
    for (int ks = 0; ks < 4; ++ks) { const s16x4 lo = vtr(vb + ks * 1024), hi4 = vtr(vb + ks * 1024 + 512); vf0[ks] = (bf16x8){lo[0], lo[1], lo[2], lo[3], hi4[0], hi4[1], hi4[2], hi4[3]}; }
#pragma unroll
    for (int ks = 0; ks < 4; ++ks) { const s16x4 lo = vtr(vb + 4096 + ks * 1024), hi4 = vtr(vb + 4096 + ks * 1024 + 512); vf1[ks] = (bf16x8){lo[0], lo[1], lo[2], lo[3], hi4[0], hi4[1], hi4[2], hi4[3]}; }
    __builtin_amdgcn_sched_barrier(0);
    bf16x8 pa1[4], pa2[4]; float la = 0.f, lb = 0.f; unsigned w0, w1, w2, w3;
#define MF(acc, A_, B_) acc = __builtin_amdgcn_mfma_f32_32x32x16_bf16(A_, B_, acc, 0, 0, 0)
#define PK(dst) dst = __builtin_bit_cast(bf16x8, (u32x4){w0, w1, w2, w3})
#define SB() __builtin_amdgcn_sched_barrier(0)
    MF(b0, kf[4], qr[2]); exp4<0>(a0, la, w0, w1); SB();
    MF(b1, kf[5], qr[2]); exp4<4>(a0, lb, w2, w3); PK(pa1[0]); SB();
    MF(b0, kf[6], qr[3]); exp4<8>(a0, la, w0, w1); SB();
    MF(b1, kf[7], qr[3]); exp4<12>(a0, lb, w2, w3); PK(pa1[1]); SB();
    MF(S.o1[0], pa1[0], vf0[0]); exp4<0>(a1, la, w0, w1); SB();
    MF(S.o1[1], pa1[0], vf1[0]); exp4<4>(a1, lb, w2, w3); PK(pa1[2]); SB();
    MF(S.o1[0], pa1[1], vf0[1]); exp4<8>(a1, la, w0, w1); SB();
    MF(S.o1[1], pa1[1], vf1[1]); exp4<12>(a1, lb, w2, w3); PK(pa1[3]); SB();
    S.l1 += la + lb; la = 0.f; lb = 0.f;
    MF(S.o1[0], pa1[2], vf0[2]); exp4<0>(b0, la, w0, w1); SB();
    MF(S.o1[1], pa1[2], vf1[2]); exp4<4>(b0, lb, w2, w3); PK(pa2[0]); SB();
    MF(S.o1[0], pa1[3], vf0[3]); MF(S.o2[0], pa2[0], vf0[0]); exp4<8>(b0, la, w0, w1); SB();
    MF(S.o1[1], pa1[3], vf1[3]); MF(S.o2[1], pa2[0], vf1[0]); exp4<12>(b0, lb, w2, w3); PK(pa2[1]); SB();
    MF(S.o2[0], pa2[1], vf0[1]); exp4<0>(b1, la, w0, w1); SB();
    MF(S.o2[1], pa2[1], vf1[1]); exp4<4>(b1, lb, w2, w3); PK(pa2[2]); SB();
    MF(S.o2[0], pa2[2], vf0[2]); exp4<8>(b1, la, w0, w1); SB();
    MF(S.o2[1], pa2[2], vf1[2]); exp4<12>(b1, lb, w2, w3); PK(pa2[3]); SB();
    S.l2 += la + lb;
    MF(S.o2[0], pa2[3], vf0[3]); MF(S.o2[1], pa2[3], vf1[3]); SB();
#undef MF
#undef PK
#undef SB
}
#undef EXP8

template <int ABL = 0>
__device__ __forceinline__ void diff_front(St& S, const LAS unsigned char* kb, const bf16x8 (&qr)[4], bf16x8 (&pa1)[4], bf16x8 (&pa2)[4]) {
    bf16x8 kf[8];
#pragma unroll
    for (int d0 = 0; d0 < 4; ++d0) { kf[2 * d0] = *(const LAS bf16x8*)(kb + d0 * 2048); kf[2 * d0 + 1] = *(const LAS bf16x8*)(kb + d0 * 2048 + 512); }
    __builtin_amdgcn_sched_barrier(0);
    f32x16 a0 = f32x16{}, a1 = f32x16{}, b0 = f32x16{}, b1 = f32x16{};
    ATT_PRIO(1);
    if (!(ABL & 4)) {
    a0 = __builtin_amdgcn_mfma_f32_32x32x16_bf16(kf[0], qr[0], a0, 0, 0, 0); a1 = __builtin_amdgcn_mfma_f32_32x32x16_bf16(kf[1], qr[0], a1, 0, 0, 0);
    b0 = __builtin_amdgcn_mfma_f32_32x32x16_bf16(kf[4], qr[2], b0, 0, 0, 0); b1 = __builtin_amdgcn_mfma_f32_32x32x16_bf16(kf[5], qr[2], b1, 0, 0, 0);
    a0 = __builtin_amdgcn_mfma_f32_32x32x16_bf16(kf[2], qr[1], a0, 0, 0, 0); a1 = __builtin_amdgcn_mfma_f32_32x32x16_bf16(kf[3], qr[1], a1, 0, 0, 0);
    b0 = __builtin_amdgcn_mfma_f32_32x32x16_bf16(kf[6], qr[3], b0, 0, 0, 0); b1 = __builtin_amdgcn_mfma_f32_32x32x16_bf16(kf[7], qr[3], b1, 0, 0, 0); }
    else { a0[0] = __builtin_bit_cast(float, (int)kf[0][0] + (int)kf[1][1] + (int)kf[2][0] + (int)kf[3][0]); b0[0] = __builtin_bit_cast(float, (int)kf[4][0] + (int)kf[5][0] + (int)kf[6][0] + (int)kf[7][0]); }
    __builtin_amdgcn_sched_barrier(0);
    ATT_PRIO(0);
    exp_step<ABL>(a0, a1, S.l1, pa1);
    exp_step<ABL>(b0, b1, S.l2, pa2);
    __builtin_amdgcn_sched_barrier(0);
}
template <int ABL = 0>
__device__ __forceinline__ void diff_back(St& S, const LAS unsigned char* vb, const bf16x8 (&pa1)[4], const bf16x8 (&pa2)[4]) {
    bf16x8 vf0[4], vf1[4];
#pragma unroll
    for (int ks = 0; ks < 4; ++ks) { const s16x4 lo = vtr(vb + ks * 1024), hi4 = vtr(vb + ks * 1024 + 512); vf0[ks] = (bf16x8){lo[0], lo[1], lo[2], lo[3], hi4[0], hi4[1], hi4[2], hi4[3]}; }
#pragma unroll
    for (int ks = 0; ks < 4; ++ks) { const s16x4 lo = vtr(vb + 4096 + ks * 1024), hi4 = vtr(vb + 4096 + ks * 1024 + 512); vf1[ks] = (bf16x8){lo[0], lo[1], lo[2], lo[3], hi4[0], hi4[1], hi4[2], hi4[3]}; }
    __builtin_amdgcn_sched_barrier(0);
#pragma unroll
    ATT_PRIO(1);
    for (int ks = 0; ks < 4; ++ks) { if (!(ABL & 2)) { S.o1[0] = __builtin_amdgcn_mfma_f32_32x32x16_bf16(pa1[ks], vf0[ks], S.o1[0], 0, 0, 0); S.o2[0] = __builtin_amdgcn_mfma_f32_32x32x16_bf16(pa2[ks], vf0[ks], S.o2[0], 0, 0, 0); } else { S.o1[0][0] += __builtin_bit_cast(float, (int)pa1[ks][0] + (int)vf0[ks][0]); S.o2[0][0] += __builtin_bit_cast(float, (int)pa2[ks][0] + (int)vf0[ks][4]); } }
#pragma unroll
    for (int ks = 0; ks < 4; ++ks) { if (!(ABL & 2)) { S.o1[1] = __builtin_amdgcn_mfma_f32_32x32x16_bf16(pa1[ks], vf1[ks], S.o1[1], 0, 0, 0); S.o2[1] = __builtin_amdgcn_mfma_f32_32x32x16_bf16(pa2[ks], vf1[ks], S.o2[1], 0, 0, 0); } else { S.o1[1][0] += __builtin_bit_cast(float, (int)pa1[ks][1] + (int)vf1[ks][0]); S.o2[1][0] += __builtin_bit_cast(float, (int)pa2[ks][1] + (int)vf1[ks][4]); } }
    ATT_PRIO(0);
    __builtin_amdgcn_sched_barrier(0);
}

__device__ __forceinline__ void tile_fox(St& S, const LAS unsigned char* kb, const LAS unsigned char* vb, const LAS unsigned char* kx, const bf16x8 (&qr)[4], int t, int qmin, int qrow, LAS float* wsf, int r32, int hi) {
    bf16x8 kf[8];
#pragma unroll
    for (int d0 = 0; d0 < 4; ++d0) { kf[2 * d0] = *(const LAS bf16x8*)(kb + d0 * 2048); kf[2 * d0 + 1] = *(const LAS bf16x8*)(kb + d0 * 2048 + 512); }
    const bf16x8 x0 = *(const LAS bf16x8*)kx, x1 = *(const LAS bf16x8*)(kx + 512);
    __builtin_amdgcn_sched_barrier(0);
    f32x16 p0 = f32x16{}, p1 = f32x16{};
#pragma unroll
    for (int d0 = 0; d0 < 4; ++d0) { p0 = __builtin_amdgcn_mfma_f32_32x32x16_bf16(kf[2 * d0], qr[d0], p0, 0, 0, 0); p1 = __builtin_amdgcn_mfma_f32_32x32x16_bf16(kf[2 * d0 + 1], qr[d0], p1, 0, 0, 0); }
    p0 = __builtin_amdgcn_mfma_f32_32x32x16_bf16(x0, S.qx, p0, 0, 0, 0); p1 = __builtin_amdgcn_mfma_f32_32x32x16_bf16(x1, S.qx, p1, 0, 0, 0);
    bf16x8 vf0[4], vf1[4];
#pragma unroll
    for (int ks = 0; ks < 4; ++ks) { const s16x4 lo = vtr(vb + ks * 1024), hi4 = vtr(vb + ks * 1024 + 512); vf0[ks] = (bf16x8){lo[0], lo[1], lo[2], lo[3], hi4[0], hi4[1], hi4[2], hi4[3]}; }
    __builtin_amdgcn_sched_barrier(0);
    if (64 * t + 63 > qmin) {
#pragma unroll
        for (int r = 0; r < 16; ++r) { const int kv = 64 * t + crow(r, hi); if (kv > qrow) p0[r] = -INFINITY; if (kv + 32 > qrow) p1[r] = -INFINITY; } }
    bf16x8 pa1[4];
#if FOX_IL
    {
        const float rm = rowmax32(p0, p1);
        if (S.first || __any(rm > THR)) {
            const float d = S.first ? rm : fmaxf(rm, 0.f); S.m1 += d; const float sc = fast_exp2(-d); S.l1 *= sc;
            if (!S.first) { if (hi == 0) wsf[r32] = sc; LDS_WAIT();
#pragma unroll
                for (int g = 0; g < 4; ++g) { const f32x4 f = *(const LAS f32x4*)(wsf + 4 * hi + 8 * g);
#pragma unroll
                    for (int i = 0; i < 4; ++i) { S.o1[0][4 * g + i] *= f[i]; S.o1[1][4 * g + i] *= f[i]; } } }
#pragma unroll
            for (int r = 0; r < 16; ++r) { p0[r] -= d; p1[r] -= d; }
        }
        S.qx = make_qx(S.m1, hi);
#pragma unroll
        for (int ks = 0; ks < 4; ++ks) { const s16x4 lo = vtr(vb + 4096 + ks * 1024), hi4 = vtr(vb + 4096 + ks * 1024 + 512); vf1[ks] = (bf16x8){lo[0], lo[1], lo[2], lo[3], hi4[0], hi4[1], hi4[2], hi4[3]}; }
        __builtin_amdgcn_sched_barrier(0);
        float la = 0.f, lb = 0.f; unsigned w0, w1, w2, w3;
#define MF(acc, A_, B_) acc = __builtin_amdgcn_mfma_f32_32x32x16_bf16(A_, B_, acc, 0, 0, 0)
#define PK(dst) dst = __builtin_bit_cast(bf16x8, (u32x4){w0, w1, w2, w3})
#define SB() __builtin_amdgcn_sched_barrier(0)
        exp4<0>(p0, la, w0, w1); SB();
        exp4<4>(p0, lb, w2, w3); PK(pa1[0]); SB();
        MF(S.o1[0], pa1[0], vf0[0]); exp4<8>(p0, la, w0, w1); SB();
        MF(S.o1[1], pa1[0], vf1[0]); exp4<12>(p0, lb, w2, w3); PK(pa1[1]); SB();
        MF(S.o1[0], pa1[1], vf0[1]); exp4<0>(p1, la, w0, w1); SB();
        MF(S.o1[1], pa1[1], vf1[1]); exp4<4>(p1, lb, w2, w3); PK(pa1[2]); SB();
        MF(S.o1[0], pa1[2], vf0[2]); exp4<8>(p1, la, w0, w1); SB();
        MF(S.o1[1], pa1[2], vf1[2]); exp4<12>(p1, lb, w2, w3); PK(pa1[3]); SB();
        S.l1 += la + lb;
        MF(S.o1[0], pa1[3], vf0[3]); MF(S.o1[1], pa1[3], vf1[3]); SB();
#undef MF
#undef PK
#undef SB
    }
#else
    softmax_step(p0, p1, S.m1, S.l1, S.o1, pa1, wsf, r32, hi, S.first);
    S.qx = make_qx(S.m1, hi);
    __builtin_amdgcn_sched_barrier(0);
#pragma unroll
    for (int ks = 0; ks < 4; ++ks) { const s16x4 lo = vtr(vb + 4096 + ks * 1024), hi4 = vtr(vb + 4096 + ks * 1024 + 512); vf1[ks] = (bf16x8){lo[0], lo[1], lo[2], lo[3], hi4[0], hi4[1], hi4[2], hi4[3]}; }
#pragma unroll
    for (int ks = 0; ks < 4; ++ks) S.o1[0] = __builtin_amdgcn_mfma_f32_32x32x16_bf16(pa1[ks], vf0[ks], S.o1[0], 0, 0, 0);
    __builtin_amdgcn_sched_barrier(0);
#pragma unroll
    for (int ks = 0; ks < 4; ++ks) S.o1[1] = __builtin_amdgcn_mfma_f32_32x32x16_bf16(pa1[ks], vf1[ks], S.o1[1], 0, 0, 0);
    __builtin_amdgcn_sched_barrier(0);
#endif
    S.first = false;
}
template <int MODE, bool FAST>
__device__ __forceinline__ void tile_compute(St& S, const LAS unsigned char* kb, const LAS unsigned char* vb, const LAS unsigned char* kx, const bf16x8 (&qr)[4], int t, int qmin, int qrow, LAS float* wsf, int r32, int hi) {
    bf16x8 pa1[4], pa2[4];
    {   f32x16 p0 = f32x16{}, p1 = f32x16{};
#pragma unroll
        for (int d0 = 0; d0 < (MODE == 0 ? 4 : 2); ++d0) { const bf16x8 k0 = *(const LAS bf16x8*)(kb + d0 * 2048), k1 = *(const LAS bf16x8*)(kb + d0 * 2048 + 512);
            p0 = __builtin_amdgcn_mfma_f32_32x32x16_bf16(k0, qr[d0], p0, 0, 0, 0); p1 = __builtin_amdgcn_mfma_f32_32x32x16_bf16(k1, qr[d0], p1, 0, 0, 0); }
        if (MODE == 0) {
            const bf16x8 x0 = *(const LAS bf16x8*)kx, x1 = *(const LAS bf16x8*)(kx + 512);
            p0 = __builtin_amdgcn_mfma_f32_32x32x16_bf16(x0, S.qx, p0, 0, 0, 0); p1 = __builtin_amdgcn_mfma_f32_32x32x16_bf16(x1, S.qx, p1, 0, 0, 0);
            if (64 * t + 63 > qmin) {
#pragma unroll
                for (int r = 0; r < 16; ++r) { const int kv = 64 * t + crow(r, hi); if (kv > qrow) p0[r] = -INFINITY; if (kv + 32 > qrow) p1[r] = -INFINITY; } }
        } else if (!FAST && S.mnz) {
#pragma unroll
            for (int r = 0; r < 16; ++r) { p0[r] -= S.m1; p1[r] -= S.m1; } }
        if (FAST) { exp_step(p0, p1, S.l1, pa1); __builtin_amdgcn_sched_barrier(0); } else
        softmax_step(p0, p1, S.m1, S.l1, S.o1, pa1, wsf, r32, hi, MODE == 0 ? S.first : false);
        if (MODE == 0) { if (S.first || __any(S.m1 != 0.f)) S.qx = make_qx(S.m1, hi); }
    }
    if (MODE == 1) {
        f32x16 p0 = f32x16{}, p1 = f32x16{};
#pragma unroll
        for (int d0 = 2; d0 < 4; ++d0) { const bf16x8 k0 = *(const LAS bf16x8*)(kb + d0 * 2048), k1 = *(const LAS bf16x8*)(kb + d0 * 2048 + 512);
            p0 = __builtin_amdgcn_mfma_f32_32x32x16_bf16(k0, qr[d0], p0, 0, 0, 0); p1 = __builtin_amdgcn_mfma_f32_32x32x16_bf16(k1, qr[d0], p1, 0, 0, 0); }
        if (!FAST && S.mnz) {
#pragma unroll
            for (int r = 0; r < 16; ++r) { p0[r] -= S.m2; p1[r] -= S.m2; } }
        if (FAST) { exp_step(p0, p1, S.l2, pa2); __builtin_amdgcn_sched_barrier(0); } else {
        softmax_step(p0, p1, S.m2, S.l2, S.o2, pa2, wsf, r32, hi, false);
        S.mnz = __any(S.m1 != 0.f || S.m2 != 0.f); }
    }
#pragma unroll
    for (int d0 = 0; d0 < 2; ++d0) { bf16x8 vf[4];
#pragma unroll
        for (int ks = 0; ks < 4; ++ks) { const s16x4 lo = vtr(vb + d0 * 4096 + ks * 1024), hi4 = vtr(vb + d0 * 4096 + ks * 1024 + 512); vf[ks] = (bf16x8){lo[0], lo[1], lo[2], lo[3], hi4[0], hi4[1], hi4[2], hi4[3]}; }
        if (MODE == 0) __builtin_amdgcn_sched_barrier(0);
#pragma unroll
        for (int ks = 0; ks < 4; ++ks) { S.o1[d0] = __builtin_amdgcn_mfma_f32_32x32x16_bf16(pa1[ks], vf[ks], S.o1[d0], 0, 0, 0);
            if (MODE == 1) S.o2[d0] = __builtin_amdgcn_mfma_f32_32x32x16_bf16(pa2[ks], vf[ks], S.o2[d0], 0, 0, 0); }
        if (MODE == 0) __builtin_amdgcn_sched_barrier(0);
    }
    S.first = false;
}

#define SBAR() __builtin_amdgcn_sched_barrier(0)
#define DQK(P0, P1, j, d0a) do { const LAS unsigned char* kb_ = kq + (j) * SLOTB; P0 = f32x16{}; P1 = f32x16{}; \
        _Pragma("unroll") for (int d0 = (d0a); d0 < (d0a) + 2; ++d0) { const bf16x8 k0 = *(const LAS bf16x8*)(kb_ + d0 * 2048), k1 = *(const LAS bf16x8*)(kb_ + d0 * 2048 + 512); \
            P0 = __builtin_amdgcn_mfma_f32_32x32x16_bf16(k0, qr[d0], P0, 0, 0, 0); P1 = __builtin_amdgcn_mfma_f32_32x32x16_bf16(k1, qr[d0], P1, 0, 0, 0); } } while (0)
#define DPV(j) do { const LAS unsigned char* vb_ = vq + (j) * SLOTB; \
        _Pragma("unroll") for (int d0 = 0; d0 < 2; ++d0) { _Pragma("unroll") for (int ks = 0; ks < 4; ++ks) { const s16x4 lo = vtr(vb_ + d0 * 4096 + ks * 1024), hi4 = vtr(vb_ + d0 * 4096 + ks * 1024 + 512); \
            const bf16x8 vf = (bf16x8){lo[0], lo[1], lo[2], lo[3], hi4[0], hi4[1], hi4[2], hi4[3]}; \
            S.o1[d0] = __builtin_amdgcn_mfma_f32_32x32x16_bf16(pa1[ks], vf, S.o1[d0], 0, 0, 0); S.o2[d0] = __builtin_amdgcn_mfma_f32_32x32x16_bf16(pa2[ks], vf, S.o2[d0], 0, 0, 0); } SBAR(); } } while (0)
__device__ __forceinline__ void diff_fast_step(St& S, const LAS unsigned char* kq, const LAS unsigned char* vq, const bf16x8 (&qr)[4], int ntl) {
    f32x16 pA0, pA1, pB0, pB1; bf16x8 pa1[4], pa2[4];
    if (ntl == 2) {
        DQK(pA0, pA1, 0, 0); SBAR();
        DQK(pB0, pB1, 0, 2); exp_step(pA0, pA1, S.l1, pa1); SBAR();
        DQK(pA0, pA1, 1, 0); exp_step(pB0, pB1, S.l2, pa2); SBAR();
        DPV(0);
        DQK(pB0, pB1, 1, 2); exp_step(pA0, pA1, S.l1, pa1); SBAR();
        exp_step(pB0, pB1, S.l2, pa2); SBAR();
        DPV(1);
    } else if (ntl == 1) {
        DQK(pA0, pA1, 0, 0); SBAR();
        DQK(pB0, pB1, 0, 2); exp_step(pA0, pA1, S.l1, pa1); SBAR();
        exp_step(pB0, pB1, S.l2, pa2); SBAR();
        DPV(0);
    }
}
#undef DQK
#undef DPV
#undef SBAR

template <int MODE, bool FAST, int ABL = 0>
__device__ __forceinline__ void attn_unit(const Frame& F, ARGS_T& A, int l, int b, int h, int qb, float thr_in = 0.f) {
    LAS unsigned char* shm = F.lds + RING_OFF;
    int lane = F.lane; asm volatile("" : "+v"(lane));
    const int r32 = lane & 31, hi = lane >> 5, wid = F.wave, tid_ = wid * 64 + lane;
    const bf16* PA = WSP(bf16, WS_PA);
    const size_t rowbase = (size_t)b * SEQ; const int q0 = qb * 256;
    constexpr int QC = MODE == 0 ? 0 : 768, KC = MODE == 0 ? 256 : 1024, VC = MODE == 0 ? 512 : 1280;
    const bf16* Qw = PA + (rowbase + q0 + wid * 32 + r32) * PA_LD + QC + h * 64;
    const bf16* Kh = PA + rowbase * PA_LD + KC + h * 64; const bf16* Vh = PA + rowbase * PA_LD + VC + h * 64;
    const unsigned lds0 = (unsigned)(uintptr_t)shm;
    LAS float* wsf = (LAS float*)(shm + L_WS) + wid * 64;
    unsigned koff = (unsigned)(lane * PA_LD + wid * 8) * 2u, voff = (unsigned)((16 * (wid & 3) + (lane >> 2)) * PA_LD + (wid >> 2) * 32 + (lane & 3) * 8) * 2u;
    asm volatile("" : "+v"(koff), "+v"(voff));
    const unsigned kdst = lds0 + L_K + wid * 1024, vdst = lds0 + L_V + wid * 1024;
#define DMA_KV(t, slot, vslot) do { glds16s(Kh + (size_t)(t) * 64 * PA_LD, koff, (unsigned)__builtin_amdgcn_readfirstlane(kdst + (slot) * SLOTB)); glds16s(Vh + (size_t)(t) * 64 * PA_LD, voff, (unsigned)__builtin_amdgcn_readfirstlane(vdst + (vslot) * SLOTB)); } while (0)
    bf16x8 qr[4];
#pragma unroll
    for (int d0 = 0; d0 < 4; ++d0) qr[d0] = *(const bf16x8*)(Qw + d0 * 16 + hi * 8);
    const int NTF = 4 * qb + 4;
    const float* cum = WSP(float, WS_CUMF) + (size_t)(b * 4 + h) * SEQ;
    float cq0 = 0.f; if (MODE == 0) cq0 = cum[q0];
    int tlo = 0;
    if (MODE == 0) { const float thr = thr_in;
        LAS int* TL = (LAS int*)(shm + L_WS + NWAVES * 256 - 16);
        if (tid_ == 0) *TL = NTF - 4;
        __syncthreads();
        if (tid_ < NTF - 4) { if (cq0 - cum[tid_ * 64 + 63] >= -thr) __hip_atomic_fetch_min(TL, tid_, __ATOMIC_RELAXED, __HIP_MEMORY_SCOPE_WORKGROUP); }
        __syncthreads();
        tlo = *TL; __syncthreads(); }
    const int NT = NTF - tlo, NT2 = (NT + 1) >> 1;
#define TILE_OF(i) (MODE == 0 ? (NTF - 1 - (i)) : (i))
#define KX_LOAD(i2) ((2 * (i2) + (tid_ >> 6) < NT) ? cq0 - cum[TILE_OF(2 * (i2) + (tid_ >> 6)) * 64 + (tid_ & 63)] : 0.f)
#define KX_RAW(i2) cum[TILE_OF((2 * (i2) + (tid_ >> 6) < NT) ? 2 * (i2) + (tid_ >> 6) : 2 * (i2)) * 64 + (tid_ & 63)]
#define KX_VAL(i2, raw) ((2 * (i2) + (tid_ >> 6) < NT) ? cq0 - (raw) : 0.f)
#define KX_STORE(base, bv) do { const float b_ = (bv); const unsigned hb_ = cvt_pk_bf16(b_, 0.f) & 0xffffu; const float lo_ = b_ - __uint_as_float(hb_ << 16); u32x4 w_; w_.x = hb_ | (cvt_pk_bf16(lo_, 0.f) << 16); w_.y = 0x3F803F80u; w_.z = 0x3F80u; w_.w = 0u; \
        *(LAS u32x4*)(shm + L_KX + ((base) + (tid_ >> 6)) * 1024 + (tid_ & 63) * 16) = w_; } while (0)
    float kxv = 0.f;
    DMA_KV(TILE_OF(0), 0, 0); if (NT > 1) DMA_KV(TILE_OF(1), 1, 1);
    if (MODE == 0 && tid_ < 128) { kxv = KX_LOAD(0); KX_STORE(0, kxv); }
    St S; S.m1 = 0.f; S.l1 = 0.f; S.m2 = 0.f; S.l2 = 0.f; S.first = true; S.mnz = false; S.qx = make_qx(0.f, hi);
#pragma unroll
    for (int d = 0; d < 2; ++d) { S.o1[d] = f32x16{}; S.o2[d] = f32x16{}; }
    const int qmin = q0 + wid * 32, qrow = qmin + r32;
    ATT_WAIT_BAR();
    asm volatile("" : "+v"(qr[0]), "+v"(qr[1]), "+v"(qr[2]), "+v"(qr[3]), "+v"(cq0));
    constexpr bool LAGP = (MODE == 1 && FAST && DIFF_LAG);
    auto step_loop = [&](auto role_) { constexpr bool LAGW = decltype(role_)::value != 0;
    int vcur = 0, pend = -1; bf16x8 pp1[4], pp2[4];
    if (LAGW) {
#pragma unroll
        for (int ks = 0; ks < 4; ++ks) { pp1[ks] = bf16x8{}; pp2[ks] = bf16x8{}; } }
    for (int it = 0; it < NT2; ++it) {
        const int base = (it & 1) * 2; const int vnxt = LAGP ? (vcur == 4 ? 0 : vcur + 2) : (base ^ 2);
        if (!LAGP) vcur = base;
        if (it + 1 < NT2) { DMA_KV(TILE_OF(2 * it + 2), base ^ 2, vnxt); if (2 * it + 3 < NT) DMA_KV(TILE_OF(2 * it + 3), (base ^ 2) + 1, vnxt + 1); if (MODE == 0 && tid_ < 128) kxv = KX_RAW(it + 1); }
        const LAS unsigned char* kq = shm + L_K + base * SLOTB + hi * 1024 + r32 * 16; const LAS unsigned char* vq = shm + L_V + (LAGP ? 0 : base * SLOTB) + ((lane >> 4) & 1) * 32 + (lane & 3) * 8 + (4 * hi + ((lane & 15) >> 2)) * 64;
        const LAS unsigned char* kxq = shm + L_KX + base * 1024 + r32 * 16;
        asm volatile("" : "+v"(kq), "+v"(vq), "+v"(kxq));
        if (MODE == 1 && FAST && ATT_STAGGER > 0) { if (wid >= 4) __builtin_amdgcn_s_sleep(ATT_STAGGER); }
#pragma unroll
        for (int j = 0; j < 2; ++j) { const int i = 2 * it + j;
            if (i < NT) { const int t = TILE_OF(i); const bool active = (MODE == 0 ? (64 * t <= qmin + 31) : (t <= 4 * qb + (wid >> 1))) && !((ABL & 8) && wid >= 4) && !((ABL & 16) && wid < 4);
                if (active) { if constexpr (LAGP) { if constexpr (!LAGW) { if constexpr (DIFF_IL && ABL == 0) tile_fast_diff_il(S, kq + j * SLOTB, vq + (vcur + j) * SLOTB, qr); else tile_fast_diff<ABL>(S, kq + j * SLOTB, vq + (vcur + j) * SLOTB, qr); }
                        else { if (pend >= 0) diff_back<ABL>(S, vq + pend * SLOTB, pp1, pp2); diff_front<ABL>(S, kq + j * SLOTB, qr, pp1, pp2); pend = vcur + j; } }
                    else if constexpr (MODE == 1 && FAST) { if constexpr (DIFF_IL && ABL == 0) tile_fast_diff_il(S, kq + j * SLOTB, vq + j * SLOTB, qr); else tile_fast_diff<ABL>(S, kq + j * SLOTB, vq + j * SLOTB, qr); } else if constexpr (MODE == 0) tile_fox(S, kq + j * SLOTB, vq + j * SLOTB, kxq + j * 1024, qr, t, qmin, qrow, wsf, r32, hi); else tile_compute<MODE, FAST>(S, kq + j * SLOTB, vq + j * SLOTB, kxq + j * 1024, qr, t, qmin, qrow, wsf, r32, hi); } }
            __builtin_amdgcn_sched_barrier(0); }
        if (MODE == 0 && it + 1 < NT2 && tid_ < 128) KX_STORE(base ^ 2, KX_VAL(it + 1, kxv));
        ATT_WAIT_BAR();
        vcur = vnxt;
    }
    if constexpr (LAGW) {
        if (pend >= 0) { const LAS unsigned char* vq = shm + L_V + ((lane >> 4) & 1) * 32 + (lane & 3) * 8 + (4 * hi + ((lane & 15) >> 2)) * 64; diff_back<ABL>(S, vq + pend * SLOTB, pp1, pp2); } }
    };
    if constexpr (LAGP) { if (wid >= 4) step_loop(IC<1>{}); else step_loop(IC<0>{}); ATT_WAIT_BAR(); }
    else step_loop(IC<0>{});
    float l1 = half_sum(S.l1), l2 = 1.f; if (MODE == 1) l2 = half_sum(S.l2);
    float lam = 0.f, post = 1.f;
    if (MODE == 1) { float d1 = 0.f, d2 = 0.f;
        for (int i = 0; i < 32; ++i) { d1 += AIN(I_LQ1)[l * 32 + i] * AIN(I_LK1)[l * 32 + i]; d2 += AIN(I_LQ2)[l * 32 + i] * AIN(I_LK2)[l * 32 + i]; }
        const float lam_init = 0.8f - 0.6f * __expf(-0.3f * (float)l); lam = __expf(d1) - __expf(d2) + lam_init; post = 1.f - lam_init; }
    if (hi == 0) { wsf[r32] = 1.f / l1; if (MODE == 1) wsf[32 + r32] = lam / l2; }
    LDS_WAIT();
    LAS float* stg = (LAS float*)(shm + L_OST) + wid * 2048;
#pragma unroll
    for (int g = 0; g < 4; ++g) { const f32x4 c1 = *(const LAS f32x4*)(wsf + 4 * hi + 8 * g); f32x4 c2 = {0.f, 0.f, 0.f, 0.f}; if (MODE == 1) c2 = *(const LAS f32x4*)(wsf + 32 + 4 * hi + 8 * g);
#pragma unroll
        for (int i = 0; i < 4; ++i) { const int r = 4 * g + i, orow = crow(r, hi);
#pragma unroll
            for (int d0 = 0; d0 < 2; ++d0) { float v = S.o1[d0][r] * c1[i]; if (MODE == 1) v -= S.o2[d0][r] * c2[i]; stg[orow * 64 + d0 * 32 + r32] = v; } } }
    LDS_WAIT();
    bf16* Y = YMIXP(F) + (rowbase + q0 + wid * 32) * DM + (MODE == 0 ? 0 : 256) + h * 64;
    const float* gn = AIN(I_DNG) + l * 64;
    int lane_e = lane; asm volatile("" : "+v"(lane_e));
    f32x4 gn0 = {1.f, 1.f, 1.f, 1.f}, gn1 = {1.f, 1.f, 1.f, 1.f}; if (MODE == 1) { gn0 = *(const f32x4*)(gn + (lane_e & 7) * 8); gn1 = *(const f32x4*)(gn + (lane_e & 7) * 8 + 4); }
#pragma unroll
    for (int i = 0; i < 4; ++i) { const int row = i * 8 + (lane_e >> 3), ch = lane_e & 7; f32x4 a = *(const LAS f32x4*)(stg + row * 64 + ch * 8), c = *(const LAS f32x4*)(stg + row * 64 + ch * 8 + 4);
        if (MODE == 1) { float ss = (a[0] * a[0] + a[1] * a[1]) + (a[2] * a[2] + a[3] * a[3]) + (c[0] * c[0] + c[1] * c[1]) + (c[2] * c[2] + c[3] * c[3]);
            ss += __shfl_xor(ss, 1); ss += __shfl_xor(ss, 2); ss += __shfl_xor(ss, 4);
            const float rs = post / sqrtf(ss * (1.f / 64.f) + LN_EPS);
            a = a * rs * gn0; c = c * rs * gn1; }
        u32x4 w; w.x = cvt_pk_bf16(a[0], a[1]); w.y = cvt_pk_bf16(a[2], a[3]); w.z = cvt_pk_bf16(c[0], c[1]); w.w = cvt_pk_bf16(c[2], c[3]);
        *(u32x4*)(Y + (size_t)row * DM + ch * 8) = w; }
    ATT_WAIT_BAR();
#undef DMA_KV
#undef TILE_OF
#undef KX_LOAD
#undef KX_RAW
#undef KX_VAL
#undef KX_STORE
}
template <int MODE, int ABL = 0>
__device__ __forceinline__ void attn_phase(const Frame& F, ARGS_T& A, int l) {
    for (int c0 = F.bid; c0 < 256; c0 += F.G) { const int c = (F.G == 256) ? (c0 & 7) * 32 + (c0 >> 3) : c0;
        const int bh = c >> 4, s = c & 15;
        bool fast = false;
        if (MODE == 1) {
            const unsigned* NRM = (const unsigned*)(F.ctl + CW_NRM + l * 128); float bmax = 0.f;
            for (int j = 0; j < 2; ++j) { const float nq = __uint_as_float(__hip_atomic_load(NRM + (2 * 16 + bh) * 2 + j, RLX_AGENT)), nk = __uint_as_float(__hip_atomic_load(NRM + (3 * 16 + bh) * 2 + j, RLX_AGENT)); bmax = fmaxf(bmax, 1.02f * sqrtf(nq * nk)); }
            fast = bmax <= DIFF_FAST_BOUND; }
        float thr = 0.f;
        if (MODE == 0) {
            const unsigned* NRM = (const unsigned*)(F.ctl + CW_NRM + l * 128);
            const unsigned w0 = __hip_atomic_load(NRM + (0 * 16 + bh) * 2, RLX_AGENT), w1 = __hip_atomic_load(NRM + (0 * 16 + bh) * 2 + 1, RLX_AGENT), w2 = __hip_atomic_load(NRM + (1 * 16 + bh) * 2, RLX_AGENT), w3 = __hip_atomic_load(NRM + (1 * 16 + bh) * 2 + 1, RLX_AGENT);
            const float nq = __uint_as_float(w0) + __uint_as_float(w1), nk = __uint_as_float(w2) + __uint_as_float(w3);
            thr = 2.f * 1.02f * sqrtf(nq * nk) + 37.f; }
        if (MODE == 1 && fast) { attn_unit<MODE, true, ABL>(F, A, l, bh >> 2, bh & 3, 31 - s); attn_unit<MODE, true, ABL>(F, A, l, bh >> 2, bh & 3, s); }
        else if (MODE == 0 || !ONLY_FAST_TEST) { attn_unit<MODE, false>(F, A, l, bh >> 2, bh & 3, 31 - s, thr); attn_unit<MODE, false>(F, A, l, bh >> 2, bh & 3, s, thr); } }
}
}
namespace hg {
constexpr int PQ = 136, PV = 72;
constexpr int L_QD = 0, L_KD = 17408, L_KO = 34816, L_QS = 43520, L_VT = 60928, L_ST = 79360, L_SEG = 114176, L_END = 116224, L_OST = 0;
static_assert(L_END <= RING_BYTES, "hgrn LDS");
struct Prep { float q[16], k[16], bc[16]; float blast, b31; };
#define HG_BAR() do { asm volatile("s_waitcnt lgkmcnt(0)" ::: "memory"); __builtin_amdgcn_s_barrier(); asm volatile("" ::: "memory"); } while (0)
struct Raw { bf16 x[16], q[16], v[16]; u32x4 st[4]; u32x4 g[2]; };
template <bool P3>
__device__ __forceinline__ void load_raw(const Frame& F, int U, Raw& R) {
    const int bh = U >> 7, n = U & 127, b = bh >> 2, h = bh & 3; const int c = F.tid & 127, seg = F.tid >> 7; const size_t tok0 = (size_t)b * SEQ + n * 64 + seg * 16; const int ch = h * 128 + c;
    const bf16* HF = WSP(bf16, WS_HF) + tok0 * 512 + ch; const bf16* HQ = WSP(bf16, WS_HQ) + tok0 * 512 + ch; const bf16* HI = WSP(bf16, WS_HI) + tok0 * 512 + ch;
#pragma unroll
    for (int i = 0; i < 16; ++i) { R.x[i] = HF[(size_t)i * 512]; R.v[i] = HI[(size_t)i * 512]; if (P3) R.q[i] = HQ[(size_t)i * 512]; }
    if (P3) { if (n > 0) { const bf16* ST = WSP(bf16, WS_ST) + (size_t)(U - 1) * 16384;
#pragma unroll
            for (int i = 0; i < 4; ++i) { const int idx = F.tid + i * NTHR; R.st[i] = *(const u32x4*)(ST + (idx >> 4) * 128 + (idx & 15) * 8); } }
        const int t = F.tid >> 3, v0 = (F.tid & 7) * 16; const bf16* HG = WSP(bf16, WS_HG) + ((size_t)b * SEQ + n * 64 + t) * 512 + h * 128 + v0; R.g[0] = *(const u32x4*)HG; R.g[1] = *(const u32x4*)(HG + 8); }
}
__device__ __forceinline__ void prep(const Frame& F, ARGS_T& A, int l, int h, const Raw& R, bool need_q, Prep& P) {
    const int c = F.tid & 127, seg = F.tid >> 7; const int ch = h * 128 + c;
    float lb = 0.f; if (l == 1) { const float b0 = AIN(I_HLB)[ch], b1 = AIN(I_HLB)[512 + ch]; lb = 1.f / (1.f + __expf(b0 - b1)); }
    LAS float* SEG = (LAS float*)(F.lds + L_SEG);
    float run = 0.f;
#pragma unroll
    for (int i = 0; i < 16; ++i) { const float x = bf2f(R.x[i]); const float e = fast_exp2(-fabsf(x) * LOG2E);
        const float s = (x >= 0.f ? 1.f : e) * fast_rcp(1.f + e);
        const float lf2 = (l == 0) ? (fminf(x, 0.f) * LOG2E - __builtin_amdgcn_logf(1.f + e)) : __builtin_amdgcn_logf(lb + (1.f - lb) * s);
        run += lf2; P.bc[i] = run; P.k[i] = (1.f - lb) * (1.f - s); P.q[i] = need_q ? bf2f(R.q[i]) : 0.f; }
    SEG[seg * 128 + c] = run;
    HG_BAR();
    const float s0 = SEG[c], s1 = SEG[128 + c], s2 = SEG[256 + c], s3 = SEG[384 + c];
    const float pre = seg == 0 ? 0.f : seg == 1 ? s0 : seg == 2 ? s0 + s1 : s0 + s1 + s2;
#pragma unroll
    for (int i = 0; i < 16; ++i) P.bc[i] += pre;
    P.b31 = s0 + s1; P.blast = (s0 + s1) + (s2 + s3);
}
__device__ __forceinline__ void store16(LAS unsigned char* dst, const float (&v)[16]) {
    u32x4 a, b; a.x = cvt_pk_bf16(v[0], v[1]); a.y = cvt_pk_bf16(v[2], v[3]); a.z = cvt_pk_bf16(v[4], v[5]); a.w = cvt_pk_bf16(v[6], v[7]);
    b.x = cvt_pk_bf16(v[8], v[9]); b.y = cvt_pk_bf16(v[10], v[11]); b.z = cvt_pk_bf16(v[12], v[13]); b.w = cvt_pk_bf16(v[14], v[15]);
    *(LAS u32x4*)dst = a; *(LAS u32x4*)(dst + 16) = b;
}
__device__ __forceinline__ void store_vt(const Frame& F, const Raw& R) {
    const int c = F.tid & 127, seg = F.tid >> 7; u32x4 a, b;
    a.x = R.v[0] | ((unsigned)R.v[1] << 16); a.y = R.v[2] | ((unsigned)R.v[3] << 16); a.z = R.v[4] | ((unsigned)R.v[5] << 16); a.w = R.v[6] | ((unsigned)R.v[7] << 16);
    b.x = R.v[8] | ((unsigned)R.v[9] << 16); b.y = R.v[10] | ((unsigned)R.v[11] << 16); b.z = R.v[12] | ((unsigned)R.v[13] << 16); b.w = R.v[14] | ((unsigned)R.v[15] << 16);
    LAS unsigned char* dst = F.lds + L_VT + c * (PV * 2) + seg * 32; *(LAS u32x4*)dst = a; *(LAS u32x4*)(dst + 16) = b;
}
__device__ __forceinline__ void pass1_unit(const Frame& F0_, ARGS_T& A, int l, int U, Raw& R, int Unext) {
    Frame F = F0_; { int t_ = F.tid; asm volatile("" : "+v"(t_)); F.tid = t_; F.lane = t_ & 63; }
    const int bh = U >> 7, h = bh & 3; const int c = F.tid & 127, seg = F.tid >> 7;
    Prep P; prep(F, A, l, h, R, false, P);
    { float kd[16];
#pragma unroll
      for (int i = 0; i < 16; ++i) kd[i] = P.k[i] * fast_exp2(P.blast - P.bc[i]);
      store16(F.lds + L_KD + c * (PV * 2) + seg * 32, kd); }
    store_vt(F, R);
    if (seg == 0) WSP(float, WS_HDEC)[(size_t)U * 128 + c] = fast_exp2(P.blast);
    HG_BAR();
    if (Unext < 2048) load_raw<false>(F, Unext, R);
    const int lane = F.lane, r32 = lane & 31, hi = lane >> 5, vb = F.wave >> 1, db0 = (F.wave & 1) * 2;
    f32x16 acc[2]; acc[0] = f32x16{}; acc[1] = f32x16{};
#pragma unroll
    for (int ks = 0; ks < 4; ++ks) { const bf16x8 a = *(const LAS bf16x8*)(F.lds + L_VT + (vb * 32 + r32) * (PV * 2) + ks * 32 + hi * 16);
#pragma unroll
        for (int j = 0; j < 2; ++j) { const bf16x8 bb = *(const LAS bf16x8*)(F.lds + L_KD + ((db0 + j) * 32 + r32) * (PV * 2) + ks * 32 + hi * 16);
            acc[j] = __builtin_amdgcn_mfma_f32_32x32x16_bf16(a, bb, acc[j], 0, 0, 0); } }
    bf16* ST = WSP(bf16, WS_ST) + (size_t)U * 16384;
#pragma unroll
    for (int j = 0; j < 2; ++j)
#pragma unroll
        for (int r = 0; r < 16; ++r) { const int v = vb * 32 + (r & 3) + 8 * (r >> 2) + 4 * hi; ST[v * 128 + (db0 + j) * 32 + r32] = f2bf(acc[j][r]); }
    HG_BAR();
}
__device__ __forceinline__ void phase_pass1(const Frame& F, ARGS_T& A, int l) {
    Raw R; if (F.bid < 2048) load_raw<false>(F, F.bid, R);
    for (int U = F.bid; U < 2048; U += F.G) pass1_unit(F, A, l, U, R, U + F.G);
}

__device__ __forceinline__ void phase_scan(const Frame& F, int skip) {
    u32x2* ST = WSP(u32x2, WS_ST); const float* HD = WSP(float, WS_HDEC);
    if (F.bid < skip) return;
    for (int g = (F.bid - skip) * NTHR + F.tid; g < 16 * 4096; g += (F.G - skip) * NTHR) { const int bh = g >> 12, rem = g & 4095, v = rem >> 5, d4 = rem & 31;
        u32x2* p = ST + ((size_t)bh * 128 * 16384 + v * 128) / 4 + d4; const float* dp = HD + (size_t)bh * 128 * 128 + 4 * d4;
        float s0 = 0.f, s1 = 0.f, s2 = 0.f, s3 = 0.f;
        for (int n0 = 0; n0 < 128; n0 += 8) { u32x2 x[8]; f32x4 dc[8];
#pragma unroll
            for (int j = 0; j < 8; ++j) { x[j] = p[(size_t)(n0 + j) * 4096]; dc[j] = *(const f32x4*)(dp + (size_t)(n0 + j) * 128); }
#pragma unroll
            for (int j = 0; j < 8; ++j) { s0 = s0 * dc[j].x + __uint_as_float(x[j].x << 16); s1 = s1 * dc[j].y + __uint_as_float(x[j].x & 0xffff0000u);
                s2 = s2 * dc[j].z + __uint_as_float(x[j].y << 16); s3 = s3 * dc[j].w + __uint_as_float(x[j].y & 0xffff0000u);
                u32x2 o; o.x = cvt_pk_bf16(s0, s1); o.y = cvt_pk_bf16(s2, s3); p[(size_t)(n0 + j) * 4096] = o; } }
    }
}
__device__ __forceinline__ void pass3_unit(const Frame& F0_, ARGS_T& A, int l, int U, Raw& R, int Unext) {
    Frame F = F0_; { int t_ = F.tid; asm volatile("" : "+v"(t_)); F.tid = t_; F.lane = t_ & 63; }
    const int bh = U >> 7, n = U & 127, b = bh >> 2, h = bh & 3; const int c = F.tid & 127, seg = F.tid >> 7;
    if (n > 0) {
#pragma unroll
        for (int i = 0; i < 4; ++i) { const int idx = F.tid + i * NTHR, v = idx >> 4, ch = idx & 15; *(LAS u32x4*)(F.lds + L_ST + v * (PQ * 2) + ch * 16) = R.st[i]; } }
    Prep P; prep(F, A, l, h, R, true, P);
    { const float ref = seg < 2 ? 0.f : P.b31;
      LAS bf16* QD = (LAS bf16*)(F.lds + L_QD); LAS bf16* KD = (LAS bf16*)(F.lds + L_KD); LAS bf16* KO = (LAS bf16*)(F.lds + L_KO); LAS bf16* QS = (LAS bf16*)(F.lds + L_QS);
#pragma unroll
      for (int i = 0; i < 16; ++i) { const int t = seg * 16 + i;
          QD[t * PQ + c] = f2bf(P.q[i] * fast_exp2(P.bc[i] - ref)); KD[t * PQ + c] = f2bf(P.k[i] * fast_exp2(ref - P.bc[i])); QS[t * PQ + c] = f2bf(P.q[i] * fast_exp2(P.bc[i]));
          if (seg < 2) KO[t * PQ + c] = f2bf(P.k[i] * fast_exp2(P.b31 - P.bc[i])); } }
    store_vt(F, R);
    u32x4 g0 = R.g[0], g1 = R.g[1]; asm volatile("" : "+v"(g0), "+v"(g1));
    HG_BAR();
    if (Unext < 2048) load_raw<true>(F, Unext, R);
    const int lane = F.lane, r32 = lane & 31, hi = lane >> 5, tb = F.wave >> 2, vb = F.wave & 3;
    f32x16 o = f32x16{};
    const LAS unsigned char* qd = F.lds + L_QD + (tb * 32 + r32) * (PQ * 2) + hi * 16;
    const LAS unsigned char* vt = F.lds + L_VT + (vb * 32 + r32) * (PV * 2) + hi * 8;
#pragma unroll
    for (int sb = 0; sb < 2; ++sb) {
        if (sb <= tb) {
            const LAS unsigned char* kk = (sb == tb) ? F.lds + L_KD + (sb * 32 + r32) * (PQ * 2) + hi * 16 : F.lds + L_KO + r32 * (PQ * 2) + hi * 16;
            bf16x8 ka[8], qa[8];
#pragma unroll
            for (int ks = 0; ks < 8; ++ks) { ka[ks] = *(const LAS bf16x8*)(kk + ks * 32); qa[ks] = *(const LAS bf16x8*)(qd + ks * 32); }
            __builtin_amdgcn_sched_barrier(0);
            f32x16 x = f32x16{};
#pragma unroll
            for (int ks = 0; ks < 8; ++ks) x = __builtin_amdgcn_mfma_f32_32x32x16_bf16(ka[ks], qa[ks], x, 0, 0, 0);
            if (sb == tb) {
#pragma unroll
                for (int r = 0; r < 16; ++r) { const int s = (r & 3) + 8 * (r >> 2) + 4 * hi; if (s > r32) x[r] = 0.f; } }
#pragma unroll
            for (int s2 = 0; s2 < 2; ++s2) { const bf16x8 pa = att::pack8(x, 8 * s2);
                const s16x4 lo = *(const LAS s16x4*)(vt + (sb * 32 + s2 * 16) * 2), hh = *(const LAS s16x4*)(vt + (sb * 32 + s2 * 16 + 8) * 2);
                const bf16x8 vf = (bf16x8){lo[0], lo[1], lo[2], lo[3], hh[0], hh[1], hh[2], hh[3]};
                o = __builtin_amdgcn_mfma_f32_32x32x16_bf16(pa, vf, o, 0, 0, 0); }
        }
    }
    if (n > 0) { const LAS unsigned char* qs = F.lds + L_QS + (tb * 32 + r32) * (PQ * 2) + hi * 16; const LAS unsigned char* st = F.lds + L_ST + (vb * 32 + r32) * (PQ * 2) + hi * 16;
        bf16x8 qa[8], sa[8];
#pragma unroll
        for (int ks = 0; ks < 8; ++ks) { qa[ks] = *(const LAS bf16x8*)(qs + ks * 32); sa[ks] = *(const LAS bf16x8*)(st + ks * 32); }
        __builtin_amdgcn_sched_barrier(0);
#pragma unroll
        for (int ks = 0; ks < 8; ++ks) o = __builtin_amdgcn_mfma_f32_32x32x16_bf16(qa[ks], sa[ks], o, 0, 0, 0); }
    HG_BAR();
    LAS float* OST = (LAS float*)(F.lds + L_OST);
#pragma unroll
    for (int r = 0; r < 16; ++r) { const int t = tb * 32 + (r & 3) + 8 * (r >> 2) + 4 * hi; OST[t * 132 + vb * 32 + r32] = o[r]; }
    HG_BAR();
    { const int t = F.tid >> 3, v0 = (F.tid & 7) * 16; const size_t tok = (size_t)b * SEQ + n * 64 + t;
      f32x4 x[4]; float ss = 0.f;
#pragma unroll
      for (int j = 0; j < 4; ++j) { x[j] = *(const LAS f32x4*)(OST + t * 132 + v0 + 4 * j); ss += (x[j][0] * x[j][0] + x[j][1] * x[j][1]) + (x[j][2] * x[j][2] + x[j][3] * x[j][3]); }
      ss += __shfl_xor(ss, 1); ss += __shfl_xor(ss, 2); ss += __shfl_xor(ss, 4);
      const float rs = 1.f / sqrtf(ss * (1.f / 128.f) + LN_EPS);
      const float* gn = AIN(I_HNG) + l * 128 + v0;
      unsigned gw[8] = {g0.x, g0.y, g0.z, g0.w, g1.x, g1.y, g1.z, g1.w};
      unsigned w[8];
#pragma unroll
      for (int j = 0; j < 4; ++j) { const f32x4 gg = *(const f32x4*)(gn + 4 * j);
          const float y0 = x[j][0] * rs * gg[0] * __uint_as_float(gw[2 * j] << 16), y1 = x[j][1] * rs * gg[1] * __uint_as_float(gw[2 * j] & 0xffff0000u);
          const float y2 = x[j][2] * rs * gg[2] * __uint_as_float(gw[2 * j + 1] << 16), y3 = x[j][3] * rs * gg[3] * __uint_as_float(gw[2 * j + 1] & 0xffff0000u);
          w[2 * j] = cvt_pk_bf16(y0, y1); w[2 * j + 1] = cvt_pk_bf16(y2, y3); }
      bf16* Y = YMIXP(F) + tok * DM + 512 + h * 128 + v0;
      *(u32x4*)Y = (u32x4){w[0], w[1], w[2], w[3]}; *(u32x4*)(Y + 8) = (u32x4){w[4], w[5], w[6], w[7]}; }
    HG_BAR();
}
__device__ __forceinline__ void phase_pass3(const Frame& F, ARGS_T& A, int l) {
    Raw R; if (F.bid < 2048) load_raw<true>(F, F.bid, R);
    for (int U = F.bid; U < 2048; U += F.G) pass3_unit(F, A, l, U, R, U + F.G);
}
}
#define DEBUG_AFTER_PHASE(p) do{}while(0)
#define DEBUG_BEFORE_PHASE(p) do{}while(0)
#define DEBUG_FINAL() do{}while(0)
#ifndef DUP_B
#define DUP_B 1
#endif
#ifndef DUP_F
#define DUP_F 1
#endif
#ifndef DUP_G
#define DUP_G 1
#endif
#ifndef DUP_K
#define DUP_K 1
#endif
#ifndef DUP_LN1
#define DUP_LN1 1
#endif
#ifndef DUP_PRO
#define DUP_PRO 1
#endif
#ifndef DUP_BAR
#define DUP_BAR 1
#endif
#ifndef DUP_D
#define DUP_D 1
#endif
#ifndef DUP_HG1
#define DUP_HG1 1
#endif
#ifndef DUP_HG3
#define DUP_HG3 1
#endif
#ifndef DUP_FOX
#define DUP_FOX 1
#endif
#ifndef DUP_BAR
#define DUP_BAR 1
#endif
#ifndef DUP_DIFF
#define DUP_DIFF 1
#endif
#ifndef XATTN_MERGE
#define XATTN_MERGE 1
#endif
#ifndef MK_N_LAUNCHES
#define MK_N_LAUNCHES 1
#endif

__global__ void __launch_bounds__(NTHR, 2) mk_fwd(Args args) {
    extern __shared__ __attribute__((aligned(16))) unsigned char lds_raw[];
    Frame F;
    F.lds = (LAS unsigned char*)lds_raw; F.ws = args.ws; F.ctl = (gu32*)(args.ws + WS_CTL); F.out = args.out;
    F.tid = threadIdx.x; F.lane = F.tid & 63; F.wave = __builtin_amdgcn_readfirstlane(F.tid >> 6); F.G = gridDim.x; F.bid = blockIdx.x;
    volatile LAS unsigned* MISC = (volatile LAS unsigned*)(F.lds + MISC_OFF);
    if (F.tid < 32) MISC[F.tid] = 0u;
    __syncthreads();
    const int lo = args.ph_lo, hi = args.ph_hi;
    XcdBarrier bar; bar.bar = (unsigned*)(F.ctl + CW_BAR); bar.x = 0; bar.st = nullptr;
    if (hi - lo > 1) bar = xcd_barrier_post((unsigned*)(F.ctl + CW_BAR), MISC + 8);
#ifdef ONLY_PH
#define IN(k) (((k) == 0 ? 0 : ((k) - 1) % NPH_L + 1) == ONLY_PH && lo <= (k) && (k) < hi)
#else
#define IN(k) (lo <= (k) && (k) < hi)
#endif
#if defined(TS_REPORT) || defined(TS_DELAY)
#define TS_STAMP(k) do { if (F0.bid == 0 && threadIdx.x == 0) __hip_atomic_store((unsigned*)(F0.ctl + 20000 + (k)), (unsigned)__builtin_amdgcn_s_memrealtime(), RLX_AGENT); } while (0)
#define SEAM(k) do { if ((k) + 1 < hi) { XcdBarrier b2_ = bar; asm volatile("" : "+s"(b2_.bar)); xcd_barrier(b2_); } TS_STAMP((k) + 1); } while (0)
#else
#define TS_STAMP(k) do {} while (0)
#define SEAM(k) do { if ((k) + 1 < hi) { XcdBarrier b2_ = bar; asm volatile("" : "+s"(b2_.bar)); for (int rb_ = 0; rb_ < DUP_BAR; ++rb_) xcd_barrier(b2_); } } while (0)
#endif
    ARGS_T* Ap = (ARGS_T*)__builtin_amdgcn_kernarg_segment_ptr();
#define A (*Ap)
    const Frame F0 = F;
#define FRESH() do { F = F0; int t_ = threadIdx.x; asm volatile("" : "+v"(t_)); F.tid = t_; F.lane = t_ & 63; Ap = (ARGS_T*)__builtin_amdgcn_kernarg_segment_ptr(); asm volatile("" : "+s"(Ap)); GAS unsigned char* w_ = Ap->ws; asm volatile("" : "+s"(w_)); F.ws = w_; F.ctl = (gu32*)(w_ + WS_CTL); GAS float* o_ = Ap->out; asm volatile("" : "+s"(o_)); F.out = o_; } while (0)
    TS_STAMP(0);
    if (IN(0)) { FRESH(); for (int rep_ = 0; rep_ < DUP_PRO; ++rep_) phase_prologue(F, A); SEAM(0); }
#pragma clang loop unroll(full)
    for (int l = 0; l < 2; ++l) {
        const int pb = 1 + NPH_L * l;
        if (IN(pb + 0)) { FRESH();
            fox_cumsum(F);
            pg8::ProjOrder S{(const char*)WSP(bf16, WS_R1), (const char*)WSP(bf16, WS_WIN), F.G, F.bid};
            pg8::EpiProj E{WSP(bf16, WS_PA), WSP(bf16, WS_HQ), WSP(bf16, WS_HI), WSP(bf16, WS_HG), WSP(bf16, WS_KMEM), WSP(bf16, WS_VT), WSP(float, WS_HF), (unsigned*)(F.ctl + CW_NRM + l * 128)};
#ifdef PROBE_PART_B
            { pg8::EpiPart<PROBE_PART_B> EN{WSP(bf16, WS_PA)}; pg8::gemm_phase<pg8::EpiPart<PROBE_PART_B>, pg8::ProjOrder, false, true>(F.lds + RING_OFF, DM, DM, DM, S, EN); }
#endif
#ifdef PROBE_NULL_B
            { pg8::EpiNull EN{WSP(float, WS_ST)}; pg8::gemm_phase<pg8::EpiNull, pg8::ProjOrder, false, true>(F.lds + RING_OFF, DM, DM, DM, S, EN); }
#endif
#ifdef PROBE_CLK
            const unsigned long long pc0_ = __builtin_readcyclecounter(), pr0_ = __builtin_amdgcn_s_memrealtime();
#endif
#ifdef PROBE_IMB
            const unsigned long long q0_ = __builtin_amdgcn_s_memrealtime();
            pg8::gemm_phase<pg8::EpiProj, pg8::ProjOrder, false, true>(F.lds + RING_OFF, DM, DM, DM, S, E);
            if (l == 0 && threadIdx.x == 0) { const unsigned d_ = (unsigned)(__builtin_amdgcn_s_memrealtime() - q0_);
                atomicMax((unsigned*)(F.ctl + CW_DBG), d_); atomicMax((unsigned*)(F.ctl + CW_DBG + 1), 1000000u - d_); atomicMax((unsigned*)(F.ctl + CW_DBG + 2), (d_ << 8) | (unsigned)F.bid); atomicMax((unsigned*)(F.ctl + CW_DBG + 3), ((1000000u - d_) << 8) | (unsigned)F.bid); }
            SEAM(pb + 0);
            if (l == 0 && F.bid == 0 && threadIdx.x == 0) {
                const unsigned mx_ = __hip_atomic_load((unsigned*)(F.ctl + CW_DBG), RLX_AGENT), mn_ = 1000000u - __hip_atomic_load((unsigned*)(F.ctl + CW_DBG + 1), RLX_AGENT);
                const unsigned bmx_ = __hip_atomic_load((unsigned*)(F.ctl + CW_DBG + 2), RLX_AGENT) & 255u, bmn_ = __hip_atomic_load((unsigned*)(F.ctl + CW_DBG + 3), RLX_AGENT) & 255u;
                const unsigned long long v_ = PROBE_IMB == 1 ? (unsigned long long)(mx_ - mn_) * 10ull : PROBE_IMB == 2 ? (unsigned long long)mx_ * 5ull : PROBE_IMB == 3 ? (unsigned long long)bmx_ * 1000ull : PROBE_IMB == 4 ? (unsigned long long)mn_ * 5ull : (unsigned long long)bmn_ * 1000ull;
                const unsigned long long until = __builtin_amdgcn_s_memrealtime() + v_;
                while (__builtin_amdgcn_s_memrealtime() < until) __builtin_amdgcn_s_sleep(32); }
            if (0) {
#elif defined(PROBE_GT) && !defined(PROBE_GD)
            unsigned long long pt_[6] = {0ull, 0ull, 0ull, 0ull, 0ull, 0ull}; unsigned long long pt3_[3] = {0ull, 0ull, 0ull};
            pg8::gemm_phase<pg8::EpiProj, pg8::ProjOrder, false, true>(F.lds + RING_OFF, DM, DM, DM, S, E, pt_);
            if (l == 0 && F.bid == PROBE_BID && threadIdx.x == 0) { const unsigned long long v_ = PROBE_GT == 1 ? pt_[0] : (PROBE_GT == 2 ? pt_[1] : pt_[2]);
                const unsigned long long until = __builtin_amdgcn_s_memrealtime() + v_ * (unsigned long long)PROBE_SCALE;
                while (__builtin_amdgcn_s_memrealtime() < until) __builtin_amdgcn_s_sleep(32); }
#else
            for (int rep_ = 0; rep_ < DUP_B; ++rep_) { pg8::gemm_phase<pg8::EpiProj, pg8::ProjOrder, false, true>(F.lds + RING_OFF, DM, DM, DM, S, E); }
#endif
#ifdef PROBE_IMB
            }
#endif
#ifdef PROBE_CLK
            if (l == 0) { const unsigned long long pc1_ = __builtin_readcyclecounter(), pr1_ = __builtin_amdgcn_s_memrealtime();
                if (F.bid == 0 && threadIdx.x == 0) { const float cpt = (float)(pc1_ - pc0_) / (float)(pr1_ - pr0_);
                    const unsigned steps = (unsigned)(cpt + 0.5f); const unsigned long long until = pr1_ + (unsigned long long)steps * 10000ull;
                    while (__builtin_amdgcn_s_memrealtime() < until) __builtin_amdgcn_s_sleep(32); } }
#endif
            SEAM(pb + 0);
        }
        if (IN(pb + 1)) { FRESH(); for (int rep_ = 0; rep_ < DUP_HG1; ++rep_) hg::phase_pass1(F, A, l); TS_STAMP(100 + l); for (int rep_ = 0; rep_ < DUP_FOX; ++rep_) att::attn_phase<0>(F, A, l); SEAM(pb + 1); }
        if (IN(pb + 2)) { FRESH();
            const int skip = F.G >= 64 ? 32 : 0;
            if (F.bid < 32) { pg8::MemKVOrder S{(const char*)WSP(bf16, WS_MEMB), (const char*)WSP(bf16, WS_WK), (const char*)WSP(bf16, WS_WV), F.bid};
                pg8::EpiProj E{WSP(bf16, WS_PA), WSP(bf16, WS_HQ), WSP(bf16, WS_HI), WSP(bf16, WS_HG), WSP(bf16, WS_KMEM), WSP(bf16, WS_VT), WSP(float, WS_HF), (unsigned*)(F.ctl + CW_NRM + l * 128)};
                pg8::gemm_phase<pg8::EpiProj, pg8::MemKVOrder, false, true>(F.lds + RING_OFF, DM, DM, DM, S, E); }
            hg::phase_scan(F, skip); SEAM(pb + 2); }
        if (IN(pb + 3)) { FRESH(); for (int rep_ = 0; rep_ < DUP_HG3; ++rep_) hg::phase_pass3(F, A, l); TS_STAMP(110 + l);
#ifdef ABL_DIFF
            att::attn_phase<1, ABL_DIFF>(F, A, l);
#endif
            for (int rep_ = 0; rep_ < DUP_DIFF; ++rep_) att::attn_phase<1>(F, A, l); SEAM(pb + 3); }
        if (IN(pb + 4)) { FRESH();
            pg8::DenseOrder S{(const char*)YMIXP(F), (const char*)WSP(bf16, WS_WOUT), DM, DM, MTOK / 256, 4, F.G, F.bid};
            pg8::EpiRes E{WSP(bf16, WS_R1), PREP(F)};
#ifdef PROBE_GD
            unsigned long long pt_[6] = {0ull, 0ull, 0ull, 0ull, 0ull, 0ull}; const unsigned long long qd0_ = __builtin_amdgcn_s_memrealtime();
            pg8::gemm_phase<pg8::EpiRes, pg8::DenseOrder, false, true>(F.lds + RING_OFF, DM, DM, DM, S, E, pt_);
            const unsigned long long qd1_ = __builtin_amdgcn_s_memrealtime();
            SEAM(pb + 4);
            if (l == 0 && F.bid == PROBE_BID && threadIdx.x == 0) { const unsigned long long qd2_ = __builtin_amdgcn_s_memrealtime();
                const unsigned long long v_ = PROBE_GD == 1 ? pt_[0] : PROBE_GD == 2 ? pt_[1] : PROBE_GD == 4 ? pt_[3] : PROBE_GD == 5 ? pt_[4] : PROBE_GD == 6 ? qd1_ - qd0_ : qd2_ - qd1_;
                const unsigned long long until = __builtin_amdgcn_s_memrealtime() + v_ * (unsigned long long)PROBE_SCALE;
                while (__builtin_amdgcn_s_memrealtime() < until) __builtin_amdgcn_s_sleep(32); }
#else
            for (int rep_ = 0; rep_ < DUP_D; ++rep_) { pg8::gemm_phase<pg8::EpiRes, pg8::DenseOrder, false, true>(F.lds + RING_OFF, DM, DM, DM, S, E); }
            SEAM(pb + 4);
#endif
        }
        if (IN(pb + 5)) { FRESH(); for (int rep_ = 0; rep_ < DUP_LN1; ++rep_) phase_ln1(F, A, l); SEAM(pb + 5); }
        if (IN(pb + 6)) { FRESH();
            { pg8::DenseOrder S{(const char*)WSP(bf16, WS_R1), (const char*)WSP(bf16, WS_WQ), DM, DM, MTOK / 256, 4, F.G, F.bid};
              pg8::EpiBf16 E{WSP(bf16, WS_Q), DM, pg8::C2_MEM};
              for (int rep_ = 0; rep_ < DUP_F; ++rep_) { pg8::gemm_phase<pg8::EpiBf16, pg8::DenseOrder, false, true>(F.lds + RING_OFF, DM, DM, DM, S, E); } }
            VM_WAIT(); __syncthreads();
#if XATTN_MERGE
            { pg8::XattnOrder2 S{(const char*)WSP(bf16, WS_Q), (const char*)WSP(bf16, WS_KMEM), (const char*)WSP(bf16, WS_PATT), (const char*)WSP(bf16, WS_VT), F.G, F.bid};
              pg8::EpiXattn E{pg8::EpiSoftmax{WSP(bf16, WS_PATT), F.lds + XCH_OFF}, pg8::EpiBf16{WSP(bf16, WS_OATT), DM, 1.f}};
              pg8::gemm_phase<pg8::EpiXattn, pg8::XattnOrder2, false, true>(F.lds + RING_OFF, DM, DM, 256, S, E); }
#else
            { pg8::XattnOrder S{(const char*)WSP(bf16, WS_Q), (const char*)WSP(bf16, WS_KMEM), 0, F.G, F.bid};
              pg8::EpiSoftmax E{WSP(bf16, WS_PATT), F.lds + XCH_OFF};
              for (int rep_ = 0; rep_ < DUP_G; ++rep_) { pg8::gemm_phase<pg8::EpiSoftmax, pg8::XattnOrder, false, true>(F.lds + RING_OFF, DM, DM, 256, S, E); } }
            VM_WAIT(); __syncthreads();
            { pg8::XattnOrder S{(const char*)WSP(bf16, WS_PATT), (const char*)WSP(bf16, WS_VT), 1, F.G, F.bid};
              pg8::EpiBf16 E{WSP(bf16, WS_OATT), DM, 1.f};
              for (int rep_ = 0; rep_ < DUP_G; ++rep_) { pg8::gemm_phase<pg8::EpiBf16, pg8::XattnOrder, false, true>(F.lds + RING_OFF, DM, DM, 256, S, E); } }
#endif
            SEAM(pb + 6);
        }
        if (IN(pb + 9)) { FRESH();
            pg8::DenseOrder S{(const char*)WSP(bf16, WS_OATT), (const char*)WSP(bf16, WS_WO), DM, DM, MTOK / 256, 4, F.G, F.bid};
            pg8::EpiRes E{WSP(bf16, WS_R1), PREP(F)};
            for (int rep_ = 0; rep_ < DUP_D; ++rep_) { pg8::gemm_phase<pg8::EpiRes, pg8::DenseOrder, false, true>(F.lds + RING_OFF, DM, DM, DM, S, E); }
            SEAM(pb + 9);
        }
        if (IN(pb + 10)) { FRESH(); phase_ln2_route(F, A, l); SEAM(pb + 10); }
        if (IN(pb + 11)) { FRESH();
            moe_tables(F, l);
            pg8::MoeOrder S{(const char*)WSP(bf16, WS_R1), (const char*)WSP(bf16, WS_W13), WSP(int, WS_LIST), (const LAS int*)(F.lds + TAB_OFF), 0, F.G, F.bid};
            pg8::EpiSwiGLU E{WSP(bf16, WS_HID)};
            for (int rep_ = 0; rep_ < DUP_K; ++rep_) { pg8::gemm_phase<pg8::EpiSwiGLU, pg8::MoeOrder, true, true>(F.lds + RING_OFF, DM, DM, DM, S, E); }
            SEAM(pb + 11);
        }
        if (IN(pb + 12)) { FRESH();
            moe_tables(F, l);
            pg8::MoeOrder S{(const char*)WSP(bf16, WS_HID), (const char*)WSP(bf16, WS_W2), WSP(int, WS_LIST), (const LAS int*)(F.lds + TAB_OFF), 1, F.G, F.bid};
            pg8::EpiMoeOut E{WSP(bf16, WS_CB), WSP(float, WS_GATE)};
            for (int rep_ = 0; rep_ < DUP_K; ++rep_) { pg8::gemm_phase<pg8::EpiMoeOut, pg8::MoeOrder, false, true>(F.lds + RING_OFF, EFF, EFF, EFF, S, E); }
            SEAM(pb + 12);
        }
        if (IN(pb + 13)) { FRESH(); phase_ln3(F, A, l); SEAM(pb + 13); }
    }
#ifdef TS_DELAY
    if (F0.bid == 0 && threadIdx.x == 0) { constexpr int ka = TS_DELAY; unsigned tot = 0;
        for (int l = 0; l < 2 && ka < 20; ++l) { const int pa = ka == 0 ? 0 : 1 + NPH_L * l + ka - 1; if (ka != 0 || l == 0) tot += __hip_atomic_load((unsigned*)(F0.ctl + 20000 + pa + 1), RLX_AGENT) - __hip_atomic_load((unsigned*)(F0.ctl + 20000 + (ka == 10 ? pa - 2 : pa)), RLX_AGENT); }
        if (ka == 20) tot = (__hip_atomic_load((unsigned*)(F0.ctl + 20100), RLX_AGENT) - __hip_atomic_load((unsigned*)(F0.ctl + 20000 + 2), RLX_AGENT)) + (__hip_atomic_load((unsigned*)(F0.ctl + 20101), RLX_AGENT) - __hip_atomic_load((unsigned*)(F0.ctl + 20000 + 2 + NPH_L), RLX_AGENT));
        if (ka == 21) tot = (__hip_atomic_load((unsigned*)(F0.ctl + 20110), RLX_AGENT) - __hip_atomic_load((unsigned*)(F0.ctl + 20000 + 4), RLX_AGENT)) + (__hip_atomic_load((unsigned*)(F0.ctl + 20111), RLX_AGENT) - __hip_atomic_load((unsigned*)(F0.ctl + 20000 + 4 + NPH_L), RLX_AGENT));
        if (ka >= 30 && ka < 30 + NPHASE) tot = __hip_atomic_load((unsigned*)(F0.ctl + 20000 + (ka - 30) + 1), RLX_AGENT) - __hip_atomic_load((unsigned*)(F0.ctl + 20000 + (ka - 30)), RLX_AGENT);
        if (ka == 99) tot = __hip_atomic_load((unsigned*)(F0.ctl + 20000 + NPHASE), RLX_AGENT) - __hip_atomic_load((unsigned*)(F0.ctl + 20000), RLX_AGENT);
        const unsigned long long until = __builtin_amdgcn_s_memrealtime() + (unsigned long long)tot * (unsigned long long)TS_SCALE;
        while (__builtin_amdgcn_s_memrealtime() < until) __builtin_amdgcn_s_sleep(32); }
#endif
#undef IN
#undef SEAM
#undef A
}

#ifdef TS_REPORT
__global__ void ts_encode(float* out, unsigned char* ws) {
    const unsigned* T = (const unsigned*)(ws + WS_CTL) + 20000; constexpr int ka = TS_REPORT; float ta = 0.f;
    for (int l = 0; l < 2; ++l) { const int pa = ka == 0 ? 0 : 1 + NPH_L * l + ka - 1; if (ka != 0 || l == 0) ta += 0.01f * (float)(T[pa + 1] - T[pa]); }
    const float c = sqrtf(ta * 0.1f);
    for (size_t i = (size_t)blockIdx.x * 256 + threadIdx.x; i < (size_t)MTOK * DM; i += (size_t)gridDim.x * 256) out[i] = c;
}
#endif
extern "C" void kernel_launch(void* const* d_in, const int* in_sizes, int n_in, void* d_out, int out_size, void* d_ws, size_t ws_size, hipStream_t stream) {
    static int grid = 0;
    if (grid == 0) {
        if (n_in != 25 || out_size != MTOK * DM || ws_size < WS_END) { fprintf(stderr, "kernel_launch: unexpected problem (n_in %d, out %d, ws %zu)\n", n_in, out_size, ws_size); grid = -1; return; }
        int dev = 0, cus = 0, per_cu = 0;
        if (hipGetDevice(&dev) != hipSuccess || hipDeviceGetAttribute(&cus, hipDeviceAttributeMultiprocessorCount, dev) != hipSuccess) { grid = -1; return; }
        if (hipFuncSetAttribute((const void*)mk_fwd, hipFuncAttributeMaxDynamicSharedMemorySize, LDS_BYTES) != hipSuccess) { fprintf(stderr, "kernel_launch: hipFuncSetAttribute failed\n"); grid = -1; return; }
        if (hipOccupancyMaxActiveBlocksPerMultiprocessor(&per_cu, (const void*)mk_fwd, NTHR, LDS_BYTES) != hipSuccess || per_cu < 1) fprintf(stderr, "kernel_launch: occupancy query says %d\n", per_cu);
        (void)hipGetLastError();
        grid = cus < 256 ? cus : 256;
    }
    if (grid < 0) return;
    (void)hipMemsetAsync((char*)d_ws + WS_CTL, 0, CTL_ZERO_BYTES, stream);
    Args a{};
    for (int i = 0; i < 25; ++i) a.in[i] = (const GAS float*)d_in[i];
    a.out = (GAS float*)d_out; a.ws = (GAS unsigned char*)d_ws;
#if MK_N_LAUNCHES == 1
    a.ph_lo = 0; a.ph_hi = NPHASE;
    hipLaunchKernelGGL(mk_fwd, dim3(grid), dim3(NTHR), LDS_BYTES, stream, a);
#ifdef TS_REPORT
    hipLaunchKernelGGL(ts_encode, dim3(1024), dim3(256), 0, stream, (float*)d_out, (unsigned char*)d_ws);
#endif
#else
    for (int p = 0; p < NPHASE; ++p) { DEBUG_BEFORE_PHASE(p); a.ph_lo = p; a.ph_hi = p + 1; hipLaunchKernelGGL(mk_fwd, dim3(grid), dim3(NTHR), LDS_BYTES, stream, a);
        DEBUG_AFTER_PHASE(p); }
    DEBUG_FINAL();
#endif
}
```
